# Optimizing an MI355X kernel written in HIP

```python
import jax
import jax.numpy as jnp
from jax import lax
import numpy as np

D_MODEL = 1024
BATCH = 4
SEQ = 8192
DEPTH = 2

HEAD_DIM = 64
ROT_DIM = HEAD_DIM // 4
ROPE_THETA = 500000.0
NORM_EPS = 1e-6
Q_BLOCK = 128
D_FF = 2816

SB_HEADS = 4
NSA_HEADS = 8
NSA_GROUPS = 2
NSA_HPG = NSA_HEADS // NSA_GROUPS
NSA_CMP_LEN = 32
NSA_CMP_STRIDE = 16
NSA_CMP_HIDDEN = 2 * HEAD_DIM
NSA_SEL_LEN = 64
NSA_SEL_N = 16
NSA_WINDOW = 512
NSA_FORCED_SCORE = 1.0e4
DSA_HEADS = 4
DSA_IDX_HEADS = 8
DSA_IDX_DIM = 32
DSA_IDX_ROT = DSA_IDX_DIM // 4
DSA_TOPK = 256

SB_W = SB_HEADS * HEAD_DIM
NSA_QW = NSA_HEADS * HEAD_DIM
NSA_KVW = NSA_GROUPS * HEAD_DIM
DSA_QW = DSA_HEADS * HEAD_DIM
IN_WIDTHS = (SB_W, SB_W, SB_W,
             NSA_QW, NSA_KVW, NSA_KVW, NSA_KVW, NSA_KVW, NSA_KVW, NSA_KVW, 3 * NSA_HEADS,
             DSA_QW, HEAD_DIM, HEAD_DIM, DSA_IDX_HEADS * DSA_IDX_DIM, DSA_IDX_DIM, DSA_IDX_HEADS)
D_IN = sum(IN_WIDTHS)

kernel_name = "hybrid_sb_nsa_dsa_macaron"


def rms_norm(x, g):
    xf = x.astype(jnp.float32)
    y = xf * lax.rsqrt(jnp.mean(xf * xf, axis=-1, keepdims=True) + NORM_EPS)
    return (y * g.astype(jnp.float32)).astype(x.dtype)


def rope_tables(pos, rot_dim):
    inv = ROPE_THETA ** (-jnp.arange(0, rot_dim, 2, dtype=jnp.float32) / rot_dim)
    ang = pos.astype(jnp.float32)[:, None] * inv[None, :]
    return jnp.cos(ang), jnp.sin(ang)


def apply_rope(x, cos, sin):
    half = cos.shape[-1]
    xf = x[..., :2 * half].astype(jnp.float32)
    x1, x2 = xf[..., :half], xf[..., half:]
    c, s = cos[:, None, :], sin[:, None, :]
    rot = jnp.concatenate([x1 * c - x2 * s, x2 * c + x1 * s], axis=-1).astype(x.dtype)
    return jnp.concatenate([rot, x[..., 2 * half:]], axis=-1)


def masked_softmax(s, mask):
    s = jnp.where(mask, s.astype(jnp.float32), -jnp.inf)
    m = jnp.max(s, axis=-1, keepdims=True)
    m = jnp.where(jnp.isfinite(m), m, 0.0)
    p = jnp.exp(s - m)
    den = jnp.sum(p, axis=-1, keepdims=True)
    return p / jnp.where(den > 0, den, 1.0)


def unblock(y):
    n, b, t = y.shape[:3]
    return jnp.moveaxis(y, 0, 1).reshape((b, n * t) + y.shape[3:])


def swiglu_ffn(x, g, w_gu, w_down):
    h = rms_norm(x, g)
    gate, up = jnp.split(h @ w_gu, 2, axis=-1)
    return (jax.nn.silu(gate) * up) @ w_down


def stick_breaking_attention(q, k, v):
    B, S, H, d = q.shape
    scale = d ** -0.5
    kh = k.transpose(0, 2, 1, 3)
    vh = v.transpose(0, 2, 1, 3)
    s_pos = jnp.arange(S)

    def block(i):
        q0 = i * Q_BLOCK
        qb = lax.dynamic_slice_in_dim(q, q0, Q_BLOCK, axis=1)
        z = jnp.einsum('bthd,bhsd->bhts', qb, kh).astype(jnp.float32) * scale
        t_pos = q0 + jnp.arange(Q_BLOCK)
        past = s_pos[None, :] < t_pos[:, None]
        log_1m = jnp.where(past, jax.nn.log_sigmoid(-z), 0.0)
        tail = lax.cumsum(log_1m, axis=3, reverse=True) - log_1m
        w = jnp.where(past, jnp.exp(jax.nn.log_sigmoid(z) + tail), 0.0)
        return jnp.einsum('bhts,bhsd->bthd', w.astype(v.dtype), vh)

    return unblock(lax.map(block, jnp.arange(S // Q_BLOCK)))


def nsa_compress(x, pe, w1, w2):
    B, S, G, d = x.shape
    nchunk = S // NSA_CMP_STRIDE
    r = NSA_CMP_LEN // NSA_CMP_STRIDE
    nc = nchunk - r + 1
    chunks = x.reshape(B, nchunk, NSA_CMP_STRIDE, G, d)
    blocks = jnp.concatenate([chunks[:, m:m + nc] for m in range(r)], axis=2)
    blocks = blocks + pe[None, None, :, None, :]
    flat = blocks.transpose(0, 1, 3, 2, 4).reshape(B, nc, G, NSA_CMP_LEN * d)
    return jax.nn.silu(flat @ w1) @ w2


def nsa_attention(q, k_cmp, v_cmp, k_sel, v_sel, k_win, v_win, gate_logits,
                  q_norm, k_norm, pe, w1, w2, cos, sin):
    B, S, _, d = q.shape
    G, hpg, T = NSA_GROUPS, NSA_HPG, Q_BLOCK
    scale = d ** -0.5
    dt = v_sel.dtype
    qg = apply_rope(rms_norm(q, q_norm), cos, sin).reshape(B, S, G, hpg, d)
    k_sel = apply_rope(rms_norm(k_sel, k_norm[1]), cos, sin)
    k_win = apply_rope(rms_norm(k_win, k_norm[2]), cos, sin)
    gates = jax.nn.sigmoid(gate_logits).reshape(B, S, G, hpg, 3)

    kc = rms_norm(nsa_compress(k_cmp, pe[0], w1[0], w2[0]), k_norm[0])
    nc = kc.shape[1]
    cmp_start = jnp.arange(nc) * NSA_CMP_STRIDE
    cmp_end = cmp_start + NSA_CMP_LEN - 1
    cos_c, sin_c = rope_tables(cmp_end, ROT_DIM)
    kc = apply_rope(kc, cos_c, sin_c).transpose(0, 2, 1, 3)
    vc = nsa_compress(v_cmp, pe[1], w1[1], w2[1]).transpose(0, 2, 1, 3)

    ns = S // NSA_SEL_LEN
    n_sel = min(NSA_SEL_N, ns)
    ks_blocks = k_sel.reshape(B, ns, NSA_SEL_LEN, G, d).transpose(0, 3, 1, 2, 4)
    vs_blocks = v_sel.reshape(B, ns, NSA_SEL_LEN, G, d).transpose(0, 3, 1, 2, 4)
    sel_start = jnp.arange(ns) * NSA_SEL_LEN
    overlap = ((cmp_start[:, None] < sel_start[None, :] + NSA_SEL_LEN)
               & (cmp_end[:, None] >= sel_start[None, :])).astype(jnp.float32)
    gather_blocks = jax.vmap(jax.vmap(lambda src, ix: src[ix]))

    pad = ((0, 0), (NSA_WINDOW, 0), (0, 0), (0, 0))
    kw_pad = jnp.pad(k_win, pad)
    vw_pad = jnp.pad(v_win, pad)

    def block(i):
        q0 = i * T
        t_pos = q0 + jnp.arange(T)
        qb = lax.dynamic_slice_in_dim(qg, q0, T, axis=1)

        sc = jnp.einsum('btghd,bgcd->bghtc', qb, kc) * scale
        pc = masked_softmax(sc, cmp_end[None, :] <= t_pos[:, None])
        o_cmp = jnp.einsum('bghtc,bgcd->btghd', pc.astype(dt), vc)

        imp = jnp.einsum('bghtc,cn->bgtn', pc, overlap)
        j = jnp.arange(ns)[None, :]
        cur = (t_pos // NSA_SEL_LEN)[:, None]
        visible = j * NSA_SEL_LEN <= t_pos[:, None]
        forced = (j == 0) | (j == cur) | (j == cur - 1)
        score = jnp.where(visible, jnp.where(forced, NSA_FORCED_SCORE, imp), -jnp.inf)
        _, sel = lax.top_k(score, n_sel)
        k_g = gather_blocks(ks_blocks, sel)
        v_g = gather_blocks(vs_blocks, sel).reshape(B, G, T, n_sel * NSA_SEL_LEN, d)
        tok = sel[..., None] * NSA_SEL_LEN + jnp.arange(NSA_SEL_LEN)
        smask = (tok <= t_pos[:, None, None]).reshape(B, G, 1, T, n_sel * NSA_SEL_LEN)
        ss = jnp.einsum('btghd,bgtnld->bghtnl', qb, k_g) * scale
        ps = masked_softmax(ss.reshape(B, G, hpg, T, n_sel * NSA_SEL_LEN), smask)
        o_sel = jnp.einsum('bghtm,bgtmd->btghd', ps.astype(dt), v_g)

        kwb = lax.dynamic_slice_in_dim(kw_pad, q0, T + NSA_WINDOW, axis=1)
        vwb = lax.dynamic_slice_in_dim(vw_pad, q0, T + NSA_WINDOW, axis=1)
        s_abs = q0 - NSA_WINDOW + jnp.arange(T + NSA_WINDOW)
        wmask = ((s_abs[None, :] <= t_pos[:, None]) & (s_abs[None, :] > t_pos[:, None] - NSA_WINDOW)
                 & (s_abs[None, :] >= 0))
        sw = jnp.einsum('btghd,bsgd->bghts', qb, kwb) * scale
        pw = masked_softmax(sw, wmask)
        o_win = jnp.einsum('bghts,bsgd->btghd', pw.astype(dt), vwb)

        g = lax.dynamic_slice_in_dim(gates, q0, T, axis=1)
        return g[..., 0:1] * o_cmp + g[..., 1:2] * o_sel + g[..., 2:3] * o_win

    out = unblock(lax.map(block, jnp.arange(S // T)))
    return out.reshape(B, S, NSA_HEADS * d)


def dsa_attention(q, k, v, iq, ik, iw, q_norm, k_norm, cos, sin, cos_i, sin_i):
    B, S, _, d = q.shape
    T = Q_BLOCK
    scale = d ** -0.5
    dt = v.dtype
    top_k = min(DSA_TOPK, S // 4)
    q = apply_rope(rms_norm(q, q_norm), cos, sin)
    k = apply_rope(rms_norm(k[:, :, None, :], k_norm), cos, sin)[:, :, 0, :]
    iq = apply_rope(iq, cos_i, sin_i)
    ik = apply_rope(ik[:, :, None, :], cos_i, sin_i)[:, :, 0, :]
    iw = iw.astype(jnp.float32) * (DSA_IDX_HEADS ** -0.5) * (DSA_IDX_DIM ** -0.5)
    s_pos = jnp.arange(S)
    gather_rows = jax.vmap(lambda src, ix: src[ix])

    def block(i):
        q0 = i * T
        t_pos = q0 + jnp.arange(T)
        qi = lax.dynamic_slice_in_dim(iq, q0, T, axis=1)
        wi = lax.dynamic_slice_in_dim(iw, q0, T, axis=1)
        logits = jax.nn.relu(jnp.einsum('bthd,bsd->bths', qi, ik).astype(jnp.float32))
        score = jnp.einsum('bths,bth->bts', logits, wi)
        score = jnp.where(s_pos[None, None, :] <= t_pos[None, :, None], score, -jnp.inf)
        _, idx = lax.top_k(score, top_k)
        kg = gather_rows(k, idx)
        vg = gather_rows(v, idx)
        qb = lax.dynamic_slice_in_dim(q, q0, T, axis=1)
        sc = jnp.einsum('bthd,btkd->bhtk', qb, kg) * scale
        p = masked_softmax(sc, (idx <= t_pos[None, :, None])[:, None])
        return jnp.einsum('bhtk,btkd->bthd', p.astype(dt), vg)

    out = unblock(lax.map(block, jnp.arange(S // T)))
    return out.reshape(B, S, DSA_HEADS * d)


def hybrid_mixer(h, w_in, w_gate, nsa_q_norm, nsa_k_norm, nsa_cmp_pe, nsa_cmp_w1, nsa_cmp_w2,
                 dsa_q_norm, dsa_k_norm, w_br_a, w_br_b, w_br_c, w_out, cos, sin, cos_i, sin_i):
    B, S, _ = h.shape
    offs = np.cumsum(IN_WIDTHS)[:-1].tolist()
    (sb_q, sb_k, sb_v, nq, nkc, nvc, nks, nvs, nkw, nvw, ngate,
     dq, dk, dv, iq, ik, iw) = jnp.split(h @ w_in, offs, axis=-1)

    def heads(t, n, d):
        return t.reshape(B, S, n, d)

    o_a = stick_breaking_attention(heads(sb_q, SB_HEADS, HEAD_DIM), heads(sb_k, SB_HEADS, HEAD_DIM),
                                   heads(sb_v, SB_HEADS, HEAD_DIM)).reshape(B, S, SB_W)
    kv = lambda t: heads(t, NSA_GROUPS, HEAD_DIM)
    o_b = nsa_attention(heads(nq, NSA_HEADS, HEAD_DIM), kv(nkc), kv(nvc), kv(nks), kv(nvs), kv(nkw), kv(nvw),
                        heads(ngate, NSA_HEADS, 3), nsa_q_norm, nsa_k_norm, nsa_cmp_pe, nsa_cmp_w1, nsa_cmp_w2,
                        cos, sin)
    o_c = dsa_attention(heads(dq, DSA_HEADS, HEAD_DIM), dk, dv, heads(iq, DSA_IDX_HEADS, DSA_IDX_DIM), ik, iw,
                        dsa_q_norm, dsa_k_norm, cos, sin, cos_i, sin_i)

    g_a, g_b, g_c = jnp.split(jax.nn.sigmoid(h @ w_gate), 3, axis=-1)
    merged = g_a * (o_a @ w_br_a) + g_b * (o_b @ w_br_b) + g_c * (o_c @ w_br_c)
    return merged @ w_out


def setup_inputs(seed: int = 0) -> dict:
    key = jax.random.key(seed)
    ks = jax.random.split(key, 21)
    f32 = jnp.float32

    def normal(k, shape, scale):
        return jax.random.normal(k, shape, f32) * scale

    def gain(k, shape):
        return 1.0 + 0.02 * jax.random.normal(k, shape, f32)

    D, L = D_MODEL, DEPTH
    cmp_in = NSA_CMP_LEN * HEAD_DIM
    return {
        "x": jax.random.normal(ks[0], (BATCH, SEQ, D), f32),
        "ffn1_norm": gain(ks[1], (L, D)),
        "ffn1_w_gu": normal(ks[2], (L, D, 2 * D_FF), D ** -0.5),
        "ffn1_w_down": normal(ks[3], (L, D_FF, D), D_FF ** -0.5),
        "mix_norm": gain(ks[4], (L, D)),
        "w_in": normal(ks[5], (L, D, D_IN), D ** -0.5),
        "w_gate": normal(ks[6], (L, D, 3 * D), D ** -0.5),
        "nsa_q_norm": gain(ks[7], (L, HEAD_DIM)),
        "nsa_k_norm": gain(ks[8], (L, 3, HEAD_DIM)),
        "nsa_cmp_pe": normal(ks[9], (L, 2, NSA_CMP_LEN, HEAD_DIM), 0.1),
        "nsa_cmp_w1": normal(ks[10], (L, 2, cmp_in, NSA_CMP_HIDDEN), cmp_in ** -0.5),
        "nsa_cmp_w2": normal(ks[11], (L, 2, NSA_CMP_HIDDEN, HEAD_DIM), NSA_CMP_HIDDEN ** -0.5),
        "dsa_q_norm": gain(ks[12], (L, HEAD_DIM)),
        "dsa_k_norm": gain(ks[13], (L, HEAD_DIM)),
        "w_br_a": normal(ks[14], (L, SB_W, D), SB_W ** -0.5),
        "w_br_b": normal(ks[15], (L, NSA_QW, D), NSA_QW ** -0.5),
        "w_br_c": normal(ks[16], (L, DSA_QW, D), DSA_QW ** -0.5),
        "w_out": normal(ks[17], (L, D, D), D ** -0.5),
        "ffn2_norm": gain(ks[18], (L, D)),
        "ffn2_w_gu": normal(ks[19], (L, D, 2 * D_FF), D ** -0.5),
        "ffn2_w_down": normal(ks[20], (L, D_FF, D), D_FF ** -0.5),
    }


def reference(x, ffn1_norm, ffn1_w_gu, ffn1_w_down, mix_norm, w_in, w_gate, nsa_q_norm, nsa_k_norm,
              nsa_cmp_pe, nsa_cmp_w1, nsa_cmp_w2, dsa_q_norm, dsa_k_norm, w_br_a, w_br_b, w_br_c, w_out,
              ffn2_norm, ffn2_w_gu, ffn2_w_down):
    S = x.shape[1]
    pos = jnp.arange(S)
    cos, sin = rope_tables(pos, ROT_DIM)
    cos_i, sin_i = rope_tables(pos, DSA_IDX_ROT)
    for l in range(DEPTH):
        x = x + 0.5 * swiglu_ffn(x, ffn1_norm[l], ffn1_w_gu[l], ffn1_w_down[l])
        h = rms_norm(x, mix_norm[l])
        x = x + hybrid_mixer(h, w_in[l], w_gate[l], nsa_q_norm[l], nsa_k_norm[l], nsa_cmp_pe[l],
                             nsa_cmp_w1[l], nsa_cmp_w2[l], dsa_q_norm[l], dsa_k_norm[l],
                             w_br_a[l], w_br_b[l], w_br_c[l], w_out[l], cos, sin, cos_i, sin_i)
        x = x + 0.5 * swiglu_ffn(x, ffn2_norm[l], ffn2_w_gu[l], ffn2_w_down[l])
    return x
```

```cpp
#include <hip/hip_runtime.h>
#include <cstdio>
#include <cstdint>
namespace pg8 {
#define PG8_LAS __attribute__((address_space(3)))
typedef unsigned short bf16_t;
typedef short bf16x8 __attribute__((ext_vector_type(8)));
typedef float f32x4 __attribute__((ext_vector_type(4)));
typedef unsigned u32x4 __attribute__((ext_vector_type(4)));
constexpr int BM = 256, BK = 64, HALF = 128, HTB = HALF * BK * 2  , STAGE_BYTES = 8 * HTB, NXCD = 8, WGM = 8;

__host__ __device__ __forceinline__ int lds_byte(int r, int c) { const int st = (r >> 4) * 2 + (c >> 5), rr = r & 15, cc = c & 31, ob = rr * 64 + cc * 2; return st * 1024 + (ob ^ (((ob >> 9) & 1) << 5)); }
__host__ __device__ __forceinline__ void stage_rc(int b, int& R, int& C) { const int st = b / 1024, sb = b % 1024, swz = sb ^ (((sb >> 9) & 1) << 5); R = (st >> 1) * 16 + swz / 64; C = (st & 1) * 32 + (swz % 64) / 2; }
__host__ __device__ __forceinline__ int perm32(int rho) { const int n = rho >> 4, i = rho & 15; return 8 * (i >> 2) + 4 * n + (i & 3); }

struct Unit { int pm, pn; };
struct Gemm { const bf16_t* A; const bf16_t* Bt; int M, N, K; };

struct StaticOrder {
    int nM, nN, nwg, G, c;
    __host__ __device__ void init(int M, int N, int G_, int c_) { nM = M / BM; nN = N / BM; nwg = nM * nN; G = G_; c = c_; }
    __host__ __device__ bool next(int i, Unit& u) const {
        const long L = (long)i * G + c; if (L >= nwg) return false;
        int wgid = (int)L; { const int q = nwg / NXCD, r = nwg % NXCD, xcd = wgid % NXCD, off = wgid / NXCD; wgid = (xcd < r ? xcd * (q + 1) : r * (q + 1) + (xcd - r) * q) + off; }
        const int nig = WGM * nN, gid = wgid / nig, fm = gid * WGM, gsz = (nM - fm) < WGM ? (nM - fm) : WGM;
        u.pm = fm + ((wgid % nig) % gsz); u.pn = (wgid % nig) / gsz; return true;
    }
    __device__ __forceinline__ void a_ready(const Unit&) const {}
    __device__ __forceinline__ void done(const Unit&) const {}
};

__device__ __forceinline__ unsigned cvt_pk_bf16(float lo, float hi) { unsigned r; asm volatile("v_cvt_pk_bf16_f32 %0, %1, %2" : "=v"(r) : "v"(lo), "v"(hi)); return r; }
typedef float f32x2 __attribute__((ext_vector_type(2)));
__device__ __forceinline__ f32x2 gelu_pk(f32x2 v) {
    const f32x2 av = __builtin_elementwise_abs(v), d = av * 0.2316418882f + 1.0f;
    f32x2 t; t.x = __builtin_amdgcn_rcpf(d.x); t.y = __builtin_amdgcn_rcpf(d.y);
    f32x2 q = t * 0.5307027145f + (-0.7265760135f); q = q * t + 0.7107068705f; q = q * t + (-0.142248368f); q = q * t + 0.127414796f; q = q * t;
    const f32x2 s = (v * v) * (-0.72134752044f);
    f32x2 e; e.x = __builtin_amdgcn_exp2f(s.x); e.y = __builtin_amdgcn_exp2f(s.y);
    const f32x2 m = v * (q * e), r = v - m;
    f32x2 o; o.x = v.x < 0.f ? m.x : r.x; o.y = v.y < 0.f ? m.y : r.y; return o;
}

template <int ACT  > struct EpiBf16 {
    static constexpr bool PERM = true, AFTER_DRAIN = false; static_assert(ACT == 0 || ACT == 1, "EpiBf16: ACT is 0 (none) or 1 (gelu_pk)");
    bf16_t* O; int ldc; const float* bias; int split_cols; size_t split_stride; float scale0;
    __device__ __forceinline__ void operator()(const f32x4 (&acc)[2][2][4][2], const Unit& u, int wr, int wc, int fr, int fq) const {
        const int row0 = u.pm * BM + wr * 64 + fr; int colt = u.pn * BM; bf16_t* base = O;
        float sc = 1.f; if (split_cols) { const int t = colt / split_cols; base += (size_t)t * split_stride; colt -= t * split_cols; if (t == 0) sc = scale0; }
        const int col0 = colt + wc * 32 + 8 * fq, bcol0 = u.pn * BM + wc * 32 + 8 * fq;
        f32x4 bv[2][2];
#pragma unroll
        for (int bj = 0; bj < 2; ++bj)
#pragma unroll
            for (int n = 0; n < 2; ++n) bv[bj][n] = bias ? *(const f32x4*)(bias + bcol0 + bj * HALF + 4 * n) : (f32x4){0.f, 0.f, 0.f, 0.f};
#pragma unroll
        for (int ai = 0; ai < 2; ++ai)
#pragma unroll
            for (int m = 0; m < 4; ++m) { bf16_t* rowp = base + (size_t)(row0 + ai * HALF + m * 16) * ldc + col0;
#pragma unroll
                for (int bj = 0; bj < 2; ++bj) { f32x4 v0 = acc[ai][bj][m][0] + bv[bj][0], v1 = acc[ai][bj][m][1] + bv[bj][1];
                    if (ACT == 1) { f32x2 a = gelu_pk((f32x2){v0[0], v0[1]}), b = gelu_pk((f32x2){v0[2], v0[3]}), c = gelu_pk((f32x2){v1[0], v1[1]}), d = gelu_pk((f32x2){v1[2], v1[3]});
                        v0 = (f32x4){a.x, a.y, b.x, b.y}; v1 = (f32x4){c.x, c.y, d.x, d.y}; }
                    v0 = v0 * sc; v1 = v1 * sc; u32x4 w; w.x = cvt_pk_bf16(v0[0], v0[1]); w.y = cvt_pk_bf16(v0[2], v0[3]); w.z = cvt_pk_bf16(v1[0], v1[1]); w.w = cvt_pk_bf16(v1[2], v1[3]);
                    *(u32x4*)(rowp + bj * HALF) = w; } }
    }
};

template <class Epi, class Sched, bool ALIGN_EPI = false, bool SP2 = false>
__device__ __forceinline__ void gemm_phase(PG8_LAS unsigned char* lds, const Gemm g, const Sched& S, const Epi& E, const int tid_in) {
    const int tid = tid_in,     wid = __builtin_amdgcn_readfirstlane(tid >> 6), lane = tid & 63, wr = wid >> 2, wc = wid & 3, fr = lane & 15, fq = lane >> 4;
    const int K = g.K, nt = K / BK;
    unsigned voffA[2], voffB[2];
#pragma unroll
    for (int i = 0; i < 2; ++i) { int R, C; stage_rc(tid * 16 + i * 8192, R, C); const int Rb = Epi::PERM ? ((R & ~31) + perm32(R & 31)) : R;
        voffA[i] = (unsigned)(R * K + C) * 2u; voffB[i] = (unsigned)(Rb * K + C) * 2u; }
    const size_t kstep = (size_t)(BK * 2);
    const size_t hstep = (size_t)HALF * K * 2;
    const size_t tstep = 2 * hstep;
    const unsigned ldsw = (unsigned)wid * 1024u;
    const int aoff = lds_byte(wr * 64 + fr, fq * 8), boff = lds_byte(wc * 32 + fr, fq * 8);
#define PG8_SA(b, h) (((b) * 2 + (h)) * HTB)
#define PG8_SB(b, h) ((4 + (b) * 2 + (h)) * HTB)
#define PG8_STAGE(bufoff, gbase, voff) do { _Pragma("unroll") for (int _i = 0; _i < 2; ++_i) \
        __builtin_amdgcn_global_load_lds((const unsigned*)((const char*)(gbase) + (voff)[_i]), (PG8_LAS unsigned*)(lds + (bufoff) + ldsw + _i * 8192), 16, 0, 0); } while (0)
#define PG8_LDA(dst, b, h) do { _Pragma("unroll") for (int m = 0; m < 4; ++m) _Pragma("unroll") for (int k = 0; k < 2; ++k) dst[m][k] = *(const PG8_LAS bf16x8*)(lds + PG8_SA(b, h) + aoff + m * 2048 + k * 1024); } while (0)
#define PG8_LDB(dst, b, h) do { _Pragma("unroll") for (int n = 0; n < 2; ++n) _Pragma("unroll") for (int k = 0; k < 2; ++k) dst[n][k] = *(const PG8_LAS bf16x8*)(lds + PG8_SB(b, h) + boff + n * 2048 + k * 1024); } while (0)
#define PG8_MMA(ai, bj, At, Bt) do { __builtin_amdgcn_s_setprio(1); _Pragma("unroll") for (int m = 0; m < 4; ++m) _Pragma("unroll") for (int n = 0; n < 2; ++n) _Pragma("unroll") for (int k = 0; k < 2; ++k) \
        acc[ai][bj][m][n] = __builtin_amdgcn_mfma_f32_16x16x32_bf16(Bt[n][k], At[m][k], acc[ai][bj][m][n], 0, 0, 0); __builtin_amdgcn_s_setprio(0); } while (0)
#define PG8_WAIT_V(n) asm volatile("s_waitcnt vmcnt(" #n ")" ::: "memory")
#define PG8_WAIT_L(n) asm volatile("s_waitcnt lgkmcnt(" #n ")" ::: "memory")
#define PG8_BAR __builtin_amdgcn_s_barrier()
#define PG8_SCHED __builtin_amdgcn_sched_barrier(0)
    Unit cur, nxt; int ui = 0;
    if (!S.next(0, cur)) return;
    f32x4 acc[2][2][4][2];
#pragma unroll
    for (int a = 0; a < 2; ++a)
#pragma unroll
        for (int b = 0; b < 2; ++b)
#pragma unroll
            for (int m = 0; m < 4; ++m)
#pragma unroll
                for (int n = 0; n < 2; ++n) acc[a][b][m][n] = (f32x4){0.f, 0.f, 0.f, 0.f};
    bf16x8 At[4][2], B0[2][2], B1[2][2];
    const char* cA = (const char*)g.A + (size_t)cur.pm * tstep; const char* cB = (const char*)g.Bt + (size_t)cur.pn * tstep;
    S.a_ready(cur);
    if constexpr (SP2) {
        PG8_STAGE(PG8_SB(0, 0), cB, voffB); PG8_STAGE(PG8_SB(0, 1), cB + hstep, voffB); PG8_STAGE(PG8_SA(0, 0), cA, voffA); PG8_STAGE(PG8_SA(0, 1), cA + hstep, voffA);
        if (wr == 1) PG8_BAR;
        PG8_WAIT_V(2); PG8_BAR;
        PG8_STAGE(PG8_SB(1, 0), cB + kstep, voffB); PG8_STAGE(PG8_SA(1, 0), cA + kstep, voffA); PG8_STAGE(PG8_SB(1, 1), cB + hstep + kstep, voffB);
        PG8_WAIT_V(6); PG8_BAR;
    } else {
        PG8_STAGE(PG8_SB(0, 0), cB, voffB); PG8_STAGE(PG8_SA(0, 0), cA, voffA); PG8_STAGE(PG8_SB(0, 1), cB + hstep, voffB); PG8_STAGE(PG8_SA(0, 1), cA + hstep, voffA);
        if (wr == 1) PG8_BAR;
        PG8_WAIT_V(4); PG8_BAR;
        PG8_STAGE(PG8_SB(1, 0), cB + kstep, voffB); PG8_STAGE(PG8_SA(1, 0), cA + kstep, voffA); PG8_STAGE(PG8_SB(1, 1), cB + hstep + kstep, voffB);
        PG8_WAIT_V(6); PG8_BAR;
    }
    for (;;) {
        const bool has_next = S.next(ui + 1, nxt);
        const char* nA = has_next ? (const char*)g.A + (size_t)nxt.pm * tstep : cA; const char* nB = has_next ? (const char*)g.Bt + (size_t)nxt.pn * tstep : cB;
        for (int t = 0; t < nt; t += 2) {
            const bool last = (t == nt - 2);
            const char* a1 = cA + (size_t)(t + 1) * kstep;
            const char* a2 = last ? nA : cA + (size_t)(t + 2) * kstep; const char* b2 = last ? nB : cB + (size_t)(t + 2) * kstep;
            const char* a3 = a2 + kstep; const char* b3 = b2 + kstep;
            if (last && has_next) S.a_ready(nxt);
            if constexpr (SP2) {
            PG8_LDB(B0, 0, 0); PG8_LDB(B1, 0, 1); PG8_SCHED; PG8_LDA(At, 0, 0); PG8_STAGE(PG8_SA(1, 1), a1 + hstep, voffA);
            PG8_WAIT_V(8); PG8_WAIT_L(0); PG8_BAR; PG8_MMA(0, 0, At, B0); PG8_MMA(0, 1, At, B1); PG8_BAR; PG8_SCHED;
            PG8_LDA(At, 0, 1); PG8_STAGE(PG8_SB(0, 0), b2, voffB); PG8_STAGE(PG8_SB(0, 1), b2 + hstep, voffB); PG8_STAGE(PG8_SA(0, 0), a2, voffA);
            PG8_WAIT_V(8); PG8_WAIT_L(0); PG8_BAR; PG8_MMA(1, 0, At, B0); PG8_MMA(1, 1, At, B1); PG8_BAR; PG8_SCHED;
            PG8_LDB(B0, 1, 0); PG8_LDB(B1, 1, 1); PG8_SCHED; PG8_LDA(At, 1, 0); PG8_STAGE(PG8_SA(0, 1), a2 + hstep, voffA);
            PG8_WAIT_V(8); PG8_WAIT_L(0); PG8_BAR; PG8_MMA(0, 0, At, B0); PG8_MMA(0, 1, At, B1); PG8_BAR; PG8_SCHED;
            PG8_LDA(At, 1, 1); PG8_STAGE(PG8_SB(1, 0), b3, voffB); PG8_STAGE(PG8_SB(1, 1), b3 + hstep, voffB); PG8_STAGE(PG8_SA(1, 0), a3, voffA);
            PG8_WAIT_V(8); PG8_WAIT_L(0); PG8_BAR; PG8_MMA(1, 0, At, B0); PG8_MMA(1, 1, At, B1); PG8_BAR; PG8_SCHED;
            } else {
            PG8_LDB(B0, 0, 0); PG8_SCHED; PG8_LDA(At, 0, 0); PG8_STAGE(PG8_SA(1, 1), a1 + hstep, voffA);
            PG8_WAIT_L(8); PG8_BAR; PG8_WAIT_L(0); PG8_MMA(0, 0, At, B0); PG8_BAR; PG8_SCHED;
            PG8_LDB(B1, 0, 1); PG8_STAGE(PG8_SB(0, 0), b2, voffB);
            PG8_BAR; PG8_WAIT_L(0); PG8_MMA(0, 1, At, B1); PG8_BAR;
            PG8_LDA(At, 0, 1); PG8_STAGE(PG8_SA(0, 0), a2, voffA);
            PG8_BAR; PG8_WAIT_L(0); PG8_MMA(1, 0, At, B0); PG8_BAR; PG8_SCHED;
            PG8_STAGE(PG8_SB(0, 1), b2 + hstep, voffB);
            PG8_WAIT_V(6); PG8_BAR; PG8_MMA(1, 1, At, B1); PG8_BAR;
            PG8_LDB(B0, 1, 0); PG8_SCHED; PG8_LDA(At, 1, 0); PG8_STAGE(PG8_SA(0, 1), a2 + hstep, voffA);
            PG8_WAIT_L(8); PG8_BAR; PG8_WAIT_L(0); PG8_MMA(0, 0, At, B0); PG8_BAR; PG8_SCHED;
            PG8_LDB(B1, 1, 1); PG8_STAGE(PG8_SB(1, 0), b3, voffB);
            PG8_BAR; PG8_WAIT_L(0); PG8_MMA(0, 1, At, B1); PG8_BAR;
            PG8_LDA(At, 1, 1); PG8_STAGE(PG8_SA(1, 0), a3, voffA);
            PG8_BAR; PG8_WAIT_L(0); PG8_MMA(1, 0, At, B0); PG8_BAR; PG8_SCHED;
            PG8_STAGE(PG8_SB(1, 1), b3 + hstep, voffB);
            PG8_WAIT_V(6); PG8_BAR; PG8_MMA(1, 1, At, B1); PG8_BAR;
            }
        }
        if constexpr (ALIGN_EPI) { if (wr == 0) PG8_BAR; }
        if constexpr (!Epi::AFTER_DRAIN) { E(acc, cur, wr, wc, fr, fq); S.done(cur); }
        if (!has_next) break;
#pragma unroll
        for (int a = 0; a < 2; ++a)
#pragma unroll
            for (int b = 0; b < 2; ++b)
#pragma unroll
                for (int m = 0; m < 4; ++m)
#pragma unroll
                    for (int n = 0; n < 2; ++n) acc[a][b][m][n] = (f32x4){0.f, 0.f, 0.f, 0.f};
        cur = nxt; cA = nA; cB = nB; ++ui;
        if constexpr (ALIGN_EPI) { if (wr == 1) PG8_BAR; }
    }
    PG8_WAIT_V(0);
    if constexpr (!ALIGN_EPI) { if (wr == 0) PG8_BAR; }
    PG8_BAR;
    if constexpr (Epi::AFTER_DRAIN) { E.fused(acc, cur, wr, wc, fr, fq, lds, wid, lane); S.done(cur); }
#undef PG8_SA
#undef PG8_SB
#undef PG8_STAGE
#undef PG8_LDA
#undef PG8_LDB
#undef PG8_MMA
#undef PG8_WAIT_V
#undef PG8_WAIT_L
#undef PG8_BAR
#undef PG8_SCHED
}
}
namespace pg8 {
typedef float f32x2_t __attribute__((ext_vector_type(2))); typedef __bf16 bf16x2_t __attribute__((ext_vector_type(2)));
__device__ __forceinline__ unsigned cvtpk_s(float lo, float hi) { f32x2_t v = {lo, hi}; bf16x2_t b = __builtin_convertvector(v, bf16x2_t); return __builtin_bit_cast(unsigned, b); }
__device__ __forceinline__ float silu_f(float x) { return x * __builtin_amdgcn_rcpf(1.0f + __builtin_amdgcn_exp2f(-1.4426950408889634f * x)); }
__device__ __forceinline__ float sigm_f(float x) { return __builtin_amdgcn_rcpf(1.0f + __builtin_amdgcn_exp2f(-1.4426950408889634f * x)); }
struct EpiSwiGLU {
    static constexpr bool PERM = true, AFTER_DRAIN = false;
    bf16_t* O; int ldc;
    __device__ __forceinline__ void operator()(const f32x4 (&acc)[2][2][4][2], const Unit& u, int wr, int wc, int fr, int fq) const {
        const int row0 = u.pm * BM + wr * 64 + fr, col0 = u.pn * HALF + wc * 32 + 8 * fq;
#pragma unroll
        for (int ai = 0; ai < 2; ++ai)
#pragma unroll
            for (int m = 0; m < 4; ++m) { bf16_t* rowp = O + (size_t)(row0 + ai * HALF + m * 16) * ldc + col0;
                const f32x4 g0 = acc[ai][0][m][0], g1 = acc[ai][0][m][1], u0 = acc[ai][1][m][0], u1 = acc[ai][1][m][1];
                u32x4 w; w.x = cvtpk_s(silu_f(g0[0]) * u0[0], silu_f(g0[1]) * u0[1]); w.y = cvtpk_s(silu_f(g0[2]) * u0[2], silu_f(g0[3]) * u0[3]);
                w.z = cvtpk_s(silu_f(g1[0]) * u1[0], silu_f(g1[1]) * u1[1]); w.w = cvtpk_s(silu_f(g1[2]) * u1[2], silu_f(g1[3]) * u1[3]);
                *(u32x4*)rowp = w; }
    }
};
struct EpiResid {
    static constexpr bool PERM = false, AFTER_DRAIN = false;
    const float* base; float* out; int ldc; float alpha;
    __device__ __forceinline__ void operator()(const f32x4 (&acc)[2][2][4][2], const Unit& u, int wr, int wc, int fr, int fq) const {
        const int row0 = u.pm * BM + wr * 64 + fr, col0 = u.pn * BM + wc * 32 + 4 * fq;
#pragma unroll
        for (int ai = 0; ai < 2; ++ai)
#pragma unroll
            for (int m = 0; m < 4; ++m) { const size_t off = (size_t)(row0 + ai * HALF + m * 16) * ldc + col0;
#pragma unroll
                for (int bj = 0; bj < 2; ++bj)
#pragma unroll
                    for (int n = 0; n < 2; ++n) { const f32x4 bs = *(const f32x4*)(base + off + bj * HALF + n * 16); *(f32x4*)(out + off + bj * HALF + n * 16) = bs + acc[ai][bj][m][n] * alpha; }
                asm volatile("" ::: "memory"); }
    }
};
struct EpiSigmoid {
    static constexpr bool PERM = true, AFTER_DRAIN = false;
    bf16_t* O; int ldc;
    __device__ __forceinline__ void operator()(const f32x4 (&acc)[2][2][4][2], const Unit& u, int wr, int wc, int fr, int fq) const {
        const int row0 = u.pm * BM + wr * 64 + fr, col0 = u.pn * BM + wc * 32 + 8 * fq;
#pragma unroll
        for (int ai = 0; ai < 2; ++ai)
#pragma unroll
            for (int m = 0; m < 4; ++m) { bf16_t* rowp = O + (size_t)(row0 + ai * HALF + m * 16) * ldc + col0;
#pragma unroll
                for (int bj = 0; bj < 2; ++bj) { const f32x4 v0 = acc[ai][bj][m][0], v1 = acc[ai][bj][m][1];
                    u32x4 w; w.x = cvtpk_s(sigm_f(v0[0]), sigm_f(v0[1])); w.y = cvtpk_s(sigm_f(v0[2]), sigm_f(v0[3])); w.z = cvtpk_s(sigm_f(v1[0]), sigm_f(v1[1])); w.w = cvtpk_s(sigm_f(v1[2]), sigm_f(v1[3]));
                    *(u32x4*)(rowp + bj * HALF) = w; } }
    }
};
struct EpiGated {
    static constexpr bool PERM = true, AFTER_DRAIN = false;
    const bf16_t* G; int ldg; int gcol; bf16_t* MG; int ldm; int first;
    __device__ __forceinline__ void operator()(const f32x4 (&acc)[2][2][4][2], const Unit& u, int wr, int wc, int fr, int fq) const {
        const int row0 = u.pm * BM + wr * 64 + fr, col0 = u.pn * BM + wc * 32 + 8 * fq;
#pragma unroll
        for (int ai = 0; ai < 2; ++ai)
#pragma unroll
            for (int m = 0; m < 4; ++m) { const size_t r = (size_t)(row0 + ai * HALF + m * 16);
#pragma unroll
                for (int bj = 0; bj < 2; ++bj) { const f32x4 v0 = acc[ai][bj][m][0], v1 = acc[ai][bj][m][1];
                    const u32x4 g = *(const u32x4*)(G + r * ldg + gcol + col0 + bj * HALF);
                    u32x4 p = (u32x4){0u, 0u, 0u, 0u}; if (!first) p = *(const u32x4*)(MG + r * ldm + col0 + bj * HALF);
#define HY_LO(x) __uint_as_float((x) << 16)
#define HY_HI(x) __uint_as_float((x) & 0xffff0000u)
                    u32x4 w;
                    w.x = cvtpk_s(HY_LO(p.x) + HY_LO(g.x) * v0[0], HY_HI(p.x) + HY_HI(g.x) * v0[1]);
                    w.y = cvtpk_s(HY_LO(p.y) + HY_LO(g.y) * v0[2], HY_HI(p.y) + HY_HI(g.y) * v0[3]);
                    w.z = cvtpk_s(HY_LO(p.z) + HY_LO(g.z) * v1[0], HY_HI(p.z) + HY_HI(g.z) * v1[1]);
                    w.w = cvtpk_s(HY_LO(p.w) + HY_LO(g.w) * v1[2], HY_HI(p.w) + HY_HI(g.w) * v1[3]);
#undef HY_LO
#undef HY_HI
                    *(u32x4*)(MG + r * ldm + col0 + bj * HALF) = w; }
                asm volatile("" ::: "memory"); }
    }
};
}
#define GAS __attribute__((address_space(1)))
#define LAS __attribute__((address_space(3)))
typedef unsigned short bf16;
typedef unsigned v4u __attribute__((ext_vector_type(4)));
typedef float f32x4 __attribute__((ext_vector_type(4)));
typedef short bf16x8 __attribute__((ext_vector_type(8)));
typedef GAS unsigned gu32;
typedef GAS unsigned long long gu64;
#define RLX_AGENT __ATOMIC_RELAXED, __HIP_MEMORY_SCOPE_AGENT
#define LDS_WAIT() asm volatile("s_waitcnt lgkmcnt(0)" ::: "memory")
#define VM_WAIT() asm volatile("s_waitcnt vmcnt(0)" ::: "memory")
__device__ __forceinline__ unsigned long long rt() { return __builtin_amdgcn_s_memrealtime(); }
__device__ __forceinline__ unsigned f2bf(float f) { unsigned u = __builtin_bit_cast(unsigned, f); return (u + 0x7fffu + ((u >> 16) & 1u)) >> 16; }
__device__ __forceinline__ unsigned pk2(float lo, float hi) { return f2bf(lo) | (f2bf(hi) << 16); }

#define XB_TMO      128
#define XB_XCNT(j)  (256  + 64 * (j))
#define XB_XSUB(j)  (1280 + 64 * (j))
#define XB_XGEN(j)  (2304 + 64 * (j))
#define XB_TOP      3328
#define XB_TOPGEN   3392
#define XCD_BAR_WORDS 3456
#define XB_SPIN_CAP (1u << 18)

__device__ __forceinline__ unsigned xb_ld(unsigned* p)              { return __hip_atomic_load(p, __ATOMIC_RELAXED, __HIP_MEMORY_SCOPE_AGENT); }
__device__ __forceinline__ unsigned xb_add(unsigned* p, unsigned v) { return __hip_atomic_fetch_add(p, v, __ATOMIC_RELAXED, __HIP_MEMORY_SCOPE_AGENT); }
__device__ __forceinline__ unsigned xb_xcc_id() { return (unsigned)__builtin_amdgcn_s_getreg((3 << 11) | 20) & 0xFu; }
#define XB_SPIN(cond, bar) do { unsigned _sp = 0; while (cond) { __builtin_amdgcn_s_sleep(1); \
    if ((++_sp & 255u) == 0u) { if (xb_ld(&(bar)[XB_TMO])) break; if (_sp > XB_SPIN_CAP) { atomicAdd(&(bar)[XB_TMO], 1u); break; } } } } while (0)

struct XcdBarrier {
    unsigned* bar; unsigned x;
    volatile LAS unsigned* st;
};

__device__ __forceinline__ XcdBarrier xcd_barrier_post(unsigned* bar, volatile LAS unsigned* st) {
    XcdBarrier b; b.bar = bar; b.x = xb_xcc_id(); b.st = st;
    if (threadIdx.x == 0) (void)xb_add(&bar[XB_XCNT(b.x)], 1u);
    return b;
}
__device__ __forceinline__ void xcd_barrier_complete(unsigned* bar, unsigned x, unsigned& nloc, unsigned& nx) {
    const unsigned G = gridDim.x * gridDim.y * gridDim.z;
    unsigned sum, cnt, mine, sp = 0u;
    for (;;) {
        sum = 0u; cnt = 0u; mine = 0u;
#pragma unroll
        for (unsigned j = 0; j < 16; ++j) { const unsigned c = xb_ld(&bar[XB_XCNT(j)]); sum += c; cnt += (c > 0u) ? 1u : 0u; mine = (j == x) ? c : mine; }
        if (sum == G) break;
        __builtin_amdgcn_s_sleep(1);
        if ((++sp & 255u) == 0u) { if (xb_ld(&bar[XB_TMO])) break; if (sp > XB_SPIN_CAP) { atomicAdd(&bar[XB_TMO], 1u); break; } }
    }
    nloc = mine > 0u ? mine : 1u; nx = cnt > 0u ? cnt : 1u;
}

__device__ __forceinline__ void xcd_barrier(const XcdBarrier& b) {
    asm volatile("s_waitcnt vmcnt(0)" ::: "memory");
    __syncthreads();
    if (threadIdx.x == 0) {
        unsigned* bar = b.bar;
        __builtin_amdgcn_s_waitcnt(0);
        unsigned nloc = b.st[0], nx = b.st[1];
        if (nloc == 0u) { xcd_barrier_complete(bar, b.x, nloc, nx); b.st[0] = nloc; b.st[1] = nx; }
        const unsigned old = xb_add(&bar[XB_XSUB(b.x)], 1u);
        const unsigned gen = old / nloc;
        if (old + 1u == (gen + 1u) * nloc) {
            __builtin_amdgcn_fence(__ATOMIC_RELEASE, "agent");
            asm volatile("s_waitcnt vmcnt(0)" ::: "memory");
            const unsigned og = xb_add(&bar[XB_TOP], 1u);
            const unsigned tg = og / nx;
            if (og + 1u == (tg + 1u) * nx) xb_add(&bar[XB_TOPGEN], 1u);
            else XB_SPIN(xb_ld(&bar[XB_TOPGEN]) == tg, bar);
            __builtin_amdgcn_fence(__ATOMIC_ACQUIRE, "agent");
            xb_add(&bar[XB_XGEN(b.x)], 1u);
            asm volatile("s_waitcnt vmcnt(0)" ::: "memory");
        } else {
            XB_SPIN(xb_ld(&bar[XB_XGEN(b.x)]) == gen, bar);
            __builtin_amdgcn_fence(__ATOMIC_ACQUIRE, "agent");
            asm volatile("s_waitcnt vmcnt(0)" ::: "memory");
        }
    }
    __syncthreads();
}

typedef float f32x16 __attribute__((ext_vector_type(16)));
constexpr int NWAVES = 8, NTHREADS = 512;
constexpr int BATCH = 4, SEQ = 8192, DM = 1024, M = BATCH * SEQ, FF = 2816, NGU = 2 * FF, DIN = 2752, DINP = 2816, NGATE = 3072, DEPTH = 2;
constexpr float NORM_EPS = 1e-6f;
constexpr float QSCALE = 0.125f * 1.4426950408889634f;
constexpr int C_SBQ = 0, C_SBK = 256, C_SBV = 512, C_NQ = 768, C_NKC = 1280, C_NVC = 1408, C_NKS = 1536, C_NVS = 1664, C_NKW = 1792, C_NVW = 1920, C_NG = 2048,
              C_DQ = 2072, C_DK = 2328, C_DV = 2392, C_IQ = 2456, C_IK = 2712, C_IW = 2744;
constexpr size_t MiB = 1u << 20;
constexpr size_t WS_CTL = 0, CTL_ZERO_BYTES = 1 * MiB;
constexpr size_t WS_TAB = 1 * MiB, TAB_CS_MAIN = 0, TAB_CS_IDX = 524288, TAB_CS_CMP = 786432, TAB_BIASPE = 819200;
constexpr size_t WS_W = 2 * MiB, WL_STRIDE = 50 * MiB;
constexpr size_t W_GU1 = 0, W_DN1 = 11534336, W_IN = 17301504, W_GATE = 23068672, W_BRA = 29360128, W_BRB = 29884416, W_BRC = 30932992, W_OUT = 31457280,
                 W_GU2 = 33554432, W_DN2 = 45088768, W_C1 = 50855936, W_C2 = 51904512, W_LEND = 51937280;
static_assert(W_LEND <= WL_STRIDE, "weights per layer");
constexpr size_t WS_XN = 102 * MiB;
constexpr size_t WS_R1 = 166 * MiB;
constexpr size_t WS_OA = 358 * MiB, WS_OB = 374 * MiB, WS_OC = 406 * MiB;
constexpr size_t WS_KC = 422 * MiB, WS_VC = WS_KC + 524288;
constexpr size_t WS_SEL = 423 * MiB;
constexpr size_t WS_IDX = 424 * MiB;
constexpr size_t WS_END = 440 * MiB;
constexpr int CW_BAR = 4096;
constexpr int RING_BYTES = 131072;
constexpr int LDS_BYTES = 147456;
constexpr int MISC_OFF = LDS_BYTES - 256;

#define CAS __attribute__((address_space(4)))
#define HY_IN(F_, k_) ((const float*)(const GAS float*)(F_).kin[k_])
struct Frame {
    unsigned char* lds;
    int tid, lane, wave, G, bid;
    const CAS unsigned long long* kin; GAS float* out; GAS unsigned char* ws;
};
__device__ __forceinline__ Frame fr_fresh(unsigned char* lds, int wave_s) {
    Frame F; F.lds = lds;
    int wv = wave_s; asm volatile("" : "+s"(wv));
    int lane = (int)__builtin_amdgcn_mbcnt_hi(~0u, __builtin_amdgcn_mbcnt_lo(~0u, 0u)); asm volatile("" : "+v"(lane));
    F.lane = lane; F.wave = wv; F.tid = wv * 64 + lane;
    const CAS unsigned long long* kin = (const CAS unsigned long long*)__builtin_amdgcn_kernarg_segment_ptr(); asm volatile("" : "+s"(kin));
    F.kin = kin; F.out = (GAS float*)kin[21]; F.ws = (GAS unsigned char*)kin[22];
    int G = gridDim.x, bid = blockIdx.x; asm volatile("" : "+s"(G), "+s"(bid));
    F.G = G; F.bid = bid;
    return F;
}
__device__ __forceinline__ float wave_sum(float v) {
#pragma unroll
    for (int o = 1; o < 64; o <<= 1) v += __shfl_xor(v, o);
    return v;
}
__device__ __forceinline__ float wave_max(float v) {
#pragma unroll
    for (int o = 1; o < 64; o <<= 1) v = fmaxf(v, __shfl_xor(v, o));
    return v;
}
__device__ __forceinline__ float bf2f(unsigned short h) { return __uint_as_float((unsigned)h << 16); }
__device__ __forceinline__ float bflo(unsigned w) { return __uint_as_float(w << 16); }
__device__ __forceinline__ float bfhi(unsigned w) { return __uint_as_float(w & 0xffff0000u); }
__device__ __forceinline__ bf16* wl_ptr(const Frame& F, int l, size_t off) { return (bf16*)(F.ws + WS_W + (size_t)l * WL_STRIDE + off); }

__device__ __forceinline__ void transpose_item(const float* W, int K, int N, bf16* WT, int mode, float* scr, int item, int lane) {
    const int nblk = N / 32, kb = item / nblk, nb = item % nblk, k0 = 64 * kb, n0 = 32 * nb;
    int drow = n0;
    if (mode == 1) drow = (n0 < FF) ? (n0 / 128) * 256 + (n0 % 128) : ((n0 - FF) / 128) * 256 + 128 + ((n0 - FF) % 128);
#pragma unroll 8
    for (int i = 0; i < 32; ++i) { const int kk = 2 * i + (lane >> 5); scr[kk * 33 + (lane & 31)] = W[(size_t)(k0 + kk) * N + n0 + (lane & 31)]; }
    LDS_WAIT(); asm volatile("" ::: "memory");
    const int c = lane & 7;
#pragma unroll
    for (int j = 0; j < 4; ++j) { const int n = (lane >> 3) + 8 * j; const float* s = scr + (8 * c) * 33 + n;
        v4u o; o.x = pk2(s[0 * 33], s[1 * 33]); o.y = pk2(s[2 * 33], s[3 * 33]); o.z = pk2(s[4 * 33], s[5 * 33]); o.w = pk2(s[6 * 33], s[7 * 33]);
        *(v4u*)(WT + (size_t)(drow + n) * K + k0 + 8 * c) = o; }
    LDS_WAIT(); asm volatile("" ::: "memory");
}
#define HY_TR(src, K_, N_, dst, mode) do { const int items_ = ((K_) / 64) * ((N_) / 32); for (int it_ = gw; it_ < items_; it_ += NGW) transpose_item((src), (K_), (N_), (dst), (mode), scr, it_, F.lane); } while (0)
__device__ __forceinline__ void p0_prologue(Frame& F) {
    float* scr = (float*)(F.lds + F.wave * 16384);
    const int gw = F.bid * NWAVES + F.wave, NGW = F.G * NWAVES;
    for (int l = 0; l < DEPTH; ++l) {
        HY_TR(HY_IN(F, 2) + (size_t)l * DM * NGU, DM, NGU, wl_ptr(F, l, W_GU1), 1);
        HY_TR(HY_IN(F, 3) + (size_t)l * FF * DM, FF, DM, wl_ptr(F, l, W_DN1), 0);
        HY_TR(HY_IN(F, 5) + (size_t)l * DM * DIN, DM, DIN, wl_ptr(F, l, W_IN), 0);
        HY_TR(HY_IN(F, 6) + (size_t)l * DM * NGATE, DM, NGATE, wl_ptr(F, l, W_GATE), 0);
        HY_TR(HY_IN(F, 14) + (size_t)l * 256 * DM, 256, DM, wl_ptr(F, l, W_BRA), 0);
        HY_TR(HY_IN(F, 15) + (size_t)l * 512 * DM, 512, DM, wl_ptr(F, l, W_BRB), 0);
        HY_TR(HY_IN(F, 16) + (size_t)l * 256 * DM, 256, DM, wl_ptr(F, l, W_BRC), 0);
        HY_TR(HY_IN(F, 17) + (size_t)l * DM * DM, DM, DM, wl_ptr(F, l, W_OUT), 0);
        HY_TR(HY_IN(F, 19) + (size_t)l * DM * NGU, DM, NGU, wl_ptr(F, l, W_GU2), 1);
        HY_TR(HY_IN(F, 20) + (size_t)l * FF * DM, FF, DM, wl_ptr(F, l, W_DN2), 0);
        for (int kv = 0; kv < 2; ++kv) {
            HY_TR(HY_IN(F, 10) + ((size_t)l * 2 + kv) * 2048 * 128, 2048, 128, wl_ptr(F, l, W_C1) + (size_t)kv * 128 * 2048, 0);
            HY_TR(HY_IN(F, 11) + ((size_t)l * 2 + kv) * 128 * 64, 128, 64, wl_ptr(F, l, W_C2) + (size_t)kv * 64 * 128, 0);
        }
        { v4u* z = (v4u*)(wl_ptr(F, l, W_IN) + (size_t)DIN * DM); const int n16 = (DINP - DIN) * DM * 2 / 16;
          for (int i = (F.bid * NTHREADS + F.tid); i < n16; i += F.G * NTHREADS) z[i] = (v4u){0u, 0u, 0u, 0u}; }
    }
    { float* tm = (float*)(F.ws + WS_TAB + TAB_CS_MAIN); float* ti = (float*)(F.ws + WS_TAB + TAB_CS_IDX); float* tc = (float*)(F.ws + WS_TAB + TAB_CS_CMP);
      const int gt = F.bid * NTHREADS + F.tid, NGT = F.G * NTHREADS;
      for (int e = gt; e < SEQ * 8; e += NGT) { const int t = e >> 3, i = e & 7; const float inv = (float)pow(500000.0, -(double)i / 8.0); const float ang = (float)t * inv;
          tm[2 * e] = (float)cos((double)ang); tm[2 * e + 1] = (float)sin((double)ang); }
      for (int e = gt; e < SEQ * 4; e += NGT) { const int t = e >> 2, i = e & 3; const float inv = (float)pow(500000.0, -(double)i / 4.0); const float ang = (float)t * inv;
          ti[2 * e] = (float)cos((double)ang); ti[2 * e + 1] = (float)sin((double)ang); }
      for (int e = gt; e < 512 * 8; e += NGT) { const int c = e >> 3, i = e & 7; const float inv = (float)pow(500000.0, -(double)i / 8.0); const float ang = (float)(16 * c + 31) * inv;
          tc[2 * e] = (float)cos((double)ang); tc[2 * e + 1] = (float)sin((double)ang); }
    }
    { float* bp = (float*)(F.ws + WS_TAB + TAB_BIASPE);
      for (int o = gw; o < DEPTH * 2 * 128; o += NGW) { const int lk = o >> 7, n = o & 127; const float* pe = HY_IN(F, 9) + (size_t)lk * 2048; const float* w1 = HY_IN(F, 10) + (size_t)lk * 2048 * 128;
          float s = 0.f; for (int k = F.lane; k < 2048; k += 64) s += pe[k] * w1[(size_t)k * 128 + n];
          s = wave_sum(s); if (F.lane == 0) bp[o] = s; } }
}
__device__ __forceinline__ void norm_phase(Frame& F, const float* X, const float* g, bf16* XN) {
    const int gw = F.bid * NWAVES + F.wave, NGW = F.G * NWAVES;
    f32x4 gv[4];
#pragma unroll
    for (int j = 0; j < 4; ++j) gv[j] = ((const f32x4*)g)[F.lane + 64 * j];
    for (int m = gw; m < M; m += NGW) {
        const f32x4* xr = (const f32x4*)(X + (size_t)m * DM) + F.lane;
        f32x4 v[4]; float s = 0.f;
#pragma unroll
        for (int j = 0; j < 4; ++j) { v[j] = xr[64 * j]; s += (v[j].x * v[j].x + v[j].y * v[j].y) + (v[j].z * v[j].z + v[j].w * v[j].w); }
        const float rstd = rsqrtf(wave_sum(s) * (1.f / DM) + NORM_EPS);
        unsigned long long* o8 = (unsigned long long*)(XN + (size_t)m * DM) + F.lane;
#pragma unroll
        for (int j = 0; j < 4; ++j) o8[64 * j] = (unsigned long long)pk2(v[j].x * rstd * gv[j].x, v[j].y * rstd * gv[j].y) | ((unsigned long long)pk2(v[j].z * rstd * gv[j].z, v[j].w * rstd * gv[j].w) << 32);
    }
}

__device__ __forceinline__ void prep_phase(Frame& F, int l) {
    const int gw = F.bid * NWAVES + F.wave, NGW = F.G * NWAVES, lane = F.lane;
    bf16* PROJ = (bf16*)(F.ws + WS_R1);
    const float* cs_main = (const float*)(F.ws + WS_TAB + TAB_CS_MAIN); const float* cs_idx = (const float*)(F.ws + WS_TAB + TAB_CS_IDX);
    const float g_nq = HY_IN(F, 7)[l * 64 + lane], g_ks = HY_IN(F, 8)[(l * 3 + 1) * 64 + lane], g_kw = HY_IN(F, 8)[(l * 3 + 2) * 64 + lane], g_dq = HY_IN(F, 12)[l * 64 + lane], g_dk = HY_IN(F, 13)[l * 64 + lane];
    for (int m = gw; m < M; m += NGW) {
        const int t = m & (SEQ - 1); bf16* p = PROJ + (size_t)m * DINP;
        const int ri = lane & 7; const float rc = cs_main[(t * 8 + ri) * 2], rs = cs_main[(t * 8 + ri) * 2 + 1];
#pragma unroll 1
        for (int v = 0; v < 17; ++v) {
            int col; float gain, post = 1.f;
            if (v < 8) { col = C_NQ + 64 * v; gain = g_nq; post = QSCALE; }
            else if (v < 10) { col = C_NKS + 64 * (v - 8); gain = g_ks; }
            else if (v < 12) { col = C_NKW + 64 * (v - 10); gain = g_kw; }
            else if (v < 16) { col = C_DQ + 64 * (v - 12); gain = g_dq; post = QSCALE; }
            else { col = C_DK; gain = g_dk; }
            const float x = bf2f(p[col + lane]);
            const float ss = wave_sum(x * x);
            float y = x * rsqrtf(ss * (1.f / 64.f) + NORM_EPS) * gain;
            const float pr = __shfl_xor(y, 8);
            if (lane < 8) y = y * rc - pr * rs; else if (lane < 16) y = y * rc + pr * rs;
            p[col + lane] = (bf16)f2bf(y * post);
        }
        { const int hh = lane >> 3, dd = lane & 7, i4 = dd & 3; const float c = cs_idx[(t * 4 + i4) * 2], s = cs_idx[(t * 4 + i4) * 2 + 1];
          const float x = bf2f(p[C_IQ + 32 * hh + dd]); const float pr = __shfl_xor(x, 4);
          const float y = (dd < 4) ? x * c - pr * s : x * c + pr * s; p[C_IQ + 32 * hh + dd] = (bf16)f2bf(y);
          const float xk = bf2f(p[C_IK + (lane & 7)]); const float prk = __shfl_xor(xk, 4);
          const float yk = (dd < 4) ? xk * c - prk * s : xk * c + prk * s; if (lane < 8) p[C_IK + lane] = (bf16)f2bf(yk); }
    }
}

#define MFMA16(a, b, c) __builtin_amdgcn_mfma_f32_16x16x32_bf16((a), (b), (c), 0, 0, 0)
#define MFMA32(a, b, c) __builtin_amdgcn_mfma_f32_32x32x16_bf16((a), (b), (c), 0, 0, 0)
__device__ __forceinline__ void cmp_phase(Frame& F, int l) {
    const int gw = F.bid * NWAVES + F.wave, NGW = F.G * NWAVES, lane = F.lane, r = lane & 15, q = lane >> 4;
    const bf16* PROJ = (const bf16*)(F.ws + WS_R1); bf16* KC = (bf16*)(F.ws + WS_KC); bf16* VC = (bf16*)(F.ws + WS_VC);
    const bf16* W1 = wl_ptr(F, l, W_C1); const bf16* W2 = wl_ptr(F, l, W_C2);
    const float* bp = (const float*)(F.ws + WS_TAB + TAB_BIASPE) + l * 256; const float* cs_cmp = (const float*)(F.ws + WS_TAB + TAB_CS_CMP);
    const float* kn0 = HY_IN(F, 8) + (size_t)(l * 3 + 0) * 64;
    bf16* Hs = (bf16*)(F.lds + F.wave * 8192);
    for (int task = gw; task < 512; task += NGW) {
        const int kv = task >> 8, rem = task & 255, bg = rem >> 5, ct = rem & 31, b = bg >> 1, g = bg & 1;
        int c_r = 16 * ct + r; if (c_r > 510) c_r = 510;
        const bf16* arow = PROJ + ((size_t)b * SEQ + 16 * c_r) * DINP + (kv ? C_NVC : C_NKC) + g * 64 + 8 * q;
        const bf16* w1 = W1 + (size_t)kv * 128 * 2048 + (size_t)r * 2048 + 8 * q;
        f32x4 acc[8];
#pragma unroll
        for (int nt = 0; nt < 8; ++nt) acc[nt] = (f32x4){0.f, 0.f, 0.f, 0.f};
#pragma unroll 2
        for (int ks = 0; ks < 64; ++ks) {
            const bf16x8 a = *(const bf16x8*)(arow + (size_t)(ks >> 1) * DINP + (ks & 1) * 32);
#pragma unroll
            for (int nt = 0; nt < 8; ++nt) { const bf16x8 bb = *(const bf16x8*)(w1 + (size_t)nt * 16 * 2048 + 32 * ks); acc[nt] = MFMA16(a, bb, acc[nt]); }
        }
#pragma unroll
        for (int nt = 0; nt < 8; ++nt) { const float bias = bp[kv * 128 + 16 * nt + r];
#pragma unroll
            for (int e = 0; e < 4; ++e) Hs[(4 * q + e) * 136 + 16 * nt + r] = (bf16)f2bf(pg8::silu_f(acc[nt][e] + bias)); }
        LDS_WAIT(); asm volatile("" ::: "memory");
        f32x4 acc2[4];
#pragma unroll
        for (int n2 = 0; n2 < 4; ++n2) acc2[n2] = (f32x4){0.f, 0.f, 0.f, 0.f};
#pragma unroll
        for (int s = 0; s < 4; ++s) { const bf16x8 a = *(const bf16x8*)(Hs + r * 136 + 32 * s + 8 * q);
#pragma unroll
            for (int n2 = 0; n2 < 4; ++n2) { const bf16x8 bb = *(const bf16x8*)(W2 + (size_t)kv * 64 * 128 + (size_t)(16 * n2 + r) * 128 + 32 * s + 8 * q); acc2[n2] = MFMA16(a, bb, acc2[n2]); } }
        LDS_WAIT(); asm volatile("" ::: "memory");
        bf16* dst = kv ? VC : KC;
#pragma unroll
        for (int e = 0; e < 4; ++e) {
            const int c = 16 * ct + 4 * q + e;
            float y[4];
#pragma unroll
            for (int n2 = 0; n2 < 4; ++n2) y[n2] = acc2[n2][e];
            if (kv == 0) {
                float ss = (y[0] * y[0] + y[1] * y[1]) + (y[2] * y[2] + y[3] * y[3]);
                ss += __shfl_xor(ss, 1); ss += __shfl_xor(ss, 2); ss += __shfl_xor(ss, 4); ss += __shfl_xor(ss, 8);
                const float rstd = rsqrtf(ss * (1.f / 64.f) + NORM_EPS);
#pragma unroll
                for (int n2 = 0; n2 < 4; ++n2) y[n2] = y[n2] * rstd * kn0[16 * n2 + r];
                const float pr = __shfl_xor(y[0], 8); const int ri = r & 7; const float cc = cs_cmp[(c * 8 + ri) * 2], sn = cs_cmp[(c * 8 + ri) * 2 + 1];
                y[0] = (r < 8) ? y[0] * cc - pr * sn : y[0] * cc + pr * sn;
            }
#pragma unroll
            for (int n2 = 0; n2 < 4; ++n2) dst[((size_t)bg * 512 + c) * 64 + 16 * n2 + r] = (c == 511) ? (bf16)0 : (bf16)f2bf(y[n2]);
        }
    }
}

__device__ __forceinline__ void sb_phase(Frame& F) {
    const int gw = F.bid * NWAVES + F.wave, NGW = F.G * NWAVES, lane = F.lane;
    const bf16* PROJ = (const bf16*)(F.ws + WS_R1); bf16* OA = (bf16*)(F.ws + WS_OA);
    bf16* Ks = (bf16*)(F.lds + F.wave * 16384); bf16* Vs = Ks + 4096;
    for (int task = gw; task < 2048; task += NGW) {
        const int qt = task & 127, bh = task >> 7, b = bh >> 2, h = bh & 3;
        const int t = qt * 64 + lane; const size_t m = (size_t)b * SEQ + t;
        float q[64], o[64];
        { const uint4* qp = (const uint4*)(PROJ + m * DINP + C_SBQ + 64 * h);
#pragma unroll
          for (int c = 0; c < 8; ++c) { const uint4 w = qp[c]; q[8 * c] = bflo(w.x); q[8 * c + 1] = bfhi(w.x); q[8 * c + 2] = bflo(w.y); q[8 * c + 3] = bfhi(w.y); q[8 * c + 4] = bflo(w.z); q[8 * c + 5] = bfhi(w.z); q[8 * c + 6] = bflo(w.w); q[8 * c + 7] = bfhi(w.w); } }
#pragma unroll
        for (int d = 0; d < 64; ++d) o[d] = 0.f;
        float carry = 0.f;
        for (int kt = qt; kt >= 0; --kt) {
            const size_t rb = (size_t)b * SEQ + (size_t)kt * 64;
#pragma unroll 2
            for (int i = 0; i < 8; ++i) { const int row = 8 * i + (lane >> 3), ch = lane & 7;
                const uint4 kk = *(const uint4*)(PROJ + (rb + row) * DINP + C_SBK + 64 * h + 8 * ch); const uint4 vv = *(const uint4*)(PROJ + (rb + row) * DINP + C_SBV + 64 * h + 8 * ch);
                *(uint4*)(Ks + row * 64 + 8 * ch) = kk; *(uint4*)(Vs + row * 64 + 8 * ch) = vv; }
            LDS_WAIT(); asm volatile("" ::: "memory");
#pragma unroll 1
            for (int j = 63; j >= 0; --j) {
                const int s = kt * 64 + j;
                float z0 = 0.f, z1 = 0.f;
#pragma unroll
                for (int c = 0; c < 8; ++c) { const uint4 w = *(const uint4*)(Ks + j * 64 + 8 * c);
                    z0 += q[8 * c] * bflo(w.x) + q[8 * c + 2] * bflo(w.y) + q[8 * c + 4] * bflo(w.z) + q[8 * c + 6] * bflo(w.w);
                    z1 += q[8 * c + 1] * bfhi(w.x) + q[8 * c + 3] * bfhi(w.y) + q[8 * c + 5] * bfhi(w.z) + q[8 * c + 7] * bfhi(w.w); }
                const float z = (z0 + z1) * 0.125f;
                const bool act = s < t;
                const float sp = fmaxf(z, 0.f) + __logf(1.f + __expf(-fabsf(z)));
                const float wgt = act ? __expf(z - sp + carry) : 0.f;
                carry = act ? carry - sp : carry;
#pragma unroll
                for (int c = 0; c < 8; ++c) { const uint4 w = *(const uint4*)(Vs + j * 64 + 8 * c);
                    o[8 * c] += wgt * bflo(w.x); o[8 * c + 1] += wgt * bfhi(w.x); o[8 * c + 2] += wgt * bflo(w.y); o[8 * c + 3] += wgt * bfhi(w.y);
                    o[8 * c + 4] += wgt * bflo(w.z); o[8 * c + 5] += wgt * bfhi(w.z); o[8 * c + 6] += wgt * bflo(w.w); o[8 * c + 7] += wgt * bfhi(w.w); }
            }
            LDS_WAIT(); asm volatile("" ::: "memory");
            if (__all(carry < -88.f)) break;
        }
        { uint4* op = (uint4*)(OA + m * 256 + 64 * h);
#pragma unroll
          for (int c = 0; c < 8; ++c) { uint4 w; w.x = pk2(o[8 * c], o[8 * c + 1]); w.y = pk2(o[8 * c + 2], o[8 * c + 3]); w.z = pk2(o[8 * c + 4], o[8 * c + 5]); w.w = pk2(o[8 * c + 6], o[8 * c + 7]); op[c] = w; } }
    }
}

__device__ __forceinline__ void nsa_unit(int u, int& bg, int& tile) {
    const int i = u >> 8, v = u & 255, j = v & 31; bg = v >> 5;
    tile = (i == 0) ? j : (i == 1) ? 63 - j : (i == 2) ? 64 + j : 127 - j;
}
__device__ __forceinline__ void nsa1_phase(Frame& F) {
    const int lane = F.lane, wave = F.wave;
    const bf16* PROJ = (const bf16*)(F.ws + WS_R1); const bf16* KCg = (const bf16*)(F.ws + WS_KC); const bf16* VCg = (const bf16*)(F.ws + WS_VC);
    bf16* OB = (bf16*)(F.ws + WS_OB); unsigned long long* SEL = (unsigned long long*)(F.ws + WS_SEL);
    bf16* Kc = (bf16*)F.lds;
    unsigned char* wb = F.lds + 73728 + wave * 8192;
    float* Qs = (float*)wb; float* Aw = (float*)(wb + 1024); uint2* P4 = (uint2*)(wb + 3072); float* SC = (float*)(wb + 7168);
    for (int u = F.bid; u < 1024; u += F.G) {
        int bg, tile; nsa_unit(u, bg, tile); const int b = bg >> 1, g = bg & 1, t0 = tile * 64;
        const int tl = t0 + 63; const int ncv = (tl >= 31) ? ((tl - 31) >> 4) + 1 : 0;
        for (int i = F.tid; i < ncv * 8; i += NTHREADS) { const int row = i >> 3, ch = i & 7; *(uint4*)(Kc + row * 72 + 8 * ch) = *(const uint4*)(KCg + ((size_t)bg * 512 + row) * 64 + 8 * ch); }
        __syncthreads();
#pragma unroll 1
        for (int tk = 0; tk < 8; ++tk) {
            const int t = t0 + 8 * wave + tk; const size_t m = (size_t)b * SEQ + t;
            const int nv = (t >= 31) ? ((t - 31) >> 4) + 1 : 0;
#pragma unroll
            for (int h = 0; h < 4; ++h) Qs[h * 64 + lane] = bf2f(PROJ[m * DINP + C_NQ + (4 * g + h) * 64 + lane]);
            LDS_WAIT(); asm volatile("" ::: "memory");
            float s[4][8];
            const int ni = (nv + 63) >> 6;
#pragma unroll
            for (int i = 0; i < 8; ++i) {
                float a0 = 0.f, a1 = 0.f, a2 = 0.f, a3 = 0.f;
                if (i < ni) {
                    const int c = lane + 64 * i;
#pragma unroll
                    for (int ch = 0; ch < 8; ++ch) { const uint4 w = *(const uint4*)(Kc + c * 72 + 8 * ch);
                        const float k0 = bflo(w.x), k1 = bfhi(w.x), k2 = bflo(w.y), k3 = bfhi(w.y), k4 = bflo(w.z), k5 = bfhi(w.z), k6 = bflo(w.w), k7 = bfhi(w.w);
#define HY_DOT(acc_, h_) { const float4 qa = *(const float4*)(Qs + (h_) * 64 + 8 * ch), qb = *(const float4*)(Qs + (h_) * 64 + 8 * ch + 4); \
                        acc_ += (k0 * qa.x + k1 * qa.y) + (k2 * qa.z + k3 * qa.w) + (k4 * qb.x + k5 * qb.y) + (k6 * qb.z + k7 * qb.w); }
                        HY_DOT(a0, 0) HY_DOT(a1, 1) HY_DOT(a2, 2) HY_DOT(a3, 3)
#undef HY_DOT
                    }
                }
                s[0][i] = a0; s[1][i] = a1; s[2][i] = a2; s[3][i] = a3;
            }
#pragma unroll
            for (int h = 0; h < 4; ++h) {
                float mx = -1e30f;
#pragma unroll
                for (int i = 0; i < 8; ++i) { const bool valid = (lane + 64 * i) < nv; mx = fmaxf(mx, valid ? s[h][i] : -1e30f); }
                mx = wave_max(mx); float sum = 0.f;
#pragma unroll
                for (int i = 0; i < 8; ++i) { const bool valid = (lane + 64 * i) < nv; const float p = valid ? __builtin_amdgcn_exp2f(s[h][i] - mx) : 0.f; s[h][i] = p; sum += p; }
                sum = wave_sum(sum); const float inv = (nv > 0) ? 1.f / sum : 0.f;
#pragma unroll
                for (int i = 0; i < 8; ++i) s[h][i] *= inv;
            }
#pragma unroll
            for (int i = 0; i < 8; ++i) { const int c = lane + 64 * i; Aw[c] = (s[0][i] + s[1][i]) + (s[2][i] + s[3][i]); P4[c] = make_uint2(pk2(s[0][i], s[1][i]), pk2(s[2][i], s[3][i])); }
            LDS_WAIT(); asm volatile("" ::: "memory");
            float sc0, sc1; const int cur = t >> 6;
            { const int n0 = lane, n1 = lane + 64;
              float i0 = (Aw[4 * n0] + Aw[4 * n0 + 1]) + (Aw[4 * n0 + 2] + Aw[4 * n0 + 3]); if (n0 > 0) i0 += Aw[4 * n0 - 1];
              float i1 = (Aw[4 * n1] + Aw[4 * n1 + 1]) + (Aw[4 * n1 + 2] + Aw[4 * n1 + 3]) + Aw[4 * n1 - 1];
              const bool f0 = (n0 == 0) || (n0 == cur) || (n0 == cur - 1), f1 = (n1 == cur) || (n1 == cur - 1);
              sc0 = (n0 * 64 <= t) ? (f0 ? 1.0e4f : i0) : -INFINITY; sc1 = (n1 * 64 <= t) ? (f1 ? 1.0e4f : i1) : -INFINITY;
              SC[n0] = sc0; SC[n1] = sc1; }
            LDS_WAIT(); asm volatile("" ::: "memory");
            int r0 = 0, r1 = 0;
#pragma unroll 8
            for (int j = 0; j < 128; ++j) { const float v = SC[j];
                r0 += ((v > sc0) || (v == sc0 && j < lane)) ? 1 : 0; r1 += ((v > sc1) || (v == sc1 && j < lane + 64)) ? 1 : 0; }
            const unsigned long long m0 = __ballot(r0 < 16), m1 = __ballot(r1 < 16);
            if (lane == 0) { SEL[((size_t)bg * SEQ + t) * 2] = m0; SEL[((size_t)bg * SEQ + t) * 2 + 1] = m1; }
            float o0 = 0.f, o1 = 0.f, o2 = 0.f, o3 = 0.f;
            const bf16* vp = VCg + (size_t)bg * 512 * 64 + lane;
#pragma unroll 4
            for (int c = 0; c < nv; ++c) { const uint2 pw = P4[c]; const float v = bf2f(vp[(size_t)c * 64]);
                o0 += bflo(pw.x) * v; o1 += bfhi(pw.x) * v; o2 += bflo(pw.y) * v; o3 += bfhi(pw.y) * v; }
            const bf16* gp = PROJ + m * DINP + C_NG + (4 * g) * 3;
            bf16* op = OB + m * 512 + (4 * g) * 64 + lane;
            op[0] = (bf16)f2bf(pg8::sigm_f(bf2f(gp[0])) * o0); op[64] = (bf16)f2bf(pg8::sigm_f(bf2f(gp[3])) * o1);
            op[128] = (bf16)f2bf(pg8::sigm_f(bf2f(gp[6])) * o2); op[192] = (bf16)f2bf(pg8::sigm_f(bf2f(gp[9])) * o3);
            LDS_WAIT(); asm volatile("" ::: "memory");
        }
        __syncthreads();
    }
}

struct FlashState { float m, l; f32x16 o0, o1; };
__device__ __forceinline__ bf16x8 pack8(const f32x16& p, int base) {
    v4u w; w.x = pk2(p[base], p[base + 1]); w.y = pk2(p[base + 2], p[base + 3]); w.z = pk2(p[base + 4], p[base + 5]); w.w = pk2(p[base + 6], p[base + 7]);
    return __builtin_bit_cast(bf16x8, w);
}
__device__ __forceinline__ void flash_tile(const bf16* Kt, const bf16* Vt, const bf16x8 (&qf)[4], FlashState& st, int r, int hf, int key0, int t, int lo_excl, bool allow) {
    f32x16 s0, s1;
#pragma unroll
    for (int i = 0; i < 16; ++i) { s0[i] = 0.f; s1[i] = 0.f; }
#pragma unroll
    for (int s = 0; s < 4; ++s) { const bf16x8 a0 = *(const bf16x8*)(Kt + r * 72 + 16 * s + 8 * hf), a1 = *(const bf16x8*)(Kt + (32 + r) * 72 + 16 * s + 8 * hf);
        s0 = MFMA32(a0, qf[s], s0); s1 = MFMA32(a1, qf[s], s1); }
    float mx = -1e30f;
#pragma unroll
    for (int i = 0; i < 16; ++i) { const int key = key0 + (i & 3) + 8 * (i >> 2) + 4 * hf;
        const bool ok0 = allow && key <= t && key > lo_excl, ok1 = allow && (key + 32) <= t && (key + 32) > lo_excl;
        s0[i] = ok0 ? s0[i] : -1e30f; s1[i] = ok1 ? s1[i] : -1e30f; mx = fmaxf(mx, fmaxf(s0[i], s1[i])); }
    mx = fmaxf(mx, __shfl_xor(mx, 32));
    const float mn = fmaxf(st.m, mx), alpha = __builtin_amdgcn_exp2f(st.m - mn);
    float ps = 0.f;
#pragma unroll
    for (int i = 0; i < 16; ++i) { s0[i] = (s0[i] > -1e29f) ? __builtin_amdgcn_exp2f(s0[i] - mn) : 0.f; s1[i] = (s1[i] > -1e29f) ? __builtin_amdgcn_exp2f(s1[i] - mn) : 0.f; ps += s0[i] + s1[i]; }
    st.l = st.l * alpha + ps; st.m = mn;
#pragma unroll
    for (int i = 0; i < 16; ++i) { st.o0[i] *= alpha; st.o1[i] *= alpha; }
    const bf16x8 p00 = pack8(s0, 0), p01 = pack8(s0, 8), p10 = pack8(s1, 0), p11 = pack8(s1, 8);
    { const bf16* v0 = Vt + r * 72 + 8 * hf; const bf16* v1 = Vt + (32 + r) * 72 + 8 * hf;
      st.o0 = MFMA32(*(const bf16x8*)(v0), p00, st.o0); st.o0 = MFMA32(*(const bf16x8*)(v0 + 16), p01, st.o0); st.o0 = MFMA32(*(const bf16x8*)(v0 + 32), p10, st.o0); st.o0 = MFMA32(*(const bf16x8*)(v0 + 48), p11, st.o0);
      st.o1 = MFMA32(*(const bf16x8*)(v1), p00, st.o1); st.o1 = MFMA32(*(const bf16x8*)(v1 + 16), p01, st.o1); st.o1 = MFMA32(*(const bf16x8*)(v1 + 32), p10, st.o1); st.o1 = MFMA32(*(const bf16x8*)(v1 + 48), p11, st.o1); }
}
__device__ __forceinline__ void nsa2_phase(Frame& F) {
    const int lane = F.lane, wave = F.wave, tid = F.tid, r = lane & 31, hf = lane >> 5, hh = r >> 3, tk = r & 7;
    const bf16* PROJ = (const bf16*)(F.ws + WS_R1); bf16* OB = (bf16*)(F.ws + WS_OB); const unsigned long long* SEL = (const unsigned long long*)(F.ws + WS_SEL);
#define HY_KB(buf) ((bf16*)(F.lds + (buf) * 9216))
#define HY_VB(buf) ((bf16*)(F.lds + 18432 + (buf) * 9216))
    const int skey = tid >> 3, sch = tid & 7, spk = (skey & ~12) | (((skey >> 2) & 1) << 3) | (((skey >> 3) & 1) << 2);
    for (int u = F.bid; u < 1024; u += F.G) {
        int bg, tile; nsa_unit(u, bg, tile); const int b = bg >> 1, g = bg & 1, t0 = tile * 64;
        const int t = t0 + 8 * wave + tk; const size_t m = (size_t)b * SEQ + t;
        bf16x8 qf[4];
#pragma unroll
        for (int s = 0; s < 4; ++s) qf[s] = *(const bf16x8*)(PROJ + m * DINP + C_NQ + (4 * g + hh) * 64 + 16 * s + 8 * hf);
        const unsigned long long sm0 = SEL[((size_t)bg * SEQ + t) * 2], sm1 = SEL[((size_t)bg * SEQ + t) * 2 + 1];
        const float g1 = pg8::sigm_f(bf2f(PROJ[m * DINP + C_NG + (4 * g + hh) * 3 + 1])), g2 = pg8::sigm_f(bf2f(PROJ[m * DINP + C_NG + (4 * g + hh) * 3 + 2]));
        f32x16 res0, res1;
#pragma unroll 1
        for (int ph = 0; ph < 2; ++ph) {
            const int kcol = (ph == 0 ? C_NKS : C_NKW) + 64 * g + 8 * sch, vcol = (ph == 0 ? C_NVS : C_NVW) + 64 * g + 8 * sch;
            const int jlo = (ph == 0) ? 0 : (tile > 8 ? tile - 8 : 0);
            const int lo_excl = (ph == 0) ? -(1 << 30) : t - 512;
            FlashState st; st.m = -1e30f; st.l = 0.f;
#pragma unroll
            for (int i = 0; i < 16; ++i) { st.o0[i] = 0.f; st.o1[i] = 0.f; }
            uint4 kq, vq;
            { const size_t row = (size_t)b * SEQ + (size_t)jlo * 64 + skey; kq = *(const uint4*)(PROJ + row * DINP + kcol); vq = *(const uint4*)(PROJ + row * DINP + vcol); }
#define HY_STAGE(buf) do { *(uint4*)(HY_KB(buf) + skey * 72 + 8 * sch) = kq; bf16* vd_ = HY_VB(buf) + (8 * sch) * 72 + spk; \
            vd_[0] = (bf16)(vq.x & 0xffffu); vd_[72] = (bf16)(vq.x >> 16); vd_[144] = (bf16)(vq.y & 0xffffu); vd_[216] = (bf16)(vq.y >> 16); \
            vd_[288] = (bf16)(vq.z & 0xffffu); vd_[360] = (bf16)(vq.z >> 16); vd_[432] = (bf16)(vq.w & 0xffffu); vd_[504] = (bf16)(vq.w >> 16); } while (0)
            HY_STAGE(0);
            __syncthreads();
#pragma unroll 1
            for (int j = jlo; j <= tile; ++j) {
                const int cb = (j - jlo) & 1;
                if (j < tile) { const size_t row = (size_t)b * SEQ + (size_t)(j + 1) * 64 + skey; kq = *(const uint4*)(PROJ + row * DINP + kcol); vq = *(const uint4*)(PROJ + row * DINP + vcol); }
                const bool allow = (ph == 1) ? true : (j < 64 ? ((sm0 >> j) & 1ull) != 0ull : ((sm1 >> (j - 64)) & 1ull) != 0ull);
                if (__any(allow)) flash_tile(HY_KB(cb), HY_VB(cb), qf, st, r, hf, j * 64, t, lo_excl, allow);
                if (j < tile) { if (cb == 0) HY_STAGE(1); else HY_STAGE(0); }
                __syncthreads();
            }
#undef HY_STAGE
            float lt = st.l + __shfl_xor(st.l, 32);
            const float sc = (ph == 0 ? g1 : g2) / lt;
            if (ph == 0) {
#pragma unroll
                for (int i = 0; i < 16; ++i) { res0[i] = st.o0[i] * sc; res1[i] = st.o1[i] * sc; }
            } else {
#pragma unroll
                for (int i = 0; i < 16; ++i) { res0[i] += st.o0[i] * sc; res1[i] += st.o1[i] * sc; }
            }
        }
        bf16* op = OB + m * 512 + (4 * g + hh) * 64;
#pragma unroll
        for (int i = 0; i < 16; ++i) { const int d = (i & 3) + 8 * (i >> 2) + 4 * hf;
            op[d] = (bf16)f2bf(res0[i] + bf2f(op[d])); op[32 + d] = (bf16)f2bf(res1[i] + bf2f(op[32 + d])); }
    }
}

__device__ __forceinline__ int wave_isum(int v) {
#pragma unroll
    for (int o = 1; o < 64; o <<= 1) v += __shfl_xor(v, o);
    return v;
}
__device__ __forceinline__ void dsa1_phase(Frame& F) {
    const int lane = F.lane, wave = F.wave, tid = F.tid, col = lane & 15, q4 = lane >> 4, tk = col >> 2, hd = col & 3;
    const bf16* PROJ = (const bf16*)(F.ws + WS_R1); unsigned short* IDX = (unsigned short*)(F.ws + WS_IDX);
    unsigned* SCK = (unsigned*)F.lds;
    unsigned* CNT = (unsigned*)(F.lds + RING_BYTES);
    const int nrounds = (8192 + F.G - 1) / F.G;
    for (int rd = 0; rd < nrounds; ++rd) {
        const int unit = rd * F.G + ((rd & 1) ? (F.G - 1 - F.bid) : F.bid);
        if (unit >= 8192) break;
        const int b = unit & 3, t0 = (unit >> 2) * 4; const size_t m0 = (size_t)b * SEQ + t0;
        const int nkt = ((t0 + 3) >> 4) + 1, nk = nkt * 16;
        bf16x8 bq[2]; float wv[2];
#pragma unroll
        for (int hg = 0; hg < 2; ++hg) { bq[hg] = *(const bf16x8*)(PROJ + (m0 + tk) * DINP + C_IQ + 32 * (4 * hg + hd) + 8 * q4); wv[hg] = bf2f(PROJ[(m0 + tk) * DINP + C_IW + 4 * hg + hd]) * 0.0625f; }
        if (tid < 160) CNT[tid] = 0u;
        for (int kt = wave; kt < nkt; kt += NWAVES) {
            const bf16x8 a = *(const bf16x8*)(PROJ + ((size_t)b * SEQ + 16 * kt + col) * DINP + C_IK + 8 * q4);
            const f32x4 z = (f32x4){0.f, 0.f, 0.f, 0.f};
            const f32x4 c0 = MFMA16(a, bq[0], z), c1 = MFMA16(a, bq[1], z);
            float v[4];
#pragma unroll
            for (int e = 0; e < 4; ++e) { float x = fmaxf(c0[e], 0.f) * wv[0] + fmaxf(c1[e], 0.f) * wv[1]; x += __shfl_xor(x, 1); x += __shfl_xor(x, 2); v[e] = x; }
            float mine = (hd == 0) ? v[0] : (hd == 1) ? v[1] : (hd == 2) ? v[2] : v[3];
            if (mine == 0.f) mine = 0.f;
            unsigned uu = __float_as_uint(mine); uu = (uu & 0x80000000u) ? ~uu : (uu | 0x80000000u);
            const int key = 16 * kt + 4 * q4 + hd;
            if (key > t0 + tk) uu = 0u;
            SCK[tk * 8192 + key] = uu;
        }
        __syncthreads();
        const int row = wave >> 1, hfw = wave & 1;
        unsigned key[64];
#pragma unroll
        for (int i = 0; i < 64; ++i) { const int e = hfw * 4096 + 64 * i + lane; key[i] = (e < nk) ? SCK[row * 8192 + e] : 0u; }
        unsigned prefix = 0u;
#pragma unroll 1
        for (int bit = 31; bit >= 0; --bit) {
            const unsigned cand = prefix | (1u << bit);
            int cl = 0;
#pragma unroll
            for (int i = 0; i < 64; ++i) cl += (key[i] >= cand) ? 1 : 0;
            const int cnt = wave_isum(cl);
            if (lane == 0) atomicAdd(&CNT[row * 40 + bit], (unsigned)cnt);
            __syncthreads();
            if (CNT[row * 40 + bit] >= 256u) prefix = cand;
        }
        const unsigned tau = prefix;
        int cgt = 0, ceq = 0;
#pragma unroll
        for (int i = 0; i < 64; ++i) { cgt += (key[i] > tau) ? 1 : 0; ceq += (key[i] == tau) ? 1 : 0; }
        cgt = wave_isum(cgt); ceq = wave_isum(ceq);
        if (lane == 0) { CNT[row * 40 + 32 + hfw] = (unsigned)cgt; CNT[row * 40 + 34 + hfw] = (unsigned)ceq; }
        __syncthreads();
        const int cgt0 = (int)CNT[row * 40 + 32], cgt_tot = cgt0 + (int)CNT[row * 40 + 33], ceq0 = (int)CNT[row * 40 + 34];
        const int need = (tau == 0u) ? 0 : 256 - cgt_tot;
        int pos_gt = hfw ? cgt0 : 0, tie_seen = hfw ? ceq0 : 0;
        unsigned short* outp = IDX + (m0 + row) * 256;
#pragma unroll
        for (int i = 0; i < 64; ++i) { const int e = hfw * 4096 + 64 * i + lane;
            const bool gt = key[i] > tau; const unsigned long long bm = __ballot(gt);
            const int pre = (int)__builtin_amdgcn_mbcnt_hi((unsigned)(bm >> 32), __builtin_amdgcn_mbcnt_lo((unsigned)bm, 0u));
            if (gt) outp[pos_gt + pre] = (unsigned short)e; pos_gt += __popcll(bm);
            const bool eq = (key[i] == tau) && (tau != 0u); const unsigned long long bq_ = __ballot(eq);
            const int preq = (int)__builtin_amdgcn_mbcnt_hi((unsigned)(bq_ >> 32), __builtin_amdgcn_mbcnt_lo((unsigned)bq_, 0u));
            if (eq && (tie_seen + preq) < need) outp[cgt_tot + tie_seen + preq] = (unsigned short)e; tie_seen += __popcll(bq_); }
        __syncthreads();
    }
}
__device__ __forceinline__ void dsa2_phase(Frame& F) {
    const int gw = F.bid * NWAVES + F.wave, NGW = F.G * NWAVES, lane = F.lane;
    const bf16* PROJ = (const bf16*)(F.ws + WS_R1); const unsigned short* IDX = (const unsigned short*)(F.ws + WS_IDX); bf16* OC = (bf16*)(F.ws + WS_OC);
    unsigned char* wb = F.lds + F.wave * 8192;
    float* Qs = (float*)wb; float4* Ps = (float4*)(wb + 1024); unsigned short* Is = (unsigned short*)(wb + 5120);
    for (int m = gw; m < M; m += NGW) {
        const int t = m & (SEQ - 1), b = m >> 13; const int cnt = (t + 1 < 256) ? t + 1 : 256;
#pragma unroll
        for (int h = 0; h < 4; ++h) Qs[h * 64 + lane] = bf2f(PROJ[(size_t)m * DINP + C_DQ + 64 * h + lane]);
        LDS_WAIT(); asm volatile("" ::: "memory");
#pragma unroll 1
        for (int rd = 0; rd < 4; ++rd) {
            const int kk = 64 * rd + lane; const bool valid = kk < cnt; const int idx = valid ? (int)IDX[(size_t)m * 256 + kk] : 0; Is[kk] = (unsigned short)idx;
            const bf16* krow = PROJ + ((size_t)b * SEQ + idx) * DINP + C_DK;
            float a0 = 0.f, a1 = 0.f, a2 = 0.f, a3 = 0.f;
#pragma unroll
            for (int ch = 0; ch < 8; ++ch) { const uint4 w = *(const uint4*)(krow + 8 * ch);
                const float k0 = bflo(w.x), k1 = bfhi(w.x), k2 = bflo(w.y), k3 = bfhi(w.y), k4 = bflo(w.z), k5 = bfhi(w.z), k6 = bflo(w.w), k7 = bfhi(w.w);
#define HY_DOT(acc_, h_) { const float4 qa = *(const float4*)(Qs + (h_) * 64 + 8 * ch), qb = *(const float4*)(Qs + (h_) * 64 + 8 * ch + 4); \
                acc_ += (k0 * qa.x + k1 * qa.y) + (k2 * qa.z + k3 * qa.w) + (k4 * qb.x + k5 * qb.y) + (k6 * qb.z + k7 * qb.w); }
                HY_DOT(a0, 0) HY_DOT(a1, 1) HY_DOT(a2, 2) HY_DOT(a3, 3)
#undef HY_DOT
            }
            Ps[kk] = valid ? make_float4(a0, a1, a2, a3) : make_float4(-1e30f, -1e30f, -1e30f, -1e30f);
        }
        LDS_WAIT(); asm volatile("" ::: "memory");
        float s[4][4];
#pragma unroll
        for (int rd = 0; rd < 4; ++rd) { const float4 v = Ps[64 * rd + lane]; s[0][rd] = v.x; s[1][rd] = v.y; s[2][rd] = v.z; s[3][rd] = v.w; }
#pragma unroll
        for (int h = 0; h < 4; ++h) {
            float mx = fmaxf(fmaxf(s[h][0], s[h][1]), fmaxf(s[h][2], s[h][3])); mx = wave_max(mx);
            float sum = 0.f;
#pragma unroll
            for (int rd = 0; rd < 4; ++rd) { const float p = (s[h][rd] > -1e29f) ? __builtin_amdgcn_exp2f(s[h][rd] - mx) : 0.f; s[h][rd] = p; sum += p; }
            sum = wave_sum(sum); const float inv = 1.f / sum;
#pragma unroll
            for (int rd = 0; rd < 4; ++rd) s[h][rd] *= inv;
        }
#pragma unroll
        for (int rd = 0; rd < 4; ++rd) Ps[64 * rd + lane] = make_float4(s[0][rd], s[1][rd], s[2][rd], s[3][rd]);
        LDS_WAIT(); asm volatile("" ::: "memory");
        float o0 = 0.f, o1 = 0.f, o2 = 0.f, o3 = 0.f;
        const bf16* vbase = PROJ + (size_t)b * SEQ * DINP + C_DV + lane;
#pragma unroll 8
        for (int kk = 0; kk < cnt; ++kk) { const int idx = Is[kk]; const float4 p = Ps[kk]; const float v = bf2f(vbase[(size_t)idx * DINP]);
            o0 += p.x * v; o1 += p.y * v; o2 += p.z * v; o3 += p.w * v; }
        bf16* op = OC + (size_t)m * 256 + lane;
        op[0] = (bf16)f2bf(o0); op[64] = (bf16)f2bf(o1); op[128] = (bf16)f2bf(o2); op[192] = (bf16)f2bf(o3);
        LDS_WAIT(); asm volatile("" ::: "memory");
    }
}

#ifndef HY_FLAGS
#define HY_FLAGS 7
#endif
#ifndef HY_N_LAUNCHES
#define HY_N_LAUNCHES 0
#endif
constexpr int NPL = 17, NPHASES = 1 + DEPTH * NPL;
struct Args { const float* in[21]; float* out; unsigned char* ws; int ph_lo, ph_hi, flags, use_bar; };
__device__ __forceinline__ void zero_rows_bf16(Frame& F, bf16* p, size_t nelem) {
    v4u* z = (v4u*)p; const size_t n16 = nelem * 2 / 16;
    for (size_t i = (size_t)F.bid * NTHREADS + F.tid; i < n16; i += (size_t)F.G * NTHREADS) z[i] = (v4u){0u, 0u, 0u, 0u};
}
__global__ void __launch_bounds__(NTHREADS, 2) hy_fwd(Args args) {
    extern __shared__ __attribute__((aligned(16))) unsigned char lds[];
    LAS unsigned char* lds3 = (LAS unsigned char*)lds;
    volatile LAS unsigned* MISC = (volatile LAS unsigned*)(lds3 + MISC_OFF);
    const int wave_s = __builtin_amdgcn_readfirstlane((int)threadIdx.x >> 6);
    if (threadIdx.x < 64) MISC[threadIdx.x] = 0u;
    __syncthreads();
    if (args.use_bar) (void)xcd_barrier_post((unsigned*)(args.ws + WS_CTL) + CW_BAR, MISC + 8);
    const int lo = args.ph_lo, hi = args.ph_hi, flags = args.flags;
#define IN(k) (lo <= (k) && (k) < hi)
#define SEAM(k) do { if (IN(k) && IN((k) + 1)) { GAS unsigned char* w_ = (GAS unsigned char*)args.ws; asm volatile("" : "+s"(w_)); XcdBarrier b_; b_.bar = (unsigned*)(w_ + WS_CTL) + CW_BAR; b_.x = xb_xcc_id(); b_.st = MISC + 8; xcd_barrier(b_); } } while (0)
#define PH_BEGIN(k) if (IN(k)) { asm volatile("; HYPH_BEGIN %0" :: "i"(__LINE__)); Frame F = fr_fresh(lds, wave_s); bf16* XN = (bf16*)(F.ws + WS_XN); bf16* R1 = (bf16*)(F.ws + WS_R1); \
        bf16* OA = (bf16*)(F.ws + WS_OA); bf16* OB = (bf16*)(F.ws + WS_OB); bf16* OC = (bf16*)(F.ws + WS_OC); (void)XN; (void)R1; (void)OA; (void)OB; (void)OC;
#define PH_END(k) asm volatile("; HYPH_END %0" :: "i"(__LINE__)); } SEAM(k);

#ifdef HY_DUMP_PHASE
    if (lo == 999) {
        Frame F = fr_fresh(lds, wave_s); const bf16* src = (const bf16*)(F.ws + HY_DUMP_OFF); float* dst = (float*)F.out;
        for (size_t i = (size_t)F.bid * NTHREADS + F.tid; i < (size_t)M * DM; i += (size_t)F.G * NTHREADS) { const size_t m = i >> 10, c = i & 1023; dst[i] = (c < HY_DUMP_COLS && m < HY_DUMP_ROWS) ? bf2f(src[m * HY_DUMP_LD + c]) + bf2f(src[m * HY_DUMP_LD + c + HY_DUMP_C2]) + bf2f(src[m * HY_DUMP_LD + c + HY_DUMP_C3]) : 0.f; }
        return;
    }
#endif
    PH_BEGIN(0) p0_prologue(F); PH_END(0)
    {
        constexpr int l = 0;
        const int pb = 1 + NPL * l;
        PH_BEGIN(pb + 0) norm_phase(F, l == 0 ? HY_IN(F, 0) : ((float*)F.out), HY_IN(F, 1) + (size_t)l * DM, XN); PH_END(pb + 0)
        PH_BEGIN(pb + 1) { pg8::Gemm g{XN, wl_ptr(F, l, W_GU1), M, NGU, DM}; pg8::StaticOrder S; S.init(M, NGU, F.G, F.bid); pg8::EpiSwiGLU E{R1, FF};
            pg8::gemm_phase<pg8::EpiSwiGLU, pg8::StaticOrder, true, true>(lds3, g, S, E, F.tid); } PH_END(pb + 1)
        PH_BEGIN(pb + 2) { pg8::Gemm g{R1, wl_ptr(F, l, W_DN1), M, DM, FF}; pg8::StaticOrder S; S.init(M, DM, F.G, F.bid); pg8::EpiResid E{l == 0 ? HY_IN(F, 0) : ((float*)F.out), ((float*)F.out), DM, 0.5f};
            pg8::gemm_phase<pg8::EpiResid, pg8::StaticOrder, true, true>(lds3, g, S, E, F.tid); } PH_END(pb + 2)
        if (flags != 0) {
        PH_BEGIN(pb + 3) norm_phase(F, ((float*)F.out), HY_IN(F, 4) + (size_t)l * DM, XN); PH_END(pb + 3)
        PH_BEGIN(pb + 4) { pg8::Gemm g{XN, wl_ptr(F, l, W_IN), M, DINP, DM}; pg8::StaticOrder S; S.init(M, DINP, F.G, F.bid); pg8::EpiBf16<0> E{R1, DINP, nullptr, 0, 0, 1.f};
            pg8::gemm_phase<pg8::EpiBf16<0>, pg8::StaticOrder, true, true>(lds3, g, S, E, F.tid); } PH_END(pb + 4)
        PH_BEGIN(pb + 5) prep_phase(F, l); PH_END(pb + 5)
        PH_BEGIN(pb + 6) {
            if (flags & 2) cmp_phase(F, l); else zero_rows_bf16(F, OB, (size_t)M * 512);
            __syncthreads();
            if (flags & 1) sb_phase(F);
            else if (flags & 16) { const v4u* src = (const v4u*)(R1); v4u* dst = (v4u*)OA;
                for (size_t i = (size_t)F.bid * NTHREADS + F.tid; i < (size_t)M * 32; i += (size_t)F.G * NTHREADS) { const size_t m = i >> 5, c = i & 31; dst[i] = src[(m * DINP + C_SBV) / 8 + c]; } }
            else zero_rows_bf16(F, OA, (size_t)M * 256);
            __syncthreads();
            if (flags & 4) dsa1_phase(F); else zero_rows_bf16(F, OC, (size_t)M * 256);
        } PH_END(pb + 6)
        PH_BEGIN(pb + 7) {
            if (flags & 2) nsa1_phase(F);
            __syncthreads();
            if (flags & 4) dsa2_phase(F);
        } PH_END(pb + 7)
        PH_BEGIN(pb + 8) { if (flags & 2) nsa2_phase(F); } PH_END(pb + 8)
        PH_BEGIN(pb + 9) { pg8::Gemm g{XN, wl_ptr(F, l, W_GATE), M, NGATE, DM}; pg8::StaticOrder S; S.init(M, NGATE, F.G, F.bid); pg8::EpiSigmoid E{R1, NGATE};
            pg8::gemm_phase<pg8::EpiSigmoid, pg8::StaticOrder, true, true>(lds3, g, S, E, F.tid); } PH_END(pb + 9)
        PH_BEGIN(pb + 10) { pg8::Gemm g{OA, wl_ptr(F, l, W_BRA), M, DM, 256}; pg8::StaticOrder S; S.init(M, DM, F.G, F.bid); pg8::EpiGated E{R1, NGATE, 0, XN, DM, 1};
            pg8::gemm_phase<pg8::EpiGated, pg8::StaticOrder, true, true>(lds3, g, S, E, F.tid); } PH_END(pb + 10)
        PH_BEGIN(pb + 11) { pg8::Gemm g{OB, wl_ptr(F, l, W_BRB), M, DM, 512}; pg8::StaticOrder S; S.init(M, DM, F.G, F.bid); pg8::EpiGated E{R1, NGATE, 1024, XN, DM, 0};
            pg8::gemm_phase<pg8::EpiGated, pg8::StaticOrder, true, true>(lds3, g, S, E, F.tid); } PH_END(pb + 11)
        PH_BEGIN(pb + 12) { pg8::Gemm g{OC, wl_ptr(F, l, W_BRC), M, DM, 256}; pg8::StaticOrder S; S.init(M, DM, F.G, F.bid); pg8::EpiGated E{R1, NGATE, 2048, XN, DM, 0};
            pg8::gemm_phase<pg8::EpiGated, pg8::StaticOrder, true, true>(lds3, g, S, E, F.tid); } PH_END(pb + 12)
        PH_BEGIN(pb + 13) { pg8::Gemm g{XN, wl_ptr(F, l, W_OUT), M, DM, DM}; pg8::StaticOrder S; S.init(M, DM, F.G, F.bid); pg8::EpiResid E{((float*)F.out), ((float*)F.out), DM, 1.0f};
            pg8::gemm_phase<pg8::EpiResid, pg8::StaticOrder, true, true>(lds3, g, S, E, F.tid); } PH_END(pb + 13)
        }
        PH_BEGIN(pb + 14) norm_phase(F, ((float*)F.out), HY_IN(F, 18) + (size_t)l * DM, XN); PH_END(pb + 14)
        PH_BEGIN(pb + 15) { pg8::Gemm g{XN, wl_ptr(F, l, W_GU2), M, NGU, DM}; pg8::StaticOrder S; S.init(M, NGU, F.G, F.bid); pg8::EpiSwiGLU E{R1, FF};
            pg8::gemm_phase<pg8::EpiSwiGLU, pg8::StaticOrder, true, true>(lds3, g, S, E, F.tid); } PH_END(pb + 15)
        PH_BEGIN(pb + 16) { pg8::Gemm g{R1, wl_ptr(F, l, W_DN2), M, DM, FF}; pg8::StaticOrder S; S.init(M, DM, F.G, F.bid); pg8::EpiResid E{((float*)F.out), ((float*)F.out), DM, 0.5f};
            pg8::gemm_phase<pg8::EpiResid, pg8::StaticOrder, true, true>(lds3, g, S, E, F.tid); } PH_END(pb + 16)
        }
    {
        constexpr int l = 1;
        const int pb = 1 + NPL * l;
        PH_BEGIN(pb + 0) norm_phase(F, l == 0 ? HY_IN(F, 0) : ((float*)F.out), HY_IN(F, 1) + (size_t)l * DM, XN); PH_END(pb + 0)
        PH_BEGIN(pb + 1) { pg8::Gemm g{XN, wl_ptr(F, l, W_GU1), M, NGU, DM}; pg8::StaticOrder S; S.init(M, NGU, F.G, F.bid); pg8::EpiSwiGLU E{R1, FF};
            pg8::gemm_phase<pg8::EpiSwiGLU, pg8::StaticOrder, true, true>(lds3, g, S, E, F.tid); } PH_END(pb + 1)
        PH_BEGIN(pb + 2) { pg8::Gemm g{R1, wl_ptr(F, l, W_DN1), M, DM, FF}; pg8::StaticOrder S; S.init(M, DM, F.G, F.bid); pg8::EpiResid E{l == 0 ? HY_IN(F, 0) : ((float*)F.out), ((float*)F.out), DM, 0.5f};
            pg8::gemm_phase<pg8::EpiResid, pg8::StaticOrder, true, true>(lds3, g, S, E, F.tid); } PH_END(pb + 2)
        if (flags != 0) {
        PH_BEGIN(pb + 3) norm_phase(F, ((float*)F.out), HY_IN(F, 4) + (size_t)l * DM, XN); PH_END(pb + 3)
        PH_BEGIN(pb + 4) { pg8::Gemm g{XN, wl_ptr(F, l, W_IN), M, DINP, DM}; pg8::StaticOrder S; S.init(M, DINP, F.G, F.bid); pg8::EpiBf16<0> E{R1, DINP, nullptr, 0, 0, 1.f};
            pg8::gemm_phase<pg8::EpiBf16<0>, pg8::StaticOrder, true, true>(lds3, g, S, E, F.tid); } PH_END(pb + 4)
        PH_BEGIN(pb + 5) prep_phase(F, l); PH_END(pb + 5)
        PH_BEGIN(pb + 6) {
            if (flags & 2) cmp_phase(F, l); else zero_rows_bf16(F, OB, (size_t)M * 512);
            __syncthreads();
            if (flags & 1) sb_phase(F);
            else if (flags & 16) { const v4u* src = (const v4u*)(R1); v4u* dst = (v4u*)OA;
                for (size_t i = (size_t)F.bid * NTHREADS + F.tid; i < (size_t)M * 32; i += (size_t)F.G * NTHREADS) { const size_t m = i >> 5, c = i & 31; dst[i] = src[(m * DINP + C_SBV) / 8 + c]; } }
            else zero_rows_bf16(F, OA, (size_t)M * 256);
            __syncthreads();
            if (flags & 4) dsa1_phase(F); else zero_rows_bf16(F, OC, (size_t)M * 256);
        } PH_END(pb + 6)
        PH_BEGIN(pb + 7) {
            if (flags & 2) nsa1_phase(F);
            __syncthreads();
            if (flags & 4) dsa2_phase(F);
        } PH_END(pb + 7)
        PH_BEGIN(pb + 8) { if (flags & 2) nsa2_phase(F); } PH_END(pb + 8)
        PH_BEGIN(pb + 9) { pg8::Gemm g{XN, wl_ptr(F, l, W_GATE), M, NGATE, DM}; pg8::StaticOrder S; S.init(M, NGATE, F.G, F.bid); pg8::EpiSigmoid E{R1, NGATE};
            pg8::gemm_phase<pg8::EpiSigmoid, pg8::StaticOrder, true, true>(lds3, g, S, E, F.tid); } PH_END(pb + 9)
        PH_BEGIN(pb + 10) { pg8::Gemm g{OA, wl_ptr(F, l, W_BRA), M, DM, 256}; pg8::StaticOrder S; S.init(M, DM, F.G, F.bid); pg8::EpiGated E{R1, NGATE, 0, XN, DM, 1};
            pg8::gemm_phase<pg8::EpiGated, pg8::StaticOrder, true, true>(lds3, g, S, E, F.tid); } PH_END(pb + 10)
        PH_BEGIN(pb + 11) { pg8::Gemm g{OB, wl_ptr(F, l, W_BRB), M, DM, 512}; pg8::StaticOrder S; S.init(M, DM, F.G, F.bid); pg8::EpiGated E{R1, NGATE, 1024, XN, DM, 0};
            pg8::gemm_phase<pg8::EpiGated, pg8::StaticOrder, true, true>(lds3, g, S, E, F.tid); } PH_END(pb + 11)
        PH_BEGIN(pb + 12) { pg8::Gemm g{OC, wl_ptr(F, l, W_BRC), M, DM, 256}; pg8::StaticOrder S; S.init(M, DM, F.G, F.bid); pg8::EpiGated E{R1, NGATE, 2048, XN, DM, 0};
            pg8::gemm_phase<pg8::EpiGated, pg8::StaticOrder, true, true>(lds3, g, S, E, F.tid); } PH_END(pb + 12)
        PH_BEGIN(pb + 13) { pg8::Gemm g{XN, wl_ptr(F, l, W_OUT), M, DM, DM}; pg8::StaticOrder S; S.init(M, DM, F.G, F.bid); pg8::EpiResid E{((float*)F.out), ((float*)F.out), DM, 1.0f};
            pg8::gemm_phase<pg8::EpiResid, pg8::StaticOrder, true, true>(lds3, g, S, E, F.tid); } PH_END(pb + 13)
        }
        PH_BEGIN(pb + 14) norm_phase(F, ((float*)F.out), HY_IN(F, 18) + (size_t)l * DM, XN); PH_END(pb + 14)
        PH_BEGIN(pb + 15) { pg8::Gemm g{XN, wl_ptr(F, l, W_GU2), M, NGU, DM}; pg8::StaticOrder S; S.init(M, NGU, F.G, F.bid); pg8::EpiSwiGLU E{R1, FF};
            pg8::gemm_phase<pg8::EpiSwiGLU, pg8::StaticOrder, true, true>(lds3, g, S, E, F.tid); } PH_END(pb + 15)
        PH_BEGIN(pb + 16) { pg8::Gemm g{R1, wl_ptr(F, l, W_DN2), M, DM, FF}; pg8::StaticOrder S; S.init(M, DM, F.G, F.bid); pg8::EpiResid E{((float*)F.out), ((float*)F.out), DM, 0.5f};
            pg8::gemm_phase<pg8::EpiResid, pg8::StaticOrder, true, true>(lds3, g, S, E, F.tid); } PH_END(pb + 16)
        }
#undef IN
#undef SEAM
}

extern "C" void kernel_launch(void* const* d_in, const int* in_sizes, int n_in, void* d_out, int out_size, void* d_ws, size_t ws_size, hipStream_t stream) {
    static int grid = 0;
    if (grid == 0) {
        if (n_in != 21 || in_sizes[0] != M * DM || out_size != M * DM || ws_size < WS_END) { fprintf(stderr, "kernel_launch: unexpected shapes (n_in %d, x %d, out %d, ws %zu); nothing launched\n", n_in, n_in > 0 ? in_sizes[0] : -1, out_size, ws_size); grid = -1; return; }
        int dev = 0, cus = 0, per_cu = 0;
        if (hipGetDevice(&dev) != hipSuccess || hipDeviceGetAttribute(&cus, hipDeviceAttributeMultiprocessorCount, dev) != hipSuccess) { grid = -1; return; }
        if (hipFuncSetAttribute((const void*)hy_fwd, hipFuncAttributeMaxDynamicSharedMemorySize, LDS_BYTES) != hipSuccess) { fprintf(stderr, "kernel_launch: hipFuncSetAttribute failed\n"); grid = -1; return; }
        if (hipOccupancyMaxActiveBlocksPerMultiprocessor(&per_cu, (const void*)hy_fwd, NTHREADS, LDS_BYTES) != hipSuccess || per_cu < 1)
            fprintf(stderr, "kernel_launch: note: occupancy query reports %d workgroups per CU\n", per_cu);
        (void)hipGetLastError();
        grid = cus;
    }
    if (grid < 0) return;
    if (hipMemsetAsync((char*)d_ws + WS_CTL, 0, CTL_ZERO_BYTES, stream) != hipSuccess) return;
    Args a{};
    for (int i = 0; i < 21; ++i) a.in[i] = (const float*)d_in[i];
    a.out = (float*)d_out; a.ws = (unsigned char*)d_ws; a.flags = HY_FLAGS;
#if HY_N_LAUNCHES == 1
    a.ph_lo = 0; a.ph_hi = NPHASES; a.use_bar = 1;
    hipLaunchKernelGGL(hy_fwd, dim3(grid), dim3(NTHREADS), LDS_BYTES, stream, a);
#else
#ifdef HY_DUMP_PHASE
    for (int p = 0; p <= HY_DUMP_PHASE; ++p) { a.ph_lo = p; a.ph_hi = p + 1; a.use_bar = 0; hipLaunchKernelGGL(hy_fwd, dim3(grid), dim3(NTHREADS), LDS_BYTES, stream, a); }
    a.ph_lo = 999; a.ph_hi = 1000; a.use_bar = 0; hipLaunchKernelGGL(hy_fwd, dim3(grid), dim3(NTHREADS), LDS_BYTES, stream, a);
#else
    for (int p = 0; p < NPHASES; ++p) { a.ph_lo = p; a.ph_hi = p + 1; a.use_bar = 0; hipLaunchKernelGGL(hy_fwd, dim3(grid), dim3(NTHREADS), LDS_BYTES, stream, a); }
#endif
#endif
}
```

```cpp
#include <hip/hip_runtime.h>
#include <cstdio>
#include <cstdint>
namespace pg8 {
#define PG8_LAS __attribute__((address_space(3)))
typedef unsigned short bf16_t;
typedef short bf16x8 __attribute__((ext_vector_type(8)));
typedef float f32x4 __attribute__((ext_vector_type(4)));
typedef unsigned u32x4 __attribute__((ext_vector_type(4)));
constexpr int BM = 256, BK = 64, HALF = 128, HTB = HALF * BK * 2  , STAGE_BYTES = 8 * HTB, NXCD = 8, WGM = 8;

__host__ __device__ __forceinline__ int lds_byte(int r, int c) { const int st = (r >> 4) * 2 + (c >> 5), rr = r & 15, cc = c & 31, ob = rr * 64 + cc * 2; return st * 1024 + (ob ^ (((ob >> 9) & 1) << 5)); }
__host__ __device__ __forceinline__ void stage_rc(int b, int& R, int& C) { const int st = b / 1024, sb = b % 1024, swz = sb ^ (((sb >> 9) & 1) << 5); R = (st >> 1) * 16 + swz / 64; C = (st & 1) * 32 + (swz % 64) / 2; }
__host__ __device__ __forceinline__ int perm32(int rho) { const int n = rho >> 4, i = rho & 15; return 8 * (i >> 2) + 4 * n + (i & 3); }

struct Unit { int pm, pn; int ks = 0; };
struct Gemm { const bf16_t* A; const bf16_t* Bt; int M, N, K; int ld = 0; };

struct StaticOrder {
    int nM, nN, nwg, G, c;
    __host__ __device__ void init(int M, int N, int G_, int c_) { nM = M / BM; nN = N / BM; nwg = nM * nN; G = G_; c = c_; }
    __host__ __device__ bool next(int i, Unit& u) const {
        const long L = (long)i * G + c; if (L >= nwg) return false;
        int wgid = (int)L; { const int q = nwg / NXCD, r = nwg % NXCD, xcd = wgid % NXCD, off = wgid / NXCD; wgid = (xcd < r ? xcd * (q + 1) : r * (q + 1) + (xcd - r) * q) + off; }
        const int nig = WGM * nN, gid = wgid / nig, fm = gid * WGM, gsz = (nM - fm) < WGM ? (nM - fm) : WGM;
        u.pm = fm + ((wgid % nig) % gsz); u.pn = (wgid % nig) / gsz; return true;
    }
    __device__ __forceinline__ void a_ready(const Unit&) const {}
    __device__ __forceinline__ void done(const Unit&) const {}
};

__device__ __forceinline__ unsigned cvt_pk_bf16(float lo, float hi) { unsigned r; asm volatile("v_cvt_pk_bf16_f32 %0, %1, %2" : "=v"(r) : "v"(lo), "v"(hi)); return r; }
typedef float f32x2 __attribute__((ext_vector_type(2)));
__device__ __forceinline__ f32x2 gelu_pk(f32x2 v) {
    const f32x2 av = __builtin_elementwise_abs(v), d = av * 0.2316418882f + 1.0f;
    f32x2 t; t.x = __builtin_amdgcn_rcpf(d.x); t.y = __builtin_amdgcn_rcpf(d.y);
    f32x2 q = t * 0.5307027145f + (-0.7265760135f); q = q * t + 0.7107068705f; q = q * t + (-0.142248368f); q = q * t + 0.127414796f; q = q * t;
    const f32x2 s = (v * v) * (-0.72134752044f);
    f32x2 e; e.x = __builtin_amdgcn_exp2f(s.x); e.y = __builtin_amdgcn_exp2f(s.y);
    const f32x2 m = v * (q * e), r = v - m;
    f32x2 o; o.x = v.x < 0.f ? m.x : r.x; o.y = v.y < 0.f ? m.y : r.y; return o;
}

template <int ACT  > struct EpiBf16 {
    static constexpr bool PERM = true, AFTER_DRAIN = false, KEEP_ACC = false; static_assert(ACT == 0 || ACT == 1, "EpiBf16: ACT is 0 (none) or 1 (gelu_pk)");
    bf16_t* O; int ldc; const float* bias; int split_cols; size_t split_stride; float scale0;
    __device__ __forceinline__ void operator()(const f32x4 (&acc)[2][2][4][2], const Unit& u, int wr, int wc, int fr, int fq) const {
        const int row0 = u.pm * BM + wr * 64 + fr; int colt = u.pn * BM; bf16_t* base = O;
        float sc = 1.f; if (split_cols) { const int t = colt / split_cols; base += (size_t)t * split_stride; colt -= t * split_cols; if (t == 0) sc = scale0; }
        const int col0 = colt + wc * 32 + 8 * fq, bcol0 = u.pn * BM + wc * 32 + 8 * fq;
        f32x4 bv[2][2];
#pragma unroll
        for (int bj = 0; bj < 2; ++bj)
#pragma unroll
            for (int n = 0; n < 2; ++n) bv[bj][n] = bias ? *(const f32x4*)(bias + bcol0 + bj * HALF + 4 * n) : (f32x4){0.f, 0.f, 0.f, 0.f};
#pragma unroll
        for (int ai = 0; ai < 2; ++ai)
#pragma unroll
            for (int m = 0; m < 4; ++m) { bf16_t* rowp = base + (size_t)(row0 + ai * HALF + m * 16) * ldc + col0;
#pragma unroll
                for (int bj = 0; bj < 2; ++bj) { f32x4 v0 = acc[ai][bj][m][0] + bv[bj][0], v1 = acc[ai][bj][m][1] + bv[bj][1];
                    if (ACT == 1) { f32x2 a = gelu_pk((f32x2){v0[0], v0[1]}), b = gelu_pk((f32x2){v0[2], v0[3]}), c = gelu_pk((f32x2){v1[0], v1[1]}), d = gelu_pk((f32x2){v1[2], v1[3]});
                        v0 = (f32x4){a.x, a.y, b.x, b.y}; v1 = (f32x4){c.x, c.y, d.x, d.y}; }
                    v0 = v0 * sc; v1 = v1 * sc; u32x4 w; w.x = cvt_pk_bf16(v0[0], v0[1]); w.y = cvt_pk_bf16(v0[2], v0[3]); w.z = cvt_pk_bf16(v1[0], v1[1]); w.w = cvt_pk_bf16(v1[2], v1[3]);
                    *(u32x4*)(rowp + bj * HALF) = w; } }
    }
};

template <class Epi, class Sched, bool ALIGN_EPI = false, bool SP2 = false>
__device__ __forceinline__ void gemm_phase(PG8_LAS unsigned char* lds, const Gemm g, const Sched& S, const Epi& E, const int tid_in) {
    const int tid = tid_in,     wid = __builtin_amdgcn_readfirstlane(tid >> 6), lane = tid & 63, wr = wid >> 2, wc = wid & 3, fr = lane & 15, fq = lane >> 4;
    const int K = g.K, nt = K / BK, LD = g.ld ? g.ld : g.K;
    unsigned voffA[2], voffB[2];
#pragma unroll
    for (int i = 0; i < 2; ++i) { int R, C; stage_rc(tid * 16 + i * 8192, R, C); const int Rb = Epi::PERM ? ((R & ~31) + perm32(R & 31)) : R;
        voffA[i] = (unsigned)(R * LD + C) * 2u; voffB[i] = (unsigned)(Rb * LD + C) * 2u; }
    const size_t kstep = (size_t)(BK * 2);
    const size_t hstep = (size_t)HALF * LD * 2;
    const size_t tstep = 2 * hstep;
    const unsigned ldsw = (unsigned)wid * 1024u;
    const int aoff = lds_byte(wr * 64 + fr, fq * 8), boff = lds_byte(wc * 32 + fr, fq * 8);
#define PG8_SA(b, h) (((b) * 2 + (h)) * HTB)
#define PG8_SB(b, h) ((4 + (b) * 2 + (h)) * HTB)
#define PG8_STAGE(bufoff, gbase, voff) do { const char* _gb = (const char*)(gbase); asm volatile("" : "+s"(_gb)); _Pragma("unroll") for (int _i = 0; _i < 2; ++_i) \
        __builtin_amdgcn_global_load_lds((const unsigned*)(_gb + (voff)[_i]), (PG8_LAS unsigned*)(lds + (bufoff) + ldsw + _i * 8192), 16, 0, 0); } while (0)
#define PG8_LDA(dst, b, h) do { _Pragma("unroll") for (int m = 0; m < 4; ++m) _Pragma("unroll") for (int k = 0; k < 2; ++k) dst[m][k] = *(const PG8_LAS bf16x8*)(lds + PG8_SA(b, h) + aoff + m * 2048 + k * 1024); } while (0)
#define PG8_LDB(dst, b, h) do { _Pragma("unroll") for (int n = 0; n < 2; ++n) _Pragma("unroll") for (int k = 0; k < 2; ++k) dst[n][k] = *(const PG8_LAS bf16x8*)(lds + PG8_SB(b, h) + boff + n * 2048 + k * 1024); } while (0)
#define PG8_MMA(ai, bj, At, Bt) do { __builtin_amdgcn_s_setprio(1); _Pragma("unroll") for (int m = 0; m < 4; ++m) _Pragma("unroll") for (int n = 0; n < 2; ++n) _Pragma("unroll") for (int k = 0; k < 2; ++k) \
        acc[ai][bj][m][n] = __builtin_amdgcn_mfma_f32_16x16x32_bf16(Bt[n][k], At[m][k], acc[ai][bj][m][n], 0, 0, 0); __builtin_amdgcn_s_setprio(0); } while (0)
#define PG8_WAIT_V(n) asm volatile("s_waitcnt vmcnt(" #n ")" ::: "memory")
#define PG8_WAIT_L(n) asm volatile("s_waitcnt lgkmcnt(" #n ")" ::: "memory")
#define PG8_BAR __builtin_amdgcn_s_barrier()
#define PG8_SCHED __builtin_amdgcn_sched_barrier(0)
    Unit cur, nxt; int ui = 0;
    if (!S.next(0, cur)) return;
    f32x4 acc[2][2][4][2];
#pragma unroll
    for (int a = 0; a < 2; ++a)
#pragma unroll
        for (int b = 0; b < 2; ++b)
#pragma unroll
            for (int m = 0; m < 4; ++m)
#pragma unroll
                for (int n = 0; n < 2; ++n) acc[a][b][m][n] = (f32x4){0.f, 0.f, 0.f, 0.f};
    bf16x8 At[4][2], B0[2][2], B1[2][2];
    const char* cA = (const char*)g.A + (size_t)cur.pm * tstep + (size_t)cur.ks * K * 2; const char* cB = (const char*)g.Bt + (size_t)cur.pn * tstep + (size_t)cur.ks * K * 2;
    S.a_ready(cur);
    if constexpr (SP2) {
        PG8_STAGE(PG8_SB(0, 0), cB, voffB); PG8_STAGE(PG8_SB(0, 1), cB + hstep, voffB); PG8_STAGE(PG8_SA(0, 0), cA, voffA); PG8_STAGE(PG8_SA(0, 1), cA + hstep, voffA);
        if (wr == 1) PG8_BAR;
        PG8_WAIT_V(2); PG8_BAR;
        PG8_STAGE(PG8_SB(1, 0), cB + kstep, voffB); PG8_STAGE(PG8_SA(1, 0), cA + kstep, voffA); PG8_STAGE(PG8_SB(1, 1), cB + hstep + kstep, voffB);
        PG8_WAIT_V(6); PG8_BAR;
    } else {
        PG8_STAGE(PG8_SB(0, 0), cB, voffB); PG8_STAGE(PG8_SA(0, 0), cA, voffA); PG8_STAGE(PG8_SB(0, 1), cB + hstep, voffB); PG8_STAGE(PG8_SA(0, 1), cA + hstep, voffA);
        if (wr == 1) PG8_BAR;
        PG8_WAIT_V(4); PG8_BAR;
        PG8_STAGE(PG8_SB(1, 0), cB + kstep, voffB); PG8_STAGE(PG8_SA(1, 0), cA + kstep, voffA); PG8_STAGE(PG8_SB(1, 1), cB + hstep + kstep, voffB);
        PG8_WAIT_V(6); PG8_BAR;
    }
    for (;;) {
        const bool has_next = S.next(ui + 1, nxt);
        const char* nA = has_next ? (const char*)g.A + (size_t)nxt.pm * tstep + (size_t)nxt.ks * K * 2 : cA; const char* nB = has_next ? (const char*)g.Bt + (size_t)nxt.pn * tstep + (size_t)nxt.ks * K * 2 : cB;
        for (int t = 0; t < nt; t += 2) {
            const bool last = (t == nt - 2);
            const char* a1 = cA + (size_t)(t + 1) * kstep;
            const char* a2 = last ? nA : cA + (size_t)(t + 2) * kstep; const char* b2 = last ? nB : cB + (size_t)(t + 2) * kstep;
            const char* a3 = a2 + kstep; const char* b3 = b2 + kstep;
            if (last && has_next) S.a_ready(nxt);
            if constexpr (SP2) {
            PG8_LDB(B0, 0, 0); PG8_LDB(B1, 0, 1); PG8_SCHED; PG8_LDA(At, 0, 0); PG8_STAGE(PG8_SA(1, 1), a1 + hstep, voffA);
            PG8_WAIT_V(8); PG8_WAIT_L(0); PG8_BAR; PG8_MMA(0, 0, At, B0); PG8_MMA(0, 1, At, B1); PG8_BAR; PG8_SCHED;
            PG8_LDA(At, 0, 1); PG8_STAGE(PG8_SB(0, 0), b2, voffB); PG8_STAGE(PG8_SB(0, 1), b2 + hstep, voffB); PG8_STAGE(PG8_SA(0, 0), a2, voffA);
            PG8_WAIT_V(8); PG8_WAIT_L(0); PG8_BAR; PG8_MMA(1, 0, At, B0); PG8_MMA(1, 1, At, B1); PG8_BAR; PG8_SCHED;
            PG8_LDB(B0, 1, 0); PG8_LDB(B1, 1, 1); PG8_SCHED; PG8_LDA(At, 1, 0); PG8_STAGE(PG8_SA(0, 1), a2 + hstep, voffA);
            PG8_WAIT_V(8); PG8_WAIT_L(0); PG8_BAR; PG8_MMA(0, 0, At, B0); PG8_MMA(0, 1, At, B1); PG8_BAR; PG8_SCHED;
            PG8_LDA(At, 1, 1); PG8_STAGE(PG8_SB(1, 0), b3, voffB); PG8_STAGE(PG8_SB(1, 1), b3 + hstep, voffB); PG8_STAGE(PG8_SA(1, 0), a3, voffA);
            PG8_WAIT_V(8); PG8_WAIT_L(0); PG8_BAR; PG8_MMA(1, 0, At, B0); PG8_MMA(1, 1, At, B1); PG8_BAR; PG8_SCHED;
            } else {
            PG8_LDB(B0, 0, 0); PG8_SCHED; PG8_LDA(At, 0, 0); PG8_STAGE(PG8_SA(1, 1), a1 + hstep, voffA);
            PG8_WAIT_L(8); PG8_BAR; PG8_WAIT_L(0); PG8_MMA(0, 0, At, B0); PG8_BAR; PG8_SCHED;
            PG8_LDB(B1, 0, 1); PG8_STAGE(PG8_SB(0, 0), b2, voffB);
            PG8_BAR; PG8_WAIT_L(0); PG8_MMA(0, 1, At, B1); PG8_BAR;
            PG8_LDA(At, 0, 1); PG8_STAGE(PG8_SA(0, 0), a2, voffA);
            PG8_BAR; PG8_WAIT_L(0); PG8_MMA(1, 0, At, B0); PG8_BAR; PG8_SCHED;
            PG8_STAGE(PG8_SB(0, 1), b2 + hstep, voffB);
            PG8_WAIT_V(6); PG8_BAR; PG8_MMA(1, 1, At, B1); PG8_BAR;
            PG8_LDB(B0, 1, 0); PG8_SCHED; PG8_LDA(At, 1, 0); PG8_STAGE(PG8_SA(0, 1), a2 + hstep, voffA);
            PG8_WAIT_L(8); PG8_BAR; PG8_WAIT_L(0); PG8_MMA(0, 0, At, B0); PG8_BAR; PG8_SCHED;
            PG8_LDB(B1, 1, 1); PG8_STAGE(PG8_SB(1, 0), b3, voffB);
            PG8_BAR; PG8_WAIT_L(0); PG8_MMA(0, 1, At, B1); PG8_BAR;
            PG8_LDA(At, 1, 1); PG8_STAGE(PG8_SA(1, 0), a3, voffA);
            PG8_BAR; PG8_WAIT_L(0); PG8_MMA(1, 0, At, B0); PG8_BAR; PG8_SCHED;
            PG8_STAGE(PG8_SB(1, 1), b3 + hstep, voffB);
            PG8_WAIT_V(6); PG8_BAR; PG8_MMA(1, 1, At, B1); PG8_BAR;
            }
        }
        if constexpr (ALIGN_EPI) { if (wr == 0) PG8_BAR; }
        if constexpr (Epi::KEEP_ACC) { E.hook(acc, cur, wr, wc, fr, fq); S.done(cur); }
        else if constexpr (!Epi::AFTER_DRAIN) { E(acc, cur, wr, wc, fr, fq); S.done(cur); }
        if (!has_next) break;
        if (!(Epi::KEEP_ACC && nxt.ks != 0)) {
#pragma unroll
        for (int a = 0; a < 2; ++a)
#pragma unroll
            for (int b = 0; b < 2; ++b)
#pragma unroll
                for (int m = 0; m < 4; ++m)
#pragma unroll
                    for (int n = 0; n < 2; ++n) acc[a][b][m][n] = (f32x4){0.f, 0.f, 0.f, 0.f};
        }
        cur = nxt; cA = nA; cB = nB; ++ui;
        if constexpr (ALIGN_EPI) { if (wr == 1) PG8_BAR; }
    }
    PG8_WAIT_V(0);
    if constexpr (!ALIGN_EPI) { if (wr == 0) PG8_BAR; }
    PG8_BAR;
    if constexpr (Epi::AFTER_DRAIN) { E.fused(acc, cur, wr, wc, fr, fq, lds, wid, lane); S.done(cur); }
#undef PG8_SA
#undef PG8_SB
#undef PG8_STAGE
#undef PG8_LDA
#undef PG8_LDB
#undef PG8_MMA
#undef PG8_WAIT_V
#undef PG8_WAIT_L
#undef PG8_BAR
#undef PG8_SCHED
}
}
namespace pg8 {
struct HotOrder : StaticOrder { __host__ __device__ bool next(int i, Unit& u) const { const bool ok = StaticOrder::next(i, u); u.pm &= 7; return ok; } };
typedef float f32x2_t __attribute__((ext_vector_type(2))); typedef __bf16 bf16x2_t __attribute__((ext_vector_type(2)));
__device__ __forceinline__ unsigned cvtpk_s(float lo, float hi) { f32x2_t v = {lo, hi}; bf16x2_t b = __builtin_convertvector(v, bf16x2_t); return __builtin_bit_cast(unsigned, b); }
__device__ __forceinline__ float silu_f(float x) { return x * __builtin_amdgcn_rcpf(1.0f + __builtin_amdgcn_exp2f(-1.4426950408889634f * x)); }
__device__ __forceinline__ float sigm_f(float x) { return __builtin_amdgcn_rcpf(1.0f + __builtin_amdgcn_exp2f(-1.4426950408889634f * x)); }
struct EpiSwiGLU {
    static constexpr bool PERM = true, AFTER_DRAIN = false, KEEP_ACC = false;
    bf16_t* O; int ldc; const unsigned long long* SSQ;
    __device__ __forceinline__ void operator()(const f32x4 (&acc)[2][2][4][2], const Unit& u, int wr, int wc, int fr, int fq) const {
        const int row0 = u.pm * BM + wr * 64 + fr, col0 = u.pn * HALF + wc * 32 + 8 * fq;
#pragma unroll
        for (int ai = 0; ai < 2; ++ai)
#pragma unroll
            for (int m = 0; m < 4; ++m) { bf16_t* rowp = O + (size_t)(row0 + ai * HALF + m * 16) * ldc + col0;
                const float rs = __builtin_amdgcn_rsqf((float)SSQ[row0 + ai * HALF + m * 16] * (1.0f / (1024.0f * 1048576.0f)) + 1e-6f);
                const f32x4 g0 = acc[ai][0][m][0] * rs, g1 = acc[ai][0][m][1] * rs, u0 = acc[ai][1][m][0] * rs, u1 = acc[ai][1][m][1] * rs;
                u32x4 w; w.x = cvtpk_s(silu_f(g0[0]) * u0[0], silu_f(g0[1]) * u0[1]); w.y = cvtpk_s(silu_f(g0[2]) * u0[2], silu_f(g0[3]) * u0[3]);
                w.z = cvtpk_s(silu_f(g1[0]) * u1[0], silu_f(g1[1]) * u1[1]); w.w = cvtpk_s(silu_f(g1[2]) * u1[2], silu_f(g1[3]) * u1[3]);
                *(u32x4*)rowp = w; }
    }
};
template <bool XBW, bool F32OUT, bool BASEF32> struct EpiResid {
    static constexpr bool PERM = true, AFTER_DRAIN = false, KEEP_ACC = false;
    const float* base_; float* out_; bf16_t* XB_; unsigned long long* SSQ_; int ldc_; float alpha_;
    __device__ __forceinline__ void operator()(const f32x4 (&acc)[2][2][4][2], const Unit& u, int wr, int wc, int fr, int fq) const {
        const float* base = base_; float* out = out_; const int ldc = ldc_; const float alpha = alpha_; bf16_t* XB = XB_; unsigned long long* SSQ = SSQ_;
        const int row0 = u.pm * BM + wr * 64 + fr, col0 = u.pn * BM + wc * 32 + 8 * fq;
        constexpr int MB = BASEF32 ? 2 : 4;
#pragma unroll
        for (int ai = 0; ai < 2; ++ai)
#pragma unroll
            for (int mb = 0; mb < 4; mb += MB) {
                u32x4 bw[MB][2]; f32x4 bf[MB][2][2];
#pragma unroll
                for (int mm = 0; mm < MB; ++mm)
#pragma unroll
                    for (int bj = 0; bj < 2; ++bj) { const size_t off = (size_t)(row0 + ai * HALF + (mb + mm) * 16) * ldc + col0 + bj * HALF;
                        if (BASEF32) { bf[mm][bj][0] = *(const f32x4*)(base + off); bf[mm][bj][1] = *(const f32x4*)(base + off + 4); }
                        else bw[mm][bj] = *(const u32x4*)(XB + off); }
#pragma unroll
                for (int mm = 0; mm < MB; ++mm) { const int m = mb + mm; float ss = 0.f;
#pragma unroll
                    for (int bj = 0; bj < 2; ++bj) { const size_t off = (size_t)(row0 + ai * HALF + m * 16) * ldc + col0 + bj * HALF;
                        f32x4 b0, b1;
                        if (BASEF32) { b0 = bf[mm][bj][0]; b1 = bf[mm][bj][1]; }
                        else { const u32x4 q = bw[mm][bj]; b0 = (f32x4){__uint_as_float(q.x << 16), __uint_as_float(q.x & 0xffff0000u), __uint_as_float(q.y << 16), __uint_as_float(q.y & 0xffff0000u)};
                            b1 = (f32x4){__uint_as_float(q.z << 16), __uint_as_float(q.z & 0xffff0000u), __uint_as_float(q.w << 16), __uint_as_float(q.w & 0xffff0000u)}; }
                        const f32x4 o0 = b0 + acc[ai][bj][m][0] * alpha, o1 = b1 + acc[ai][bj][m][1] * alpha;
                        if (F32OUT) { *(f32x4*)(out + off) = o0; *(f32x4*)(out + off + 4) = o1; }
                        if (XBW) { ss += ((o0[0] * o0[0] + o0[1] * o0[1]) + (o0[2] * o0[2] + o0[3] * o0[3])) + ((o1[0] * o1[0] + o1[1] * o1[1]) + (o1[2] * o1[2] + o1[3] * o1[3]));
                            u32x4 w; w.x = cvtpk_s(o0[0], o0[1]); w.y = cvtpk_s(o0[2], o0[3]); w.z = cvtpk_s(o1[0], o1[1]); w.w = cvtpk_s(o1[2], o1[3]); *(u32x4*)(XB + off) = w; } }
                    if (XBW) {
                        { auto r_ = __builtin_amdgcn_permlane16_swap(__float_as_uint(ss), __float_as_uint(ss), false, false); ss = __uint_as_float(r_[0]) + __uint_as_float(r_[1]); }
                        { auto r_ = __builtin_amdgcn_permlane32_swap(__float_as_uint(ss), __float_as_uint(ss), false, false); ss = __uint_as_float(r_[0]) + __uint_as_float(r_[1]); }
                        if (fq == 0) atomicAdd(SSQ + (row0 + ai * HALF + m * 16), (unsigned long long)(ss * 1048576.0f)); } }
                __builtin_amdgcn_sched_barrier(0); }
    }
};
struct EpiScaled {
    static constexpr bool PERM = true, AFTER_DRAIN = false, KEEP_ACC = false;
    bf16_t* O; int ldc; const unsigned long long* SSQ;
    __device__ __forceinline__ void operator()(const f32x4 (&acc)[2][2][4][2], const Unit& u, int wr, int wc, int fr, int fq) const {
        const int row0 = u.pm * BM + wr * 64 + fr, col0 = u.pn * BM + wc * 32 + 8 * fq;
#pragma unroll
        for (int ai = 0; ai < 2; ++ai)
#pragma unroll
            for (int m = 0; m < 4; ++m) { bf16_t* rowp = O + (size_t)(row0 + ai * HALF + m * 16) * ldc + col0;
                const float rs = __builtin_amdgcn_rsqf((float)SSQ[row0 + ai * HALF + m * 16] * (1.0f / (1024.0f * 1048576.0f)) + 1e-6f);
#pragma unroll
                for (int bj = 0; bj < 2; ++bj) { const f32x4 v0 = acc[ai][bj][m][0] * rs, v1 = acc[ai][bj][m][1] * rs;
                    u32x4 w; w.x = cvtpk_s(v0[0], v0[1]); w.y = cvtpk_s(v0[2], v0[3]); w.z = cvtpk_s(v1[0], v1[1]); w.w = cvtpk_s(v1[2], v1[3]);
                    *(u32x4*)(rowp + bj * HALF) = w; } }
    }
};
struct EpiSigmoid {
    static constexpr bool PERM = true, AFTER_DRAIN = false, KEEP_ACC = false;
    bf16_t* O; int ldc; const unsigned long long* SSQ;
    __device__ __forceinline__ void operator()(const f32x4 (&acc)[2][2][4][2], const Unit& u, int wr, int wc, int fr, int fq) const {
        const int row0 = u.pm * BM + wr * 64 + fr, col0 = u.pn * BM + wc * 32 + 8 * fq;
#pragma unroll
        for (int ai = 0; ai < 2; ++ai)
#pragma unroll
            for (int m = 0; m < 4; ++m) { bf16_t* rowp = O + (size_t)(row0 + ai * HALF + m * 16) * ldc + col0;
                const float rs = __builtin_amdgcn_rsqf((float)SSQ[row0 + ai * HALF + m * 16] * (1.0f / (1024.0f * 1048576.0f)) + 1e-6f);
#pragma unroll
                for (int bj = 0; bj < 2; ++bj) { const f32x4 v0 = acc[ai][bj][m][0] * rs, v1 = acc[ai][bj][m][1] * rs;
                    u32x4 w; w.x = cvtpk_s(sigm_f(v0[0]), sigm_f(v0[1])); w.y = cvtpk_s(sigm_f(v0[2]), sigm_f(v0[3])); w.z = cvtpk_s(sigm_f(v1[0]), sigm_f(v1[1])); w.w = cvtpk_s(sigm_f(v1[2]), sigm_f(v1[3]));
                    *(u32x4*)(rowp + bj * HALF) = w; } }
    }
};
struct EpiGated {
    static constexpr bool PERM = true, AFTER_DRAIN = false, KEEP_ACC = false;
    const bf16_t* G; int ldg; int gcol; bf16_t* MG; int ldm; int first;
    __device__ __forceinline__ void operator()(const f32x4 (&acc)[2][2][4][2], const Unit& u, int wr, int wc, int fr, int fq) const {
        const int row0 = u.pm * BM + wr * 64 + fr, col0 = u.pn * BM + wc * 32 + 8 * fq;
#pragma unroll
        for (int ai = 0; ai < 2; ++ai)
#pragma unroll
            for (int m = 0; m < 4; ++m) { const size_t r = (size_t)(row0 + ai * HALF + m * 16);
#pragma unroll
                for (int bj = 0; bj < 2; ++bj) { const f32x4 v0 = acc[ai][bj][m][0], v1 = acc[ai][bj][m][1];
                    const u32x4 g = *(const u32x4*)(G + r * ldg + gcol + col0 + bj * HALF);
                    u32x4 p = (u32x4){0u, 0u, 0u, 0u}; if (!first) p = *(const u32x4*)(MG + r * ldm + col0 + bj * HALF);
#define HY_LO(x) __uint_as_float((x) << 16)
#define HY_HI(x) __uint_as_float((x) & 0xffff0000u)
                    u32x4 w;
                    w.x = cvtpk_s(HY_LO(p.x) + HY_LO(g.x) * v0[0], HY_HI(p.x) + HY_HI(g.x) * v0[1]);
                    w.y = cvtpk_s(HY_LO(p.y) + HY_LO(g.y) * v0[2], HY_HI(p.y) + HY_HI(g.y) * v0[3]);
                    w.z = cvtpk_s(HY_LO(p.z) + HY_LO(g.z) * v1[0], HY_HI(p.z) + HY_HI(g.z) * v1[1]);
                    w.w = cvtpk_s(HY_LO(p.w) + HY_LO(g.w) * v1[2], HY_HI(p.w) + HY_HI(g.w) * v1[3]);
#undef HY_LO
#undef HY_HI
                    *(u32x4*)(MG + r * ldm + col0 + bj * HALF) = w; }
                asm volatile("" ::: "memory"); }
    }
};

struct EpiNull {
    static constexpr bool PERM = true, AFTER_DRAIN = false, KEEP_ACC = false;
    __device__ __forceinline__ void operator()(const f32x4 (&acc)[2][2][4][2], const Unit&, int, int, int, int) const {
#pragma unroll
        for (int a = 0; a < 2; ++a)
#pragma unroll
            for (int b = 0; b < 2; ++b)
#pragma unroll
                for (int m = 0; m < 4; ++m)
#pragma unroll
                    for (int n = 0; n < 2; ++n) asm volatile("" :: "v"(acc[a][b][m][n]));
    }
};
struct MergeOrder {
    StaticOrder base;
    __host__ __device__ void init(int M, int N, int G_, int c_) { base.init(M, N, G_, c_); }
    __host__ __device__ bool next(int i, Unit& u) const { const bool ok = base.next(i >> 2, u); u.ks = i & 3; return ok; }
    __device__ __forceinline__ void a_ready(const Unit&) const {}
    __device__ __forceinline__ void done(const Unit&) const {}
};
struct EpiMerge {
    static constexpr bool PERM = true, AFTER_DRAIN = false, KEEP_ACC = true;
    const bf16_t* G_; bf16_t* MG_; int ldg_, ldm_;
    __device__ __forceinline__ void operator()(const f32x4 (&)[2][2][4][2], const Unit&, int, int, int, int) const {}
    __device__ __forceinline__ void hook(f32x4 (&acc)[2][2][4][2], const Unit& u, int wr, int wc, int fr, int fq) const {
        const int ks = u.ks; if (ks == 1) return;
        const bf16_t* G = G_; bf16_t* MG = MG_; const int ldg = ldg_, ldm = ldm_;
        const int row0 = u.pm * BM + wr * 64 + fr, col0 = u.pn * BM + wc * 32 + 8 * fq;
        const int gnum = (ks == 0) ? 0 : (ks == 2) ? 1024 : 2048, gden = (ks == 0) ? 1024 : 2048;
#define HY_LO(x) __uint_as_float((x) << 16)
#define HY_HI(x) __uint_as_float((x) & 0xffff0000u)
#pragma unroll
        for (int ai = 0; ai < 2; ++ai)
#pragma unroll
            for (int m = 0; m < 4; ++m) { const size_t r = (size_t)(row0 + ai * HALF + m * 16);
#pragma unroll
                for (int bj = 0; bj < 2; ++bj) {
                    const u32x4 gn = *(const u32x4*)(G + r * ldg + gnum + col0 + bj * HALF);
                    if (ks != 3) { const u32x4 gd = *(const u32x4*)(G + r * ldg + gden + col0 + bj * HALF);
#define HY_SC(acc_, n_, d_) acc_ *= (n_) * __builtin_amdgcn_rcpf(fmaxf((d_), 1e-30f))
                        HY_SC(acc[ai][bj][m][0][0], HY_LO(gn.x), HY_LO(gd.x)); HY_SC(acc[ai][bj][m][0][1], HY_HI(gn.x), HY_HI(gd.x)); HY_SC(acc[ai][bj][m][0][2], HY_LO(gn.y), HY_LO(gd.y)); HY_SC(acc[ai][bj][m][0][3], HY_HI(gn.y), HY_HI(gd.y));
                        HY_SC(acc[ai][bj][m][1][0], HY_LO(gn.z), HY_LO(gd.z)); HY_SC(acc[ai][bj][m][1][1], HY_HI(gn.z), HY_HI(gd.z)); HY_SC(acc[ai][bj][m][1][2], HY_LO(gn.w), HY_LO(gd.w)); HY_SC(acc[ai][bj][m][1][3], HY_HI(gn.w), HY_HI(gd.w));
#undef HY_SC
                    } else { u32x4 w;
                        w.x = cvtpk_s(acc[ai][bj][m][0][0] * HY_LO(gn.x), acc[ai][bj][m][0][1] * HY_HI(gn.x)); w.y = cvtpk_s(acc[ai][bj][m][0][2] * HY_LO(gn.y), acc[ai][bj][m][0][3] * HY_HI(gn.y));
                        w.z = cvtpk_s(acc[ai][bj][m][1][0] * HY_LO(gn.z), acc[ai][bj][m][1][1] * HY_HI(gn.z)); w.w = cvtpk_s(acc[ai][bj][m][1][2] * HY_LO(gn.w), acc[ai][bj][m][1][3] * HY_HI(gn.w));
                        *(u32x4*)(MG + r * ldm + col0 + bj * HALF) = w; }
                    asm volatile("" ::: "memory"); } }
#undef HY_LO
#undef HY_HI
    }
};
}
#define GAS __attribute__((address_space(1)))
#define LAS __attribute__((address_space(3)))
typedef unsigned short bf16;
typedef unsigned v4u __attribute__((ext_vector_type(4)));
typedef float f32x4 __attribute__((ext_vector_type(4)));
typedef short bf16x8 __attribute__((ext_vector_type(8)));
typedef GAS unsigned gu32;
typedef GAS unsigned long long gu64;
#define RLX_AGENT __ATOMIC_RELAXED, __HIP_MEMORY_SCOPE_AGENT
#define LDS_WAIT() asm volatile("s_waitcnt lgkmcnt(0)" ::: "memory")
#define VM_WAIT() asm volatile("s_waitcnt vmcnt(0)" ::: "memory")
__device__ __forceinline__ unsigned long long rt() { return __builtin_amdgcn_s_memrealtime(); }
__device__ __forceinline__ unsigned f2bf(float f) { unsigned u = __builtin_bit_cast(unsigned, f); return (u + 0x7fffu + ((u >> 16) & 1u)) >> 16; }
__device__ __forceinline__ unsigned pk2(float lo, float hi) { return f2bf(lo) | (f2bf(hi) << 16); }

#define XB_TMO      128
#define XB_XCNT(j)  (256  + 64 * (j))
#define XB_XSUB(j)  (1280 + 64 * (j))
#define XB_XGEN(j)  (2304 + 64 * (j))
#define XB_TOP      3328
#define XB_TOPGEN   3392
#define XCD_BAR_WORDS 3456
#define XB_SPIN_CAP (1u << 18)

__device__ __forceinline__ unsigned xb_ld(unsigned* p)              { return __hip_atomic_load(p, __ATOMIC_RELAXED, __HIP_MEMORY_SCOPE_AGENT); }
__device__ __forceinline__ unsigned xb_add(unsigned* p, unsigned v) { return __hip_atomic_fetch_add(p, v, __ATOMIC_RELAXED, __HIP_MEMORY_SCOPE_AGENT); }
__device__ __forceinline__ unsigned xb_xcc_id() { return (unsigned)__builtin_amdgcn_s_getreg((3 << 11) | 20) & 0xFu; }
#define XB_SPIN(cond, bar) do { unsigned _sp = 0; while (cond) { __builtin_amdgcn_s_sleep(1); \
    if ((++_sp & 255u) == 0u) { if (xb_ld(&(bar)[XB_TMO])) break; if (_sp > XB_SPIN_CAP) { atomicAdd(&(bar)[XB_TMO], 1u); break; } } } } while (0)

struct XcdBarrier {
    unsigned* bar; unsigned x;
    volatile LAS unsigned* st;
};

__device__ __forceinline__ XcdBarrier xcd_barrier_post(unsigned* bar, volatile LAS unsigned* st) {
    XcdBarrier b; b.bar = bar; b.x = xb_xcc_id(); b.st = st;
    if (threadIdx.x == 0) (void)xb_add(&bar[XB_XCNT(b.x)], 1u);
    return b;
}
__device__ __forceinline__ void xcd_barrier_complete(unsigned* bar, unsigned x, unsigned& nloc, unsigned& nx) {
    const unsigned G = gridDim.x * gridDim.y * gridDim.z;
    unsigned sum, cnt, mine, sp = 0u;
    for (;;) {
        sum = 0u; cnt = 0u; mine = 0u;
#pragma unroll
        for (unsigned j = 0; j < 16; ++j) { const unsigned c = xb_ld(&bar[XB_XCNT(j)]); sum += c; cnt += (c > 0u) ? 1u : 0u; mine = (j == x) ? c : mine; }
        if (sum == G) break;
        __builtin_amdgcn_s_sleep(1);
        if ((++sp & 255u) == 0u) { if (xb_ld(&bar[XB_TMO])) break; if (sp > XB_SPIN_CAP) { atomicAdd(&bar[XB_TMO], 1u); break; } }
    }
    nloc = mine > 0u ? mine : 1u; nx = cnt > 0u ? cnt : 1u;
}

__device__ __forceinline__ void xcd_barrier(const XcdBarrier& b) {
    asm volatile("s_waitcnt vmcnt(0)" ::: "memory");
    __syncthreads();
    if (threadIdx.x == 0) {
        unsigned* bar = b.bar;
        __builtin_amdgcn_s_waitcnt(0);
        unsigned nloc = b.st[0], nx = b.st[1];
        if (nloc == 0u) { xcd_barrier_complete(bar, b.x, nloc, nx); b.st[0] = nloc; b.st[1] = nx; }
        const unsigned old = xb_add(&bar[XB_XSUB(b.x)], 1u);
        const unsigned gen = old / nloc;
        if (old + 1u == (gen + 1u) * nloc) {
            __builtin_amdgcn_fence(__ATOMIC_RELEASE, "agent");
            asm volatile("s_waitcnt vmcnt(0)" ::: "memory");
            const unsigned og = xb_add(&bar[XB_TOP], 1u);
            const unsigned tg = og / nx;
            if (og + 1u == (tg + 1u) * nx) xb_add(&bar[XB_TOPGEN], 1u);
            else XB_SPIN(xb_ld(&bar[XB_TOPGEN]) == tg, bar);
            __builtin_amdgcn_fence(__ATOMIC_ACQUIRE, "agent");
            xb_add(&bar[XB_XGEN(b.x)], 1u);
            asm volatile("s_waitcnt vmcnt(0)" ::: "memory");
        } else {
            XB_SPIN(xb_ld(&bar[XB_XGEN(b.x)]) == gen, bar);
            __builtin_amdgcn_fence(__ATOMIC_ACQUIRE, "agent");
            asm volatile("s_waitcnt vmcnt(0)" ::: "memory");
        }
    }
    __syncthreads();
}

typedef float f32x16 __attribute__((ext_vector_type(16)));
constexpr int NWAVES = 8, NTHREADS = 512;
constexpr int BATCH = 4, SEQ = 8192, DM = 1024, M = BATCH * SEQ, FF = 2816, NGU = 2 * FF, DIN = 2752, DINP = 2816, NGATE = 3072, DEPTH = 2;
constexpr float NORM_EPS = 1e-6f;
constexpr float QSCALE = 0.125f * 1.4426950408889634f;
constexpr int C_SBQ = 0, C_SBK = 256, C_SBV = 512, C_NQ = 768, C_NKC = 1280, C_NVC = 1408, C_NKS = 1536, C_NVS = 1664, C_NKW = 1792, C_NVW = 1920, C_NG = 2048,
              C_DQ = 2072, C_DK = 2328, C_DV = 2392, C_IQ = 2456, C_IK = 2712, C_IW = 2744;
constexpr size_t MiB = 1u << 20;
constexpr size_t WS_CTL = 0, CTL_ZERO_BYTES = 1 * MiB;
constexpr size_t WS_TAB = 1 * MiB, TAB_CS_MAIN = 0, TAB_CS_IDX = 524288, TAB_CS_CMP = 786432, TAB_BIASPE = 819200;
constexpr size_t WS_W = 2 * MiB, WL_STRIDE = 50 * MiB;
constexpr size_t W_GU1 = 0, W_DN1 = 11534336, W_IN = 17301504, W_GATE = 23068672, W_BRA = 29360128, W_BRB = 29884416, W_BRC = 30932992, W_OUT = 31457280,
                 W_GU2 = 33554432, W_DN2 = 45088768, W_C1 = 50855936, W_C2 = 51904512, W_LEND = 51937280;
static_assert(W_LEND <= WL_STRIDE, "weights per layer");
constexpr size_t WS_XN = 102 * MiB;
constexpr size_t WS_R1 = 166 * MiB;
constexpr size_t WS_VT = WS_R1 + 176 * MiB;
constexpr size_t WS_OA = 358 * MiB, WS_OB = 374 * MiB, WS_OC = 406 * MiB;
constexpr size_t WS_KC = 422 * MiB, WS_VC = WS_KC + 524288;
constexpr size_t WS_SEL = 423 * MiB;
constexpr size_t WS_IDX = 424 * MiB;
constexpr size_t WS_IKC = 440 * MiB;
constexpr size_t WS_SS = 442 * MiB;
constexpr size_t WS_MG = 444 * MiB;
constexpr size_t WS_END = 508 * MiB;
constexpr int CW_KMAX = 64;
constexpr int CW_BAR = 4096;
constexpr int RING_BYTES = 131072;
constexpr int LDS_BYTES = 147456;
constexpr int MISC_OFF = LDS_BYTES - 256;

#define CAS __attribute__((address_space(4)))
#define HY_IN(F_, k_) ((const float*)(const GAS float*)(F_).kin[k_])
struct Frame {
    unsigned char* lds;
    int tid, lane, wave, G, bid;
    const CAS unsigned long long* kin; GAS float* out; GAS unsigned char* ws;
};
__device__ __forceinline__ Frame fr_fresh(unsigned char* lds, int wave_s) {
    Frame F; F.lds = lds;
    int wv = wave_s; asm volatile("" : "+s"(wv));
    int lane = (int)__builtin_amdgcn_mbcnt_hi(~0u, __builtin_amdgcn_mbcnt_lo(~0u, 0u)); asm volatile("" : "+v"(lane));
    F.lane = lane; F.wave = wv; F.tid = wv * 64 + lane;
    const CAS unsigned long long* kin = (const CAS unsigned long long*)__builtin_amdgcn_kernarg_segment_ptr(); asm volatile("" : "+s"(kin));
    F.kin = kin; F.out = (GAS float*)kin[21]; F.ws = (GAS unsigned char*)kin[22];
    int G = gridDim.x, bid = blockIdx.x; asm volatile("" : "+s"(G), "+s"(bid));
    F.G = G; F.bid = bid;
    return F;
}
template <int CTRL> __device__ __forceinline__ float dppf(float x) { return __builtin_bit_cast(float, __builtin_amdgcn_update_dpp(0, __builtin_bit_cast(int, x), CTRL, 0xf, 0xf, true)); }
template <int CTRL> __device__ __forceinline__ int dppi(int x) { return __builtin_amdgcn_update_dpp(0, x, CTRL, 0xf, 0xf, true); }
constexpr int DPP_X1 = 0xB1, DPP_X2 = 0x4E, DPP_ROR4 = 0x124, DPP_ROR8 = 0x128, DPP_SHL4 = 0x104, DPP_SHR4 = 0x114;
__device__ __forceinline__ float x16_other(float x, int lane) { auto r = __builtin_amdgcn_permlane16_swap(__float_as_uint(x), __float_as_uint(x), false, false); return __uint_as_float((lane & 16) ? r[0] : r[1]); }
__device__ __forceinline__ float x32_other(float x, int lane) { auto r = __builtin_amdgcn_permlane32_swap(__float_as_uint(x), __float_as_uint(x), false, false); return __uint_as_float((lane & 32) ? r[0] : r[1]); }
__device__ __forceinline__ float x16_sum(float x) { auto r = __builtin_amdgcn_permlane16_swap(__float_as_uint(x), __float_as_uint(x), false, false); return __uint_as_float(r[0]) + __uint_as_float(r[1]); }
__device__ __forceinline__ float x32_sum(float x) { auto r = __builtin_amdgcn_permlane32_swap(__float_as_uint(x), __float_as_uint(x), false, false); return __uint_as_float(r[0]) + __uint_as_float(r[1]); }
__device__ __forceinline__ float x16_max(float x) { auto r = __builtin_amdgcn_permlane16_swap(__float_as_uint(x), __float_as_uint(x), false, false); return fmaxf(__uint_as_float(r[0]), __uint_as_float(r[1])); }
__device__ __forceinline__ float x32_max(float x) { auto r = __builtin_amdgcn_permlane32_swap(__float_as_uint(x), __float_as_uint(x), false, false); return fmaxf(__uint_as_float(r[0]), __uint_as_float(r[1])); }
__device__ __forceinline__ float x16_min(float x) { auto r = __builtin_amdgcn_permlane16_swap(__float_as_uint(x), __float_as_uint(x), false, false); return fminf(__uint_as_float(r[0]), __uint_as_float(r[1])); }
__device__ __forceinline__ float x32_min(float x) { auto r = __builtin_amdgcn_permlane32_swap(__float_as_uint(x), __float_as_uint(x), false, false); return fminf(__uint_as_float(r[0]), __uint_as_float(r[1])); }
__device__ __forceinline__ float row16_sum(float v) { v += dppf<DPP_X1>(v); v += dppf<DPP_X2>(v); v += dppf<DPP_ROR4>(v); v += dppf<DPP_ROR8>(v); return v; }
__device__ __forceinline__ float wave_sum(float v) { return x32_sum(x16_sum(row16_sum(v))); }
__device__ __forceinline__ float wave_max(float v) { v = fmaxf(v, dppf<DPP_X1>(v)); v = fmaxf(v, dppf<DPP_X2>(v)); v = fmaxf(v, dppf<DPP_ROR4>(v)); v = fmaxf(v, dppf<DPP_ROR8>(v)); return x32_max(x16_max(v)); }
__device__ __forceinline__ float bf2f(unsigned short h) { return __uint_as_float((unsigned)h << 16); }
__device__ __forceinline__ float bflo(unsigned w) { return __uint_as_float(w << 16); }
__device__ __forceinline__ float bfhi(unsigned w) { return __uint_as_float(w & 0xffff0000u); }
__device__ __forceinline__ bf16* wl_ptr(const Frame& F, int l, size_t off) { return (bf16*)(F.ws + WS_W + (size_t)l * WL_STRIDE + off); }

__device__ __forceinline__ void transpose_item(const float* W, int K, int N, bf16* WT, int mode, float* scr, int item, int lane, const float* gain, int dpitch, int dkoff) {
    const int nblk = N / 32, kb = item / nblk, nb = item % nblk, k0 = 64 * kb, n0 = 32 * nb;
    int drow = n0;
    if (mode == 1) drow = (n0 < FF) ? (n0 / 128) * 256 + (n0 % 128) : ((n0 - FF) / 128) * 256 + 128 + ((n0 - FF) % 128);
    {
        const int n4 = (lane & 7) * 4; f32x4 wv[8]; float gv[8];
#pragma unroll
        for (int i = 0; i < 8; ++i) { const int kk = 8 * i + (lane >> 3); wv[i] = *(const f32x4*)(W + (size_t)(k0 + kk) * N + n0 + n4); gv[i] = gain ? gain[k0 + kk] : 1.0f; }
#pragma unroll
        for (int i = 0; i < 8; ++i) { const int kk = 8 * i + (lane >> 3); float* d = scr + kk * 33 + n4; d[0] = wv[i][0] * gv[i]; d[1] = wv[i][1] * gv[i]; d[2] = wv[i][2] * gv[i]; d[3] = wv[i][3] * gv[i]; } }
    LDS_WAIT(); asm volatile("" ::: "memory");
    const int c = lane & 7;
#pragma unroll
    for (int j = 0; j < 4; ++j) { const int n = (lane >> 3) + 8 * j; const float* s = scr + (8 * c) * 33 + n;
        v4u o; o.x = pk2(s[0 * 33], s[1 * 33]); o.y = pk2(s[2 * 33], s[3 * 33]); o.z = pk2(s[4 * 33], s[5 * 33]); o.w = pk2(s[6 * 33], s[7 * 33]);
        *(v4u*)(WT + (size_t)(drow + n) * dpitch + dkoff + k0 + 8 * c) = o; }
    LDS_WAIT(); asm volatile("" ::: "memory");
}
#define HY_TR(src, K_, N_, dst, mode, gain) do { const int items_ = ((K_) / 64) * ((N_) / 32); for (int it_ = gw; it_ < items_; it_ += NGW) transpose_item((src), (K_), (N_), (dst), (mode), scr, it_, F.lane, (gain), (K_), 0); } while (0)
#define HY_TRC(src, K_, N_, dst, dkoff_) do { const int items_ = ((K_) / 64) * ((N_) / 32); for (int it_ = gw; it_ < items_; it_ += NGW) transpose_item((src), (K_), (N_), (dst), 0, scr, it_, F.lane, nullptr, DM, (dkoff_)); } while (0)
__device__ __forceinline__ void p0_prologue(Frame& F) {
    float* scr = (float*)(F.lds + F.wave * 16384);
    const int gw = F.bid * NWAVES + F.wave, NGW = F.G * NWAVES;
    for (int l = 0; l < DEPTH; ++l) {
        HY_TR(HY_IN(F, 2) + (size_t)l * DM * NGU, DM, NGU, wl_ptr(F, l, W_GU1), 1, HY_IN(F, 1) + (size_t)l * DM);
        HY_TR(HY_IN(F, 3) + (size_t)l * FF * DM, FF, DM, wl_ptr(F, l, W_DN1), 0, nullptr);
        HY_TR(HY_IN(F, 5) + (size_t)l * DM * DIN, DM, DIN, wl_ptr(F, l, W_IN), 0, HY_IN(F, 4) + (size_t)l * DM);
        HY_TR(HY_IN(F, 6) + (size_t)l * DM * NGATE, DM, NGATE, wl_ptr(F, l, W_GATE), 0, HY_IN(F, 4) + (size_t)l * DM);
        HY_TRC(HY_IN(F, 14) + (size_t)l * 256 * DM, 256, DM, wl_ptr(F, l, W_BRA), 0);
        HY_TRC(HY_IN(F, 15) + (size_t)l * 512 * DM, 512, DM, wl_ptr(F, l, W_BRA), 256);
        HY_TRC(HY_IN(F, 16) + (size_t)l * 256 * DM, 256, DM, wl_ptr(F, l, W_BRA), 768);
        HY_TR(HY_IN(F, 17) + (size_t)l * DM * DM, DM, DM, wl_ptr(F, l, W_OUT), 0, nullptr);
        HY_TR(HY_IN(F, 19) + (size_t)l * DM * NGU, DM, NGU, wl_ptr(F, l, W_GU2), 1, HY_IN(F, 18) + (size_t)l * DM);
        HY_TR(HY_IN(F, 20) + (size_t)l * FF * DM, FF, DM, wl_ptr(F, l, W_DN2), 0, nullptr);
        for (int kv = 0; kv < 2; ++kv) {
            HY_TR(HY_IN(F, 10) + ((size_t)l * 2 + kv) * 2048 * 128, 2048, 128, wl_ptr(F, l, W_C1) + (size_t)kv * 128 * 2048, 0, nullptr);
            HY_TR(HY_IN(F, 11) + ((size_t)l * 2 + kv) * 128 * 64, 128, 64, wl_ptr(F, l, W_C2) + (size_t)kv * 64 * 128, 0, nullptr);
        }
        { v4u* z = (v4u*)(wl_ptr(F, l, W_IN) + (size_t)DIN * DM); const int n16 = (DINP - DIN) * DM * 2 / 16;
          for (int i = (F.bid * NTHREADS + F.tid); i < n16; i += F.G * NTHREADS) z[i] = (v4u){0u, 0u, 0u, 0u}; }
    }
    { unsigned long long* SS = (unsigned long long*)(F.ws + WS_SS); bf16* XN = (bf16*)(F.ws + WS_XN); const float* X = HY_IN(F, 0);
      for (int i = F.bid * NTHREADS + F.tid; i < (DEPTH * 3 - 1) * M; i += F.G * NTHREADS) SS[M + i] = 0ull;
      for (int m = gw; m < M; m += NGW) { const f32x4* xr = (const f32x4*)(X + (size_t)m * DM) + F.lane; f32x4 v[4]; float s = 0.f;
#pragma unroll
          for (int j = 0; j < 4; ++j) { v[j] = xr[64 * j]; s += (v[j].x * v[j].x + v[j].y * v[j].y) + (v[j].z * v[j].z + v[j].w * v[j].w); }
          s = wave_sum(s); if (F.lane == 0) SS[m] = (unsigned long long)(s * 1048576.0f);
          unsigned long long* o8 = (unsigned long long*)(XN + (size_t)m * DM) + F.lane;
#pragma unroll
          for (int j = 0; j < 4; ++j) o8[64 * j] = (unsigned long long)pk2(v[j].x, v[j].y) | ((unsigned long long)pk2(v[j].z, v[j].w) << 32); } }
    { float* tm = (float*)(F.ws + WS_TAB + TAB_CS_MAIN); float* ti = (float*)(F.ws + WS_TAB + TAB_CS_IDX); float* tc = (float*)(F.ws + WS_TAB + TAB_CS_CMP);
      const int gt = F.bid * NTHREADS + F.tid, NGT = F.G * NTHREADS;
      for (int e = gt; e < SEQ * 8; e += NGT) { const int t = e >> 3, i = e & 7; const float inv = (float)pow(500000.0, -(double)i / 8.0); const float ang = (float)t * inv;
          tm[2 * e] = (float)cos((double)ang); tm[2 * e + 1] = (float)sin((double)ang); }
      for (int e = gt; e < SEQ * 4; e += NGT) { const int t = e >> 2, i = e & 3; const float inv = (float)pow(500000.0, -(double)i / 4.0); const float ang = (float)t * inv;
          ti[2 * e] = (float)cos((double)ang); ti[2 * e + 1] = (float)sin((double)ang); }
      for (int e = gt; e < 512 * 8; e += NGT) { const int c = e >> 3, i = e & 7; const float inv = (float)pow(500000.0, -(double)i / 8.0); const float ang = (float)(16 * c + 31) * inv;
          tc[2 * e] = (float)cos((double)ang); tc[2 * e + 1] = (float)sin((double)ang); }
    }
    { float* bp = (float*)(F.ws + WS_TAB + TAB_BIASPE);
      for (int o = gw; o < DEPTH * 2 * 128; o += NGW) { const int lk = o >> 7, n = o & 127; const float* pe = HY_IN(F, 9) + (size_t)lk * 2048; const float* w1 = HY_IN(F, 10) + (size_t)lk * 2048 * 128;
          float s = 0.f; for (int k = F.lane; k < 2048; k += 64) s += pe[k] * w1[(size_t)k * 128 + n];
          s = wave_sum(s); if (F.lane == 0) bp[o] = s; } }
}
__device__ __forceinline__ void norm_phase(Frame& F, const float* X, const float* g, bf16* XN) {
    const int gw = F.bid * NWAVES + F.wave, NGW = F.G * NWAVES;
    f32x4 gv[4];
#pragma unroll
    for (int j = 0; j < 4; ++j) gv[j] = ((const f32x4*)g)[F.lane + 64 * j];
    for (int m = gw; m < M; m += NGW) {
        const f32x4* xr = (const f32x4*)(X + (size_t)m * DM) + F.lane;
        f32x4 v[4]; float s = 0.f;
#pragma unroll
        for (int j = 0; j < 4; ++j) { v[j] = xr[64 * j]; s += (v[j].x * v[j].x + v[j].y * v[j].y) + (v[j].z * v[j].z + v[j].w * v[j].w); }
        const float rstd = rsqrtf(wave_sum(s) * (1.f / DM) + NORM_EPS);
        unsigned long long* o8 = (unsigned long long*)(XN + (size_t)m * DM) + F.lane;
#pragma unroll
        for (int j = 0; j < 4; ++j) o8[64 * j] = (unsigned long long)pk2(v[j].x * rstd * gv[j].x, v[j].y * rstd * gv[j].y) | ((unsigned long long)pk2(v[j].z * rstd * gv[j].z, v[j].w * rstd * gv[j].w) << 32);
    }
}

__device__ __forceinline__ void prep_phase(Frame& F, int l) {
    const int gw = F.bid * NWAVES + F.wave, NGW = F.G * NWAVES, lane = F.lane;
    bf16* PROJ = (bf16*)(F.ws + WS_R1);
    const float* cs_main = (const float*)(F.ws + WS_TAB + TAB_CS_MAIN); const float* cs_idx = (const float*)(F.ws + WS_TAB + TAB_CS_IDX);
    const float g_nq = HY_IN(F, 7)[l * 64 + lane], g_ks = HY_IN(F, 8)[(l * 3 + 1) * 64 + lane], g_kw = HY_IN(F, 8)[(l * 3 + 2) * 64 + lane], g_dq = HY_IN(F, 12)[l * 64 + lane], g_dk = HY_IN(F, 13)[l * 64 + lane];
    unsigned kmx = 0u;
    float nxv[17], nxiq, nxik, nrc, nrs, nic, nis; bf16 nraw;
#define HY_PREP_LOAD(mm_) do { const int t_ = (mm_) & (SEQ - 1); const bf16* p_ = PROJ + (size_t)(mm_) * DINP; const int ri_ = lane & 7, i4_ = lane & 3; \
        nrc = cs_main[(t_ * 8 + ri_) * 2]; nrs = cs_main[(t_ * 8 + ri_) * 2 + 1]; nic = cs_idx[(t_ * 4 + i4_) * 2]; nis = cs_idx[(t_ * 4 + i4_) * 2 + 1]; \
        nxiq = bf2f(p_[C_IQ + 32 * (lane >> 3) + (lane & 7)]); nxik = bf2f(p_[C_IK + (lane & 7)]); nraw = p_[C_IK + (lane & 31)]; \
        _Pragma("unroll") for (int v = 0; v < 17; ++v) { const int col = (v < 8) ? C_NQ + 64 * v : (v < 10) ? C_NKS + 64 * (v - 8) : (v < 12) ? C_NKW + 64 * (v - 10) : (v < 16) ? C_DQ + 64 * (v - 12) : C_DK; \
            nxv[v] = bf2f(p_[col + lane]); } } while (0)
    HY_PREP_LOAD(gw);
    for (int m = gw; m < M; m += NGW) {
        bf16* p = PROJ + (size_t)m * DINP;
        const float rc = nrc, rs = nrs, xiq = nxiq, xik = nxik, ic = nic, is = nis; const bf16 xik_raw = nraw; kmx = max(kmx, ((unsigned)xik_raw & 0x7fffu) << 16);
        float xv[17];
#pragma unroll
        for (int v = 0; v < 17; ++v) xv[v] = nxv[v];
        if (m + NGW < M) HY_PREP_LOAD(m + NGW);
#pragma unroll
        for (int v = 0; v < 17; ++v) { const int col = (v < 8) ? C_NQ + 64 * v : (v < 10) ? C_NKS + 64 * (v - 8) : (v < 12) ? C_NKW + 64 * (v - 10) : (v < 16) ? C_DQ + 64 * (v - 12) : C_DK;
            const float gain = (v < 8) ? g_nq : (v < 10) ? g_ks : (v < 12) ? g_kw : (v < 16) ? g_dq : g_dk, post = (v < 8 || (v >= 12 && v < 16)) ? QSCALE : 1.f;
            const float x = xv[v];
            const float ss = wave_sum(x * x);
            float y = x * rsqrtf(ss * (1.f / 64.f) + NORM_EPS) * gain;
            const float pr = dppf<DPP_ROR8>(y);
            if (lane < 8) y = y * rc - pr * rs; else if (lane < 16) y = y * rc + pr * rs;
            p[col + lane] = (bf16)f2bf(y * post);
        }
        { const int hh = lane >> 3, dd = lane & 7; const float c = ic, s = is;
          const float x = xiq; const float pr = __shfl_xor(x, 4);
          const float y = (dd < 4) ? x * c - pr * s : x * c + pr * s; p[C_IQ + 32 * hh + dd] = (bf16)f2bf(y);
          const float xk = xik; const float prk = __shfl_xor(xk, 4);
          const float yk = (dd < 4) ? xk * c - prk * s : xk * c + prk * s;
          bf16* ikc = (bf16*)(F.ws + WS_IKC) + (size_t)m * 32;
          if (lane < 8) ikc[lane] = (bf16)f2bf(yk); else if (lane < 32) ikc[lane] = xik_raw; }
    }
#undef HY_PREP_LOAD
    { const float km = wave_max(__uint_as_float(kmx)); if (lane == 0) atomicMax((unsigned*)(F.ws + WS_CTL) + CW_KMAX + l, __float_as_uint(km)); }
}


#define MFMA16(a, b, c) __builtin_amdgcn_mfma_f32_16x16x32_bf16((a), (b), (c), 0, 0, 0)
#define MFMA32(a, b, c) __builtin_amdgcn_mfma_f32_32x32x16_bf16((a), (b), (c), 0, 0, 0)
typedef unsigned hy_u32x2 __attribute__((ext_vector_type(2)));
__device__ __forceinline__ void st4_bf16(bf16* p, float a, float b, float c, float d) { hy_u32x2 w; w.x = pg8::cvtpk_s(a, b); w.y = pg8::cvtpk_s(c, d); *(hy_u32x2*)p = w; }
__device__ __forceinline__ void add4_bf16(bf16* p, float a, float b, float c, float d) { const hy_u32x2 q = *(const hy_u32x2*)p;
    hy_u32x2 w; w.x = pg8::cvtpk_s(a + __uint_as_float(q.x << 16), b + __uint_as_float(q.x & 0xffff0000u)); w.y = pg8::cvtpk_s(c + __uint_as_float(q.y << 16), d + __uint_as_float(q.y & 0xffff0000u)); *(hy_u32x2*)p = w; }
__device__ __forceinline__ void cmp_phase(Frame& F, int l) {
    const int lane = F.lane, wave = F.wave, r = lane & 15, q = lane >> 4, kq = wave & 3, wg = wave >> 2;
    const bf16* PROJ = (const bf16*)(F.ws + WS_R1); bf16* KC = (bf16*)(F.ws + WS_KC); bf16* VC = (bf16*)(F.ws + WS_VC);
    const bf16* W1 = wl_ptr(F, l, W_C1); const bf16* W2 = wl_ptr(F, l, W_C2);
    const float* bp = (const float*)(F.ws + WS_TAB + TAB_BIASPE) + l * 256; const float* cs_cmp = (const float*)(F.ws + WS_TAB + TAB_CS_CMP);
    const float* kn0 = HY_IN(F, 8) + (size_t)(l * 3 + 0) * 64;
    float* Pw = (float*)(F.lds + wave * 8192);
    bf16* Hs = (bf16*)(F.lds + 65536 + wg * 8192);
    const int niter = (512 + 2 * F.G - 1) / (2 * F.G);
    for (int it = 0; it < niter; ++it) {
        const int task = it * 2 * F.G + F.bid * 2 + wg; const bool live = task < 512;
        const int kv = (task >> 8) & 1, rem = task & 255, bg = rem >> 5, ct = rem & 31, b = bg >> 1, g = bg & 1;
        f32x4 acc[8];
#pragma unroll
        for (int nt = 0; nt < 8; ++nt) acc[nt] = (f32x4){0.f, 0.f, 0.f, 0.f};
        if (live) {
            int c_r = 16 * ct + r; if (c_r > 510) c_r = 510;
            const bf16* arow = PROJ + ((size_t)b * SEQ + 16 * c_r) * DINP + (kv ? C_NVC : C_NKC) + g * 64 + 8 * q;
            const bf16* w1 = W1 + (size_t)kv * 128 * 2048 + (size_t)r * 2048 + 8 * q;
#pragma unroll 4
            for (int k4 = 0; k4 < 16; ++k4) { const int ks = 16 * kq + k4;
                const bf16x8 a = *(const bf16x8*)(arow + (size_t)(ks >> 1) * DINP + (ks & 1) * 32);
#pragma unroll
                for (int nt = 0; nt < 8; ++nt) { const bf16x8 bb = *(const bf16x8*)(w1 + (size_t)nt * 16 * 2048 + 32 * ks); acc[nt] = MFMA16(a, bb, acc[nt]); }
            }
        }
#pragma unroll
        for (int nt = 0; nt < 8; ++nt)
#pragma unroll
            for (int e = 0; e < 4; ++e) Pw[(4 * q + e) * 128 + 16 * nt + r] = acc[nt][e];
        __syncthreads();
        if (live && kq == 0) {
#pragma unroll
            for (int nt = 0; nt < 8; ++nt)
#pragma unroll
                for (int e = 0; e < 4; ++e) { const float* pp = Pw + (4 * q + e) * 128 + 16 * nt + r; acc[nt][e] = (pp[0] + pp[2048]) + (pp[4096] + pp[6144]); }
#pragma unroll
            for (int nt = 0; nt < 8; ++nt) { const float bias = bp[kv * 128 + 16 * nt + r];
#pragma unroll
                for (int e = 0; e < 4; ++e) Hs[(4 * q + e) * 136 + 16 * nt + r] = (bf16)f2bf(pg8::silu_f(acc[nt][e] + bias)); }
            LDS_WAIT(); asm volatile("" ::: "memory");
            f32x4 acc2[4];
#pragma unroll
            for (int n2 = 0; n2 < 4; ++n2) acc2[n2] = (f32x4){0.f, 0.f, 0.f, 0.f};
#pragma unroll
            for (int s = 0; s < 4; ++s) { const bf16x8 a = *(const bf16x8*)(Hs + r * 136 + 32 * s + 8 * q);
#pragma unroll
                for (int n2 = 0; n2 < 4; ++n2) { const bf16x8 bb = *(const bf16x8*)(W2 + (size_t)kv * 64 * 128 + (size_t)(16 * n2 + r) * 128 + 32 * s + 8 * q); acc2[n2] = MFMA16(a, bb, acc2[n2]); } }
            LDS_WAIT(); asm volatile("" ::: "memory");
            bf16* dst = kv ? VC : KC;
#pragma unroll
            for (int e = 0; e < 4; ++e) {
                const int c = 16 * ct + 4 * q + e;
                float y[4];
#pragma unroll
                for (int n2 = 0; n2 < 4; ++n2) y[n2] = acc2[n2][e];
                if (kv == 0) {
                    float ss = (y[0] * y[0] + y[1] * y[1]) + (y[2] * y[2] + y[3] * y[3]);
                    ss = row16_sum(ss);
                    const float rstd = rsqrtf(ss * (1.f / 64.f) + NORM_EPS);
#pragma unroll
                    for (int n2 = 0; n2 < 4; ++n2) y[n2] = y[n2] * rstd * kn0[16 * n2 + r];
                    const float pr = dppf<DPP_ROR8>(y[0]); const int ri = r & 7; const float cc = cs_cmp[(c * 8 + ri) * 2], sn = cs_cmp[(c * 8 + ri) * 2 + 1];
                    y[0] = (r < 8) ? y[0] * cc - pr * sn : y[0] * cc + pr * sn;
                }
#pragma unroll
                for (int n2 = 0; n2 < 4; ++n2) { const bf16 val = (c == 511) ? (bf16)0 : (bf16)f2bf(y[n2]);
                    if (kv == 0) dst[((size_t)bg * 512 + c) * 64 + 16 * n2 + r] = val;
                    else { const int pc = (c & ~12) | (((c >> 2) & 1) << 3) | (((c >> 3) & 1) << 2); dst[((size_t)bg * 64 + 16 * n2 + r) * 512 + pc] = val; } }
            }
        }
        __syncthreads();
    }
}

__device__ __forceinline__ void nsa_unit(int u, int& bg, int& tile) {
    const int i = u >> 8, v = u & 255, j = v & 31; bg = v >> 5;
    tile = (i == 0) ? j : (i == 1) ? 63 - j : (i == 2) ? 64 + j : 127 - j;
}
__device__ __forceinline__ bf16x8 pack8(const f32x16& p, int base) {
    v4u w; w.x = pg8::cvtpk_s(p[base], p[base + 1]); w.y = pg8::cvtpk_s(p[base + 2], p[base + 3]); w.z = pg8::cvtpk_s(p[base + 4], p[base + 5]); w.w = pg8::cvtpk_s(p[base + 6], p[base + 7]);
    return __builtin_bit_cast(bf16x8, w);
}
__device__ __forceinline__ unsigned fkey(float f) { const unsigned u = __float_as_uint(f); return (u & 0x80000000u) ? ~u : (u | 0x80000000u); }
__device__ __forceinline__ void nsa1_phase(Frame& F, int l) {
    const int lane = F.lane, wave = F.wave, r = lane & 31, hf = lane >> 5, hh = r >> 3, tk = r & 7;
    const bf16* PROJ = (const bf16*)(F.ws + WS_R1); const bf16* KCg = (const bf16*)(F.ws + WS_KC); const bf16* VCt = (const bf16*)(F.ws + WS_VC);
    bf16* OB = (bf16*)(F.ws + WS_OA) + 256; unsigned long long* SEL = (unsigned long long*)(F.ws + WS_SEL);
    float* IMP = (float*)(F.lds + wave * 16512);
    float* INV = IMP + 4096;
    const float Bcmp = 11.66f * wave_max(fabsf(HY_IN(F, 7)[l * 64 + lane])) * wave_max(fabsf(HY_IN(F, 8)[(l * 3 + 0) * 64 + lane]));
    const bool fixed_ref = Bcmp < 60.f;
    for (int u = F.bid; u < 1024; u += F.G) {
        int bg, tile; nsa_unit(u, bg, tile); const int b = bg >> 1, g = bg & 1, t0 = tile * 64 + 8 * wave;
        const int t = t0 + tk; const size_t m = (size_t)b * SEQ + t;
        bf16x8 qf[4];
#pragma unroll
        for (int s = 0; s < 4; ++s) qf[s] = *(const bf16x8*)(PROJ + m * DINP + C_NQ + (4 * g + hh) * 64 + 16 * s + 8 * hf);
        const int nv = (t >= 31) ? ((t - 31) >> 4) + 1 : 0;
        const int tl = t0 + 7; const int nvw = (tl >= 31) ? ((tl - 31) >> 4) + 1 : 0, nkt = (nvw + 31) >> 5;
        if (!fixed_ref) {
#pragma unroll
            for (int i = 0; i < 16; ++i) IMP[64 * i + lane] = 0.f; }
        const bf16* kb = KCg + (size_t)bg * 512 * 64 + r * 64 + 8 * hf;
        const bf16* vb = VCt + (size_t)bg * 64 * 512 + (size_t)r * 512 + 8 * hf;
        f32x16 o0, o1;
#pragma unroll
        for (int i = 0; i < 16; ++i) { o0[i] = 0.f; o1[i] = 0.f; }
        float inv;
        if (fixed_ref) {
            float lsum = 0.f, prevlast = 0.f;
            bf16x8 ka[4], va[4];
#pragma unroll
            for (int s = 0; s < 4; ++s) ka[s] = *(const bf16x8*)(kb + 16 * s);
            va[0] = *(const bf16x8*)(vb); va[1] = *(const bf16x8*)(vb + 16); va[2] = *(const bf16x8*)(vb + 32 * 512); va[3] = *(const bf16x8*)(vb + 32 * 512 + 16);
            float* impw = IMP + (tk * 4 + hh) * 128 + hf;
#pragma unroll 1
            for (int kt = 0; kt < nkt; ++kt) {
                bf16x8 kn[4], vn[4];
                const int ktn = (kt + 1 < nkt) ? kt + 1 : kt;
#pragma unroll
                for (int s = 0; s < 4; ++s) kn[s] = *(const bf16x8*)(kb + (size_t)ktn * 2048 + 16 * s);
                vn[0] = *(const bf16x8*)(vb + 32 * ktn); vn[1] = *(const bf16x8*)(vb + 32 * ktn + 16); vn[2] = *(const bf16x8*)(vb + 32 * 512 + 32 * ktn); vn[3] = *(const bf16x8*)(vb + 32 * 512 + 32 * ktn + 16);
                f32x16 sT;
#pragma unroll
                for (int i = 0; i < 16; ++i) sT[i] = -Bcmp;
#pragma unroll
                for (int s = 0; s < 4; ++s) sT = MFMA32(ka[s], qf[s], sT);
                float ps = 0.f;
#pragma unroll
                for (int i = 0; i < 16; ++i) { const int c = 32 * kt + (i & 3) + 8 * (i >> 2) + 4 * hf; sT[i] = (c < nv) ? __builtin_amdgcn_exp2f(sT[i]) : 0.f; ps += sT[i]; }
                lsum += ps;
                float I[4], pl[4];
#pragma unroll
                for (int k = 0; k < 4; ++k) { I[k] = (sT[4 * k] + sT[4 * k + 1]) + (sT[4 * k + 2] + sT[4 * k + 3]); pl[k] = x32_other(sT[4 * k + 3], lane); }
                I[0] += hf ? pl[0] : prevlast; I[1] += hf ? pl[1] : pl[0]; I[2] += hf ? pl[2] : pl[1]; I[3] += hf ? pl[3] : pl[2];
                prevlast = pl[3];
#pragma unroll
                for (int k = 0; k < 4; ++k) impw[8 * kt + 2 * k] = I[k];
                const bf16x8 pf0 = pack8(sT, 0), pf1 = pack8(sT, 8);
                o0 = MFMA32(va[0], pf0, o0); o0 = MFMA32(va[1], pf1, o0); o1 = MFMA32(va[2], pf0, o1); o1 = MFMA32(va[3], pf1, o1);
#pragma unroll
                for (int s = 0; s < 4; ++s) { ka[s] = kn[s]; va[s] = vn[s]; }
            }
            const float lt = x32_sum(lsum); inv = (nv > 0) ? 1.f / lt : 0.f;
            if (hf == 0) INV[tk * 4 + hh] = inv;
#pragma unroll
            for (int i = 0; i < 16; ++i) { o0[i] *= inv; o1[i] *= inv; }
        } else {
        float mrun = -1e30f, lrun = 0.f;
        bf16x8 ka[4];
#pragma unroll
        for (int s = 0; s < 4; ++s) ka[s] = *(const bf16x8*)(kb + 16 * s);
#pragma unroll 1
        for (int kt = 0; kt < nkt; ++kt) {
            bf16x8 kn[4];
            const int ktn = (kt + 1 < nkt) ? kt + 1 : kt;
#pragma unroll
            for (int s = 0; s < 4; ++s) kn[s] = *(const bf16x8*)(kb + (size_t)ktn * 2048 + 16 * s);
            f32x16 sT;
#pragma unroll
            for (int i = 0; i < 16; ++i) sT[i] = 0.f;
#pragma unroll
            for (int s = 0; s < 4; ++s) sT = MFMA32(ka[s], qf[s], sT);
            float mx = -1e30f;
#pragma unroll
            for (int i = 0; i < 16; ++i) { const int c = 32 * kt + (i & 3) + 8 * (i >> 2) + 4 * hf; sT[i] = (c < nv) ? sT[i] : -1e30f; mx = fmaxf(mx, sT[i]); }
            const float mn = fmaxf(mrun, mx); float ps = 0.f;
#pragma unroll
            for (int i = 0; i < 16; ++i) ps += (sT[i] > -1e29f) ? __builtin_amdgcn_exp2f(sT[i] - mn) : 0.f;
            lrun = lrun * __builtin_amdgcn_exp2f(mrun - mn) + ps; mrun = mn;
#pragma unroll
            for (int s = 0; s < 4; ++s) ka[s] = kn[s];
        }
        float mf;
        { const float mo = x32_other(mrun, lane), lo_ = x32_other(lrun, lane); mf = fmaxf(mrun, mo);
          const float lf = lrun * __builtin_amdgcn_exp2f(mrun - mf) + lo_ * __builtin_amdgcn_exp2f(mo - mf); inv = (nv > 0) ? 1.f / lf : 0.f; }
        float prevlast = 0.f;
        bf16x8 va[4];
#pragma unroll
        for (int s = 0; s < 4; ++s) ka[s] = *(const bf16x8*)(kb + 16 * s);
        va[0] = *(const bf16x8*)(vb); va[1] = *(const bf16x8*)(vb + 16); va[2] = *(const bf16x8*)(vb + 32 * 512); va[3] = *(const bf16x8*)(vb + 32 * 512 + 16);
#pragma unroll 1
        for (int kt = 0; kt < nkt; ++kt) {
            bf16x8 kn[4], vn[4];
            const int ktn = (kt + 1 < nkt) ? kt + 1 : kt;
#pragma unroll
            for (int s = 0; s < 4; ++s) kn[s] = *(const bf16x8*)(kb + (size_t)ktn * 2048 + 16 * s);
            vn[0] = *(const bf16x8*)(vb + 32 * ktn); vn[1] = *(const bf16x8*)(vb + 32 * ktn + 16); vn[2] = *(const bf16x8*)(vb + 32 * 512 + 32 * ktn); vn[3] = *(const bf16x8*)(vb + 32 * 512 + 32 * ktn + 16);
            f32x16 sT;
#pragma unroll
            for (int i = 0; i < 16; ++i) sT[i] = 0.f;
#pragma unroll
            for (int s = 0; s < 4; ++s) sT = MFMA32(ka[s], qf[s], sT);
#pragma unroll
            for (int i = 0; i < 16; ++i) { const int c = 32 * kt + (i & 3) + 8 * (i >> 2) + 4 * hf; sT[i] = (c < nv) ? __builtin_amdgcn_exp2f(sT[i] - mf) * inv : 0.f; }
            float I[4], pl[4];
#pragma unroll
            for (int k = 0; k < 4; ++k) { I[k] = (sT[4 * k] + sT[4 * k + 1]) + (sT[4 * k + 2] + sT[4 * k + 3]); pl[k] = x32_other(sT[4 * k + 3], lane); }
            I[0] += hf ? pl[0] : prevlast; I[1] += hf ? pl[1] : pl[0]; I[2] += hf ? pl[2] : pl[1]; I[3] += hf ? pl[3] : pl[2];
            prevlast = pl[3];
#pragma unroll
            for (int k = 0; k < 4; ++k) { I[k] += dppf<DPP_ROR8>(I[k]); I[k] = x16_sum(I[k]); }
            if (hh == 0) {
#pragma unroll
                for (int k = 0; k < 4; ++k) IMP[tk * 128 + 8 * kt + 2 * k + hf] = I[k]; }
            const bf16x8 pf0 = pack8(sT, 0), pf1 = pack8(sT, 8);
            o0 = MFMA32(va[0], pf0, o0); o0 = MFMA32(va[1], pf1, o0); o1 = MFMA32(va[2], pf0, o1); o1 = MFMA32(va[3], pf1, o1);
#pragma unroll
            for (int s = 0; s < 4; ++s) { ka[s] = kn[s]; va[s] = vn[s]; }
        }
        }
        { const float g0 = pg8::sigm_f(bf2f(PROJ[m * DINP + C_NG + (4 * g + hh) * 3 + 0]));
          bf16* op = OB + m * 1024 + (4 * g + hh) * 64;
#pragma unroll
          for (int k = 0; k < 4; ++k) { st4_bf16(op + 8 * k + 4 * hf, g0 * o0[4 * k], g0 * o0[4 * k + 1], g0 * o0[4 * k + 2], g0 * o0[4 * k + 3]); st4_bf16(op + 32 + 8 * k + 4 * hf, g0 * o1[4 * k], g0 * o1[4 * k + 1], g0 * o1[4 * k + 2], g0 * o1[4 * k + 3]); } }
        LDS_WAIT(); asm volatile("" ::: "memory");
#define HY_TOPK_KEYS(t2k_, u0_, u1_) do { const int t2_ = t0 + (t2k_), cur_ = t2_ >> 6, n0_ = lane, n1_ = lane + 64; float i0_, i1_; \
            if (fixed_ref) { i0_ = 0.f; i1_ = 0.f; \
                if (n0_ < 8 * nkt) { _Pragma("unroll") for (int h4 = 0; h4 < 4; ++h4) i0_ += IMP[((t2k_) * 4 + h4) * 128 + n0_] * INV[(t2k_) * 4 + h4]; } \
                if (n1_ < 8 * nkt) { _Pragma("unroll") for (int h4 = 0; h4 < 4; ++h4) i1_ += IMP[((t2k_) * 4 + h4) * 128 + n1_] * INV[(t2k_) * 4 + h4]; } \
            } else { i0_ = IMP[(t2k_) * 128 + n0_]; i1_ = IMP[(t2k_) * 128 + n1_]; } \
            const bool f0_ = (n0_ == 0) || (n0_ == cur_) || (n0_ == cur_ - 1), f1_ = (n1_ == cur_) || (n1_ == cur_ - 1); \
            const float sc0_ = (n0_ * 64 <= t2_) ? (f0_ ? 1.0e4f : i0_) : -INFINITY, sc1_ = (n1_ * 64 <= t2_) ? (f1_ ? 1.0e4f : i1_) : -INFINITY; \
            u0_ = fkey(sc0_); u1_ = fkey(sc1_); } while (0)
#define HY_TOPK_EMIT(t2k_, u0_, u1_, tau_) do { const int t2_ = t0 + (t2k_); \
            const int cgt_ = __popcll(__ballot(u0_ > tau_)) + __popcll(__ballot(u1_ > tau_)), need_ = 16 - cgt_; \
            const unsigned long long e0_ = __ballot(u0_ == tau_), e1_ = __ballot(u1_ == tau_); \
            const int pre0_ = (int)__builtin_amdgcn_mbcnt_hi((unsigned)(e0_ >> 32), __builtin_amdgcn_mbcnt_lo((unsigned)e0_, 0u)); \
            const int pre1_ = (int)__builtin_amdgcn_mbcnt_hi((unsigned)(e1_ >> 32), __builtin_amdgcn_mbcnt_lo((unsigned)e1_, 0u)) + __popcll(e0_); \
            const unsigned long long m0_ = __ballot((u0_ > tau_) || (u0_ == tau_ && pre0_ < need_)), m1_ = __ballot((u1_ > tau_) || (u1_ == tau_ && pre1_ < need_)); \
            if (lane == 0) { SEL[((size_t)bg * SEQ + t2_) * 2] = m0_; SEL[((size_t)bg * SEQ + t2_) * 2 + 1] = m1_; } } while (0)
        {   unsigned u0[8], u1[8], pf[8];
#pragma unroll
            for (int k = 0; k < 8; ++k) { HY_TOPK_KEYS(k, u0[k], u1[k]); pf[k] = 0u; }
#pragma unroll 1
            for (int bit = 31; bit >= 0; --bit) {
#pragma unroll
                for (int k = 0; k < 8; ++k) { const unsigned c = pf[k] | (1u << bit); const int n = __popcll(__ballot(u0[k] >= c)) + __popcll(__ballot(u1[k] >= c)); if (n >= 16) pf[k] = c; } }
#pragma unroll
            for (int k = 0; k < 8; ++k) HY_TOPK_EMIT(k, u0[k], u1[k], pf[k]);
        }
#undef HY_TOPK_KEYS
#undef HY_TOPK_EMIT
        LDS_WAIT(); asm volatile("" ::: "memory");
    }
}

__device__ __forceinline__ void vt_build(Frame& F) {
    const int gw = F.bid * NWAVES + F.wave, NGW = F.G * NWAVES, lane = F.lane;
    const bf16* PROJ = (const bf16*)(F.ws + WS_R1); bf16* VT = (bf16*)(F.ws + WS_VT);
    const int spk = (lane & ~12) | (((lane >> 2) & 1) << 3) | (((lane >> 3) & 1) << 2);
    for (int it = gw; it < 2048; it += NGW) {
        const int tile = it & 127, br = (it >> 7) & 1, bg = it >> 8, b = bg >> 1, g = bg & 1;
        const bf16* src = PROJ + ((size_t)b * SEQ + (size_t)tile * 64 + lane) * DINP + (br ? C_NVW : C_NVS) + 64 * g;
        uint4 v[8];
#pragma unroll
        for (int c = 0; c < 8; ++c) v[c] = *(const uint4*)(src + 8 * c);
        bf16* dst = VT + (size_t)it * 4096 + spk;
#pragma unroll
        for (int c = 0; c < 8; ++c) { bf16* d_ = dst + (8 * c) * 64;
            d_[0] = (bf16)(v[c].x & 0xffffu); d_[64] = (bf16)(v[c].x >> 16); d_[128] = (bf16)(v[c].y & 0xffffu); d_[192] = (bf16)(v[c].y >> 16);
            d_[256] = (bf16)(v[c].z & 0xffffu); d_[320] = (bf16)(v[c].z >> 16); d_[384] = (bf16)(v[c].w & 0xffffu); d_[448] = (bf16)(v[c].w >> 16); }
    }
}
struct FlashState { float m, l; f32x16 o0, o1; };
__device__ __forceinline__ void flash_tile(const bf16* Kt, const bf16* Vt, const bf16x8 (&qf)[4], FlashState& st, int r, int hf, int key0, int t, int lo_excl, bool allow) {
    f32x16 s0, s1;
#pragma unroll
    for (int i = 0; i < 16; ++i) { s0[i] = 0.f; s1[i] = 0.f; }
#pragma unroll
    for (int s = 0; s < 4; ++s) { const bf16x8 a0 = *(const bf16x8*)(Kt + r * 72 + 16 * s + 8 * hf), a1 = *(const bf16x8*)(Kt + (32 + r) * 72 + 16 * s + 8 * hf);
        s0 = MFMA32(a0, qf[s], s0); s1 = MFMA32(a1, qf[s], s1); }
    float mx = -1e30f;
#pragma unroll
    for (int i = 0; i < 16; ++i) { const int key = key0 + (i & 3) + 8 * (i >> 2) + 4 * hf;
        const bool ok0 = allow && key <= t && key > lo_excl, ok1 = allow && (key + 32) <= t && (key + 32) > lo_excl;
        s0[i] = ok0 ? s0[i] : -1e30f; s1[i] = ok1 ? s1[i] : -1e30f; mx = fmaxf(mx, fmaxf(s0[i], s1[i])); }
    mx = x32_max(mx);
    const float mn = fmaxf(st.m, mx), alpha = __builtin_amdgcn_exp2f(st.m - mn);
    float ps = 0.f;
#pragma unroll
    for (int i = 0; i < 16; ++i) { s0[i] = (s0[i] > -1e29f) ? __builtin_amdgcn_exp2f(s0[i] - mn) : 0.f; s1[i] = (s1[i] > -1e29f) ? __builtin_amdgcn_exp2f(s1[i] - mn) : 0.f; ps += s0[i] + s1[i]; }
    st.l = st.l * alpha + ps; st.m = mn;
#pragma unroll
    for (int i = 0; i < 16; ++i) { st.o0[i] *= alpha; st.o1[i] *= alpha; }
    const bf16x8 p00 = pack8(s0, 0), p01 = pack8(s0, 8), p10 = pack8(s1, 0), p11 = pack8(s1, 8);
    { const bf16* v0 = Vt + r * 72 + 8 * hf; const bf16* v1 = Vt + (32 + r) * 72 + 8 * hf;
      st.o0 = MFMA32(*(const bf16x8*)(v0), p00, st.o0); st.o0 = MFMA32(*(const bf16x8*)(v0 + 16), p01, st.o0); st.o0 = MFMA32(*(const bf16x8*)(v0 + 32), p10, st.o0); st.o0 = MFMA32(*(const bf16x8*)(v0 + 48), p11, st.o0);
      st.o1 = MFMA32(*(const bf16x8*)(v1), p00, st.o1); st.o1 = MFMA32(*(const bf16x8*)(v1 + 16), p01, st.o1); st.o1 = MFMA32(*(const bf16x8*)(v1 + 32), p10, st.o1); st.o1 = MFMA32(*(const bf16x8*)(v1 + 48), p11, st.o1); }
}
template <bool MASK>
__device__ __forceinline__ void flash_tile_fixed(const bf16* Kt, const bf16* Vt, const bf16x8 (&qf)[4], float& lsum, f32x16& o0, f32x16& o1, int r, int hf, const f32x16& cneg, bool allow, int key0, int t, int lo_excl) {
    f32x16 s0, s1;
    { const bf16x8 a0 = *(const bf16x8*)(Kt + r * 72 + 8 * hf), a1 = *(const bf16x8*)(Kt + (32 + r) * 72 + 8 * hf); s0 = MFMA32(a0, qf[0], cneg); s1 = MFMA32(a1, qf[0], cneg); }
#pragma unroll
    for (int s = 1; s < 4; ++s) { const bf16x8 a0 = *(const bf16x8*)(Kt + r * 72 + 16 * s + 8 * hf), a1 = *(const bf16x8*)(Kt + (32 + r) * 72 + 16 * s + 8 * hf);
        s0 = MFMA32(a0, qf[s], s0); s1 = MFMA32(a1, qf[s], s1); }
    float ps = 0.f;
#pragma unroll
    for (int i = 0; i < 16; ++i) {
        float p0 = __builtin_amdgcn_exp2f(s0[i]), p1 = __builtin_amdgcn_exp2f(s1[i]);
        if (MASK) { const int key = key0 + (i & 3) + 8 * (i >> 2) + 4 * hf; p0 = (key <= t && key > lo_excl) ? p0 : 0.f; p1 = (key + 32 <= t && key + 32 > lo_excl) ? p1 : 0.f; }
        s0[i] = p0; s1[i] = p1; ps += p0 + p1; }
    lsum += allow ? ps : 0.f;
    const unsigned am = allow ? 0xffffffffu : 0u;
    v4u q00 = __builtin_bit_cast(v4u, pack8(s0, 0)), q01 = __builtin_bit_cast(v4u, pack8(s0, 8)), q10 = __builtin_bit_cast(v4u, pack8(s1, 0)), q11 = __builtin_bit_cast(v4u, pack8(s1, 8));
    q00 &= am; q01 &= am; q10 &= am; q11 &= am;
    const bf16x8 p00 = __builtin_bit_cast(bf16x8, q00), p01 = __builtin_bit_cast(bf16x8, q01), p10 = __builtin_bit_cast(bf16x8, q10), p11 = __builtin_bit_cast(bf16x8, q11);
    const bf16* v0 = Vt + r * 72 + 8 * hf; const bf16* v1 = Vt + (32 + r) * 72 + 8 * hf;
    o0 = MFMA32(*(const bf16x8*)(v0), p00, o0); o0 = MFMA32(*(const bf16x8*)(v0 + 16), p01, o0); o0 = MFMA32(*(const bf16x8*)(v0 + 32), p10, o0); o0 = MFMA32(*(const bf16x8*)(v0 + 48), p11, o0);
    o1 = MFMA32(*(const bf16x8*)(v1), p00, o1); o1 = MFMA32(*(const bf16x8*)(v1 + 16), p01, o1); o1 = MFMA32(*(const bf16x8*)(v1 + 32), p10, o1); o1 = MFMA32(*(const bf16x8*)(v1 + 48), p11, o1);
}
#define HY_FENCE8(a_, b_) asm volatile("" : "+v"(a_[0]), "+v"(a_[1]), "+v"(a_[2]), "+v"(a_[3]), "+v"(b_[0]), "+v"(b_[1]), "+v"(b_[2]), "+v"(b_[3]))
__device__ __forceinline__ void ft_kload(const bf16* Kt, int r, int hf, bf16x8 (&f0)[4], bf16x8 (&f1)[4]) {
#pragma unroll
    for (int s = 0; s < 4; ++s) { f0[s] = *(const bf16x8*)(Kt + r * 72 + 16 * s + 8 * hf); f1[s] = *(const bf16x8*)(Kt + (32 + r) * 72 + 16 * s + 8 * hf); }
}
__device__ __forceinline__ void ft_qkm(const bf16x8 (&f0)[4], const bf16x8 (&f1)[4], const bf16x8 (&qf)[4], const f32x16& cneg, f32x16& s0, f32x16& s1) {
    s0 = MFMA32(f0[0], qf[0], cneg); s1 = MFMA32(f1[0], qf[0], cneg);
#pragma unroll
    for (int s = 1; s < 4; ++s) { s0 = MFMA32(f0[s], qf[s], s0); s1 = MFMA32(f1[s], qf[s], s1); }
}
template <bool MASK>
__device__ __forceinline__ void ft_sm_pv(const bf16* Vt, f32x16& s0, f32x16& s1, float& lsum, f32x16& o0, f32x16& o1, int r, int hf, bool allow, int key0, int t, int lo_excl) {
    bf16x8 va[4], vb[4];
    { const bf16* v0 = Vt + r * 72 + 8 * hf; const bf16* v1 = Vt + (32 + r) * 72 + 8 * hf;
#pragma unroll
      for (int s = 0; s < 4; ++s) { va[s] = *(const bf16x8*)(v0 + 16 * s); vb[s] = *(const bf16x8*)(v1 + 16 * s); } }
    __builtin_amdgcn_sched_barrier(0);
    float ps = 0.f;
#pragma unroll
    for (int i = 0; i < 16; ++i) {
        float p0 = __builtin_amdgcn_exp2f(s0[i]), p1 = __builtin_amdgcn_exp2f(s1[i]);
        if (MASK) { const int key = key0 + (i & 3) + 8 * (i >> 2) + 4 * hf; p0 = (key <= t && key > lo_excl) ? p0 : 0.f; p1 = (key + 32 <= t && key + 32 > lo_excl) ? p1 : 0.f; }
        s0[i] = p0; s1[i] = p1; ps += p0 + p1; }
    lsum += allow ? ps : 0.f;
    const unsigned am = allow ? 0xffffffffu : 0u;
    v4u q00 = __builtin_bit_cast(v4u, pack8(s0, 0)), q01 = __builtin_bit_cast(v4u, pack8(s0, 8)), q10 = __builtin_bit_cast(v4u, pack8(s1, 0)), q11 = __builtin_bit_cast(v4u, pack8(s1, 8));
    q00 &= am; q01 &= am; q10 &= am; q11 &= am;
    const bf16x8 p00 = __builtin_bit_cast(bf16x8, q00), p01 = __builtin_bit_cast(bf16x8, q01), p10 = __builtin_bit_cast(bf16x8, q10), p11 = __builtin_bit_cast(bf16x8, q11);
    HY_FENCE8(va, vb);
    o0 = MFMA32(va[0], p00, o0); o0 = MFMA32(va[1], p01, o0); o0 = MFMA32(va[2], p10, o0); o0 = MFMA32(va[3], p11, o0);
    o1 = MFMA32(vb[0], p00, o1); o1 = MFMA32(vb[1], p01, o1); o1 = MFMA32(vb[2], p10, o1); o1 = MFMA32(vb[3], p11, o1);
    __builtin_amdgcn_sched_barrier(0);
}
template <bool M0, bool M1>
__device__ __forceinline__ void flash_pair_fixed(const bf16* K0, const bf16* V0, const bf16* K1, const bf16* V1, const bf16x8 (&qf)[4], float& lsum, f32x16& o0, f32x16& o1, int r, int hf, const f32x16& cneg,
                                                 bool allow0, bool allow1, int key0, int t, int lo_excl) {
    f32x16 a0, a1, b0, b1;
    bf16x8 f0[4], f1[4], g0[4], g1[4];
    ft_kload(K0, r, hf, f0, f1); HY_FENCE8(f0, f1);
    ft_kload(K1, r, hf, g0, g1);
    __builtin_amdgcn_sched_barrier(0);
    ft_qkm(f0, f1, qf, cneg, a0, a1);
    HY_FENCE8(g0, g1);
    ft_qkm(g0, g1, qf, cneg, b0, b1);
    __builtin_amdgcn_sched_barrier(0);
    ft_sm_pv<M0>(V0, a0, a1, lsum, o0, o1, r, hf, allow0, key0, t, lo_excl);
    ft_sm_pv<M1>(V1, b0, b1, lsum, o0, o1, r, hf, allow1, key0 + 64, t, lo_excl);
}
template <int MODE>
__device__ __forceinline__ void nsa2_phase_t(Frame& F, int l) {
    const int lane = F.lane, wave = F.wave, tid = F.tid, r = lane & 31, hf = lane >> 5, hh = r >> 3, tk = r & 7;
    const bf16* PROJ = (const bf16*)(F.ws + WS_R1); bf16* OB = (bf16*)(F.ws + WS_OA) + 256; const unsigned long long* SEL = (const unsigned long long*)(F.ws + WS_SEL);
#define HY_KB2(buf, sub) ((bf16*)(F.lds + (buf) * 18432 + (sub) * 9216))
#define HY_VB2(buf, sub) ((bf16*)(F.lds + 36864 + (buf) * 18432 + (sub) * 9216))
#define HY_KB(buf) ((bf16*)(F.lds + (buf) * 9216))
#define HY_VB(buf) ((bf16*)(F.lds + 18432 + (buf) * 9216))
    const int srow = tid >> 3, sch = tid & 7; const bf16* VT = (const bf16*)(F.ws + WS_VT);
    float Bsel, Bwin;
    { const float gq = wave_max(fabsf(HY_IN(F, 7)[l * 64 + lane])), gks = wave_max(fabsf(HY_IN(F, 8)[(l * 3 + 1) * 64 + lane])), gkw = wave_max(fabsf(HY_IN(F, 8)[(l * 3 + 2) * 64 + lane]));
      Bsel = 11.66f * gq * gks; Bwin = 11.66f * gq * gkw; }
    const bool fixed_ref = (Bsel < 60.f) && (Bwin < 60.f);
    for (int u = F.bid; u < 1024; u += F.G) {
        int bg, tile; nsa_unit(u, bg, tile); const int b = bg >> 1, g = bg & 1, t0 = tile * 64;
        const int t = t0 + 8 * wave + tk; const size_t m = (size_t)b * SEQ + t;
        bf16x8 qf[4];
#pragma unroll
        for (int s = 0; s < 4; ++s) qf[s] = *(const bf16x8*)(PROJ + m * DINP + C_NQ + (4 * g + hh) * 64 + 16 * s + 8 * hf);
        const unsigned long long sm0 = SEL[((size_t)bg * SEQ + t) * 2], sm1 = SEL[((size_t)bg * SEQ + t) * 2 + 1];
        const float g1 = pg8::sigm_f(bf2f(PROJ[m * DINP + C_NG + (4 * g + hh) * 3 + 1])), g2 = pg8::sigm_f(bf2f(PROJ[m * DINP + C_NG + (4 * g + hh) * 3 + 2]));
        float* stash = (float*)(F.lds + 73728 + wave * 8192);
#pragma unroll 1
        for (int ph = 0; ph < 2; ++ph) {
            const int kcol = (ph == 0 ? C_NKS : C_NKW) + 64 * g + 8 * sch; const bf16* vtb = VT + (size_t)((bg * 2 + ph) * 128) * 4096 + srow * 64 + 8 * sch;
            const int jlo = (ph == 0) ? 0 : (tile > 8 ? tile - 8 : 0);
            const int lo_excl = (ph == 0) ? -(1 << 30) : t - 512;
            FlashState st; st.m = -1e30f; st.l = 0.f;
            f32x16 cneg;
#pragma unroll
            for (int i = 0; i < 16; ++i) cneg[i] = -(ph == 0 ? Bsel : Bwin);
            asm volatile("" : "+v"(cneg));
#pragma unroll
            for (int i = 0; i < 16; ++i) { st.o0[i] = 0.f; st.o1[i] = 0.f; }
            uint4 kq0, vq0, kq1, vq1;
#define HY_LOAD1(kq_, vq_, jt_) do { const size_t row_ = (size_t)b * SEQ + (size_t)(jt_) * 64 + srow; kq_ = *(const uint4*)(PROJ + row_ * DINP + kcol); vq_ = *(const uint4*)(vtb + (size_t)(jt_) * 4096); } while (0)
#define HY_LOAD2(jj_) do { HY_LOAD1(kq0, vq0, (jj_)); HY_LOAD1(kq1, vq1, ((jj_) + 1 <= tile ? (jj_) + 1 : tile)); } while (0)
#define HY_STAGE1(buf, sb_, kq_, vq_) do { *(uint4*)(HY_KB2(buf, sb_) + srow * 72 + 8 * sch) = kq_; *(uint4*)(HY_VB2(buf, sb_) + srow * 72 + 8 * sch) = vq_; } while (0)
#define HY_STAGE2(buf) do { HY_STAGE1(buf, 0, kq0, vq0); HY_STAGE1(buf, 1, kq1, vq1); } while (0)
            if (MODE != 2) { HY_LOAD2(jlo); HY_STAGE2(0); }
            __syncthreads();
#pragma unroll 1
            for (int jj = jlo; jj <= tile; jj += 2) {
                const int cb = ((jj - jlo) >> 1) & 1;
                const bool more = jj + 2 <= tile;
                if (more && MODE != 2) HY_LOAD2(jj + 2);
                if (MODE != 1) {   const int j1 = jj + 1; const bool has1 = j1 <= tile;
                    const bool al0 = (ph == 1) ? true : (jj < 64 ? ((sm0 >> jj) & 1ull) != 0ull : ((sm1 >> (jj - 64)) & 1ull) != 0ull);
                    const bool al1 = has1 && ((ph == 1) ? true : (j1 < 64 ? ((sm0 >> j1) & 1ull) != 0ull : ((sm1 >> (j1 - 64)) & 1ull) != 0ull));
                    const bool any0 = __any(al0), any1 = has1 && __any(al1);
                    if (fixed_ref && any0 && any1) {
                        if (ph == 1 && jj == tile - 8) flash_pair_fixed<true, false>(HY_KB2(cb, 0), HY_VB2(cb, 0), HY_KB2(cb, 1), HY_VB2(cb, 1), qf, st.l, st.o0, st.o1, r, hf, cneg, al0, al1, jj * 64, t, lo_excl);
                        else if (j1 == tile) flash_pair_fixed<false, true>(HY_KB2(cb, 0), HY_VB2(cb, 0), HY_KB2(cb, 1), HY_VB2(cb, 1), qf, st.l, st.o0, st.o1, r, hf, cneg, al0, al1, jj * 64, t, lo_excl);
                        else flash_pair_fixed<false, false>(HY_KB2(cb, 0), HY_VB2(cb, 0), HY_KB2(cb, 1), HY_VB2(cb, 1), qf, st.l, st.o0, st.o1, r, hf, cneg, al0, al1, jj * 64, t, lo_excl);
                    } else {
#pragma unroll
                        for (int sb = 0; sb < 2; ++sb) { const int j = jj + sb; const bool allow = sb ? al1 : al0;
                            if (sb ? any1 : any0) {
                                if (fixed_ref) {
                                    if (j == tile || (ph == 1 && j == tile - 8)) flash_tile_fixed<true>(HY_KB2(cb, sb), HY_VB2(cb, sb), qf, st.l, st.o0, st.o1, r, hf, cneg, allow, j * 64, t, lo_excl);
                                    else flash_tile_fixed<false>(HY_KB2(cb, sb), HY_VB2(cb, sb), qf, st.l, st.o0, st.o1, r, hf, cneg, allow, j * 64, t, lo_excl);
                                } else flash_tile(HY_KB2(cb, sb), HY_VB2(cb, sb), qf, st, r, hf, j * 64, t, lo_excl, allow);
                            } } } }
                if (more && MODE != 2) { if (cb == 0) HY_STAGE2(1); else HY_STAGE2(0); }
                __syncthreads();
            }
#undef HY_LOAD1
#undef HY_LOAD2
#undef HY_STAGE1
#undef HY_STAGE2
            float lt = x32_sum(st.l);
            const float sc = (ph == 0 ? g1 : g2) / lt;
            if (ph == 0) {
#pragma unroll
                for (int k = 0; k < 4; ++k) { *(f32x4*)(stash + k * 256 + lane * 4) = (f32x4){st.o0[4 * k] * sc, st.o0[4 * k + 1] * sc, st.o0[4 * k + 2] * sc, st.o0[4 * k + 3] * sc};
                    *(f32x4*)(stash + (4 + k) * 256 + lane * 4) = (f32x4){st.o1[4 * k] * sc, st.o1[4 * k + 1] * sc, st.o1[4 * k + 2] * sc, st.o1[4 * k + 3] * sc}; }
            } else if (MODE != 0) { asm volatile("" :: "v"(st.o0), "v"(st.o1), "v"(st.l));
            } else {
                bf16* op = OB + m * 1024 + (4 * g + hh) * 64;
#pragma unroll
                for (int k = 0; k < 4; ++k) { const f32x4 r0 = *(const f32x4*)(stash + k * 256 + lane * 4), r1 = *(const f32x4*)(stash + (4 + k) * 256 + lane * 4);
                    add4_bf16(op + 8 * k + 4 * hf, r0[0] + st.o0[4 * k] * sc, r0[1] + st.o0[4 * k + 1] * sc, r0[2] + st.o0[4 * k + 2] * sc, r0[3] + st.o0[4 * k + 3] * sc);
                    add4_bf16(op + 32 + 8 * k + 4 * hf, r1[0] + st.o1[4 * k] * sc, r1[1] + st.o1[4 * k + 1] * sc, r1[2] + st.o1[4 * k + 2] * sc, r1[3] + st.o1[4 * k + 3] * sc); }
            }
        }
    }
}
__device__ __forceinline__ void nsa2_phase(Frame& F, int l) { nsa2_phase_t<0>(F, l); }

__device__ __forceinline__ void sb_half(const f32x16& sT, int kb, int t, int hf, int lane_, float& carry, f32x16& wout) {
    const float C = 0.125f * 1.4426950408889634f;
    float sp[16];
#pragma unroll
    for (int i = 0; i < 16; ++i) { const int key = kb + (i & 3) + 8 * (i >> 2) + 4 * hf; const float z2 = sT[i] * C;
        const float s2 = fmaxf(z2, 0.f) + __builtin_amdgcn_logf(1.f + __builtin_amdgcn_exp2f(-fabsf(z2)));
        sp[i] = (key < t) ? s2 : 0.f; wout[i] = z2; }
    float T[4], P[4];
#pragma unroll
    for (int k = 0; k < 4; ++k) { T[k] = (sp[4 * k] + sp[4 * k + 1]) + (sp[4 * k + 2] + sp[4 * k + 3]); P[k] = x32_other(T[k], lane_); }
    float H[4]; float acc = 0.f;
#pragma unroll
    for (int k = 3; k >= 0; --k) { H[k] = acc + (hf ? 0.f : P[k]); acc += T[k] + P[k]; }
#pragma unroll
    for (int k = 0; k < 4; ++k) {
        const float base = carry + H[k];
        const float t3 = base, t2 = t3 + sp[4 * k + 3], t1 = t2 + sp[4 * k + 2], t0_ = t1 + sp[4 * k + 1];
        const float tl[4] = {t0_, t1, t2, t3};
#pragma unroll
        for (int e = 0; e < 4; ++e) { const int i = 4 * k + e; const int key = kb + e + 8 * k + 4 * hf;
            wout[i] = (key < t) ? __builtin_amdgcn_exp2f(wout[i] - sp[i] - tl[e]) : 0.f; }
    }
    carry += acc;
}
__device__ __forceinline__ void sb_phase(Frame& F) {
    const int lane = F.lane, wave = F.wave, tid = F.tid, r = lane & 31, hf = lane >> 5;
    const bf16* PROJ = (const bf16*)(F.ws + WS_R1); bf16* OA = (bf16*)(F.ws + WS_OA);
    unsigned* DONE = (unsigned*)(F.lds + 36864);
    const int skey = lane, sch = wave, spk = (skey & ~12) | (((skey >> 2) & 1) << 3) | (((skey >> 3) & 1) << 2);
    for (int u = F.bid; u < 512; u += F.G) {
        const int i2 = u >> 8, v = u & 255, bh = v >> 4, jq = v & 15, qb = i2 ? 31 - jq : jq, b = bh >> 2, h = bh & 3;
        const int t0 = qb * 256, t = t0 + 32 * wave + r; const size_t m = (size_t)b * SEQ + t;
        bf16x8 qf[4];
#pragma unroll
        for (int s = 0; s < 4; ++s) qf[s] = *(const bf16x8*)(PROJ + m * DINP + C_SBQ + 64 * h + 16 * s + 8 * hf);
        f32x16 o0, o1;
#pragma unroll
        for (int i = 0; i < 16; ++i) { o0[i] = 0.f; o1[i] = 0.f; }
        float carry = 0.f; bool fin = false;
        const int jtop = 4 * qb + 3, jmine = (t0 + 32 * wave + 31) >> 6;
        const int kcol = C_SBK + 64 * h + 8 * sch, vcol = C_SBV + 64 * h + 8 * sch;
        if (tid == 0) *DONE = 0u;
        uint4 kq, vq;
        { const size_t row = (size_t)b * SEQ + (size_t)jtop * 64 + skey; kq = *(const uint4*)(PROJ + row * DINP + kcol); vq = *(const uint4*)(PROJ + row * DINP + vcol); }
#define HY_STAGE(buf) do { *(uint4*)(HY_KB(buf) + skey * 72 + 8 * sch) = kq; bf16* vd_ = HY_VB(buf) + (8 * sch) * 72 + spk; \
        vd_[0] = (bf16)(vq.x & 0xffffu); vd_[72] = (bf16)(vq.x >> 16); vd_[144] = (bf16)(vq.y & 0xffffu); vd_[216] = (bf16)(vq.y >> 16); \
        vd_[288] = (bf16)(vq.z & 0xffffu); vd_[360] = (bf16)(vq.z >> 16); vd_[432] = (bf16)(vq.w & 0xffffu); vd_[504] = (bf16)(vq.w >> 16); } while (0)
        HY_STAGE(0);
        __syncthreads();
#pragma unroll 1
        for (int j = jtop; j >= 0; --j) {
            const int cb = (jtop - j) & 1;
            if (j > 0) { const size_t row = (size_t)b * SEQ + (size_t)(j - 1) * 64 + skey; kq = *(const uint4*)(PROJ + row * DINP + kcol); vq = *(const uint4*)(PROJ + row * DINP + vcol); }
            if (!fin && j <= jmine) {
                const bf16* Kt = HY_KB(cb); const bf16* Vt = HY_VB(cb);
                f32x16 s0, s1;
#pragma unroll
                for (int i = 0; i < 16; ++i) { s0[i] = 0.f; s1[i] = 0.f; }
#pragma unroll
                for (int s = 0; s < 4; ++s) { const bf16x8 a0 = *(const bf16x8*)(Kt + r * 72 + 16 * s + 8 * hf), a1 = *(const bf16x8*)(Kt + (32 + r) * 72 + 16 * s + 8 * hf);
                    s0 = MFMA32(a0, qf[s], s0); s1 = MFMA32(a1, qf[s], s1); }
                f32x16 w0, w1;
                sb_half(s1, 64 * j + 32, t, hf, lane, carry, w1);
                sb_half(s0, 64 * j, t, hf, lane, carry, w0);
                const bf16x8 p00 = pack8(w0, 0), p01 = pack8(w0, 8), p10 = pack8(w1, 0), p11 = pack8(w1, 8);
                const bf16* v0 = Vt + r * 72 + 8 * hf; const bf16* v1 = Vt + (32 + r) * 72 + 8 * hf;
                o0 = MFMA32(*(const bf16x8*)(v0), p00, o0); o0 = MFMA32(*(const bf16x8*)(v0 + 16), p01, o0); o0 = MFMA32(*(const bf16x8*)(v0 + 32), p10, o0); o0 = MFMA32(*(const bf16x8*)(v0 + 48), p11, o0);
                o1 = MFMA32(*(const bf16x8*)(v1), p00, o1); o1 = MFMA32(*(const bf16x8*)(v1 + 16), p01, o1); o1 = MFMA32(*(const bf16x8*)(v1 + 32), p10, o1); o1 = MFMA32(*(const bf16x8*)(v1 + 48), p11, o1);
                if (__all(carry > 127.f)) { fin = true; if (lane == 0) atomicAdd(DONE, 1u); }
            }
            if (j > 0) { if (cb == 0) HY_STAGE(1); else HY_STAGE(0); }
            __syncthreads();
            const unsigned nd = *DONE;
            __syncthreads();
            if (nd == 8u) break;
        }
#undef HY_STAGE
        bf16* op = OA + m * 1024 + 64 * h;
#pragma unroll
        for (int k = 0; k < 4; ++k) { st4_bf16(op + 8 * k + 4 * hf, o0[4 * k], o0[4 * k + 1], o0[4 * k + 2], o0[4 * k + 3]); st4_bf16(op + 32 + 8 * k + 4 * hf, o1[4 * k], o1[4 * k + 1], o1[4 * k + 2], o1[4 * k + 3]); }
        __syncthreads();
    }
}

__device__ __forceinline__ int wave_isum(int v) {
    v += dppi<DPP_X1>(v); v += dppi<DPP_X2>(v); v += dppi<DPP_ROR4>(v); v += dppi<DPP_ROR8>(v);
    { auto r = __builtin_amdgcn_permlane16_swap((unsigned)v, (unsigned)v, false, false); v = (int)(r[0] + r[1]); }
    { auto r = __builtin_amdgcn_permlane32_swap((unsigned)v, (unsigned)v, false, false); v = (int)(r[0] + r[1]); }
    return v;
}
__device__ __forceinline__ int wave_scan_incl(int v, int lane, int& total) {
    int p = v, t = v, x;
    x = dppi<DPP_X1>(t); p += (lane & 1) ? x : 0; t += x;
    x = dppi<DPP_X2>(t); p += (lane & 2) ? x : 0; t += x;
    x = dppi<0x141>(t); p += (lane & 4) ? x : 0; t += x;
    x = dppi<DPP_ROR8>(t); p += (lane & 8) ? x : 0; t += x;
    { auto r = __builtin_amdgcn_permlane16_swap((unsigned)t, (unsigned)t, false, false); x = (int)((lane & 16) ? r[0] : r[1]); } p += (lane & 16) ? x : 0; t += x;
    { auto r = __builtin_amdgcn_permlane32_swap((unsigned)t, (unsigned)t, false, false); x = (int)((lane & 32) ? r[0] : r[1]); } p += (lane & 32) ? x : 0; t += x;
    total = t; return p;
}
__device__ __forceinline__ float unkey(unsigned k) { return __uint_as_float((k & 0x80000000u) ? (k & 0x7fffffffu) : ~k); }
typedef float v2f __attribute__((ext_vector_type(2)));
__device__ __forceinline__ v2f relu_wsum(const f32x4& c0, const f32x4& c1, v2f s2, v2f w01, v2f w23, v2f w45, v2f w67) {
    const v2f a = {c0[0], c0[1]}, b = {c0[2], c0[3]}, c = {c1[0], c1[1]}, d = {c1[2], c1[3]};
    v2f t0, t1, t2, t3;
    asm("s_nop 7\n\ts_nop 3\n\t"
        "v_pk_mul_f32 %0, %4, %8 clamp\n\t"
        "v_pk_mul_f32 %1, %5, %8 clamp\n\t"
        "v_pk_mul_f32 %2, %6, %8 clamp\n\t"
        "v_pk_mul_f32 %3, %7, %8 clamp\n\t"
        "v_pk_mul_f32 %0, %0, %9\n\t"
        "v_pk_mul_f32 %1, %1, %10\n\t"
        "v_pk_fma_f32 %0, %2, %11, %0\n\t"
        "v_pk_fma_f32 %1, %3, %12, %1\n\t"
        "s_nop 0\n\t"
        "v_pk_add_f32 %0, %0, %1\n\t"
        "s_nop 0"
        : "=&v"(t0), "=&v"(t1), "=&v"(t2), "=&v"(t3) : "v"(a), "v"(b), "v"(c), "v"(d), "v"(s2), "v"(w01), "v"(w23), "v"(w45), "v"(w67));
    return t0;
}
__device__ __forceinline__ void dsa1_phase(Frame& F, int l) {
    const int lane = F.lane, wave = F.wave, tid = F.tid, col = lane & 15, q4 = lane >> 4, tk = col >> 2, hd = col & 3;
    const bf16* PROJ = (const bf16*)(F.ws + WS_R1); unsigned short* IDX = (unsigned short*)(F.ws + WS_IDX);
    float* SCF = (float*)F.lds;
    unsigned* HIST = (unsigned*)(F.lds + RING_BYTES);
    uint2* CAND = (uint2*)(F.lds + RING_BYTES + 8192);
    unsigned* CT = (unsigned*)(F.lds + RING_BYTES + 12288);
#ifdef HY_PROBE
    GAS unsigned long long* TSA = (GAS unsigned long long*)((GAS unsigned char*)F.ws + WS_CTL + 65536); unsigned long long tprev = __builtin_amdgcn_s_memrealtime();
    unsigned long long dacc0 = 0, dacc1 = 0, dacc2 = 0, dacc3 = 0, dacc4 = 0, dacc5 = 0;
#define DSTAMP(id) do { const unsigned long long tn_ = __builtin_amdgcn_s_memrealtime(); const unsigned long long dd_ = tn_ - tprev; tprev = tn_; \
        if ((id) == 110) dacc0 += dd_; else if ((id) == 111) dacc1 += dd_; else if ((id) == 112) dacc2 += dd_; else if ((id) == 113) dacc3 += dd_; else if ((id) == 114) dacc4 += dd_; else dacc5 += dd_; } while (0)
#else
#define DSTAMP(id) do { } while (0)
#endif
    const int nrounds = (8192 + F.G - 1) / F.G;
    for (int rd = 0; rd < nrounds; ++rd) {
        const int unit = rd * F.G + ((rd & 1) ? (F.G - 1 - F.bid) : F.bid);
        if (unit >= 8192) break;
        const int b = unit & 3, t0 = (unit >> 2) * 4; const size_t m0 = (size_t)b * SEQ + t0;
        const int nkt = ((t0 + 3) >> 4) + 1;
        bf16x8 bq[2]; float wq[8];
#pragma unroll
        for (int hg = 0; hg < 2; ++hg) bq[hg] = *(const bf16x8*)(PROJ + (m0 + tk) * DINP + C_IQ + 32 * (4 * hg + hd) + 8 * q4);
        { const uint4 w8 = *(const uint4*)(PROJ + (m0 + q4) * DINP + C_IW);
          wq[0] = bflo(w8.x) * 0.0625f; wq[1] = bfhi(w8.x) * 0.0625f; wq[2] = bflo(w8.y) * 0.0625f; wq[3] = bfhi(w8.y) * 0.0625f; wq[4] = bflo(w8.z) * 0.0625f; wq[5] = bfhi(w8.z) * 0.0625f; wq[6] = bflo(w8.w) * 0.0625f; wq[7] = bfhi(w8.w) * 0.0625f; }
#pragma unroll
        for (int i = 0; i < 4; ++i) HIST[tid + 512 * i] = 0u;
        if (tid < 64) CT[tid] = ((tid & 15) == 0) ? 0xffffffffu : 0u;
        float m1 = -INFINITY, m2 = -INFINITY;
        v2f s2, w01, w23, w45, w67;
        { unsigned qm = 0u;
#pragma unroll
          for (int hg = 0; hg < 2; ++hg) { const v4u qq = __builtin_bit_cast(v4u, bq[hg]);
#pragma unroll
              for (int j = 0; j < 4; ++j) { qm = max(qm, qq[j] & 0x7fff0000u); qm = max(qm, (qq[j] << 16) & 0x7fff0000u); } }
          const float qmax = wave_max(__uint_as_float(qm)), kmax = __uint_as_float(((const unsigned*)(F.ws + WS_CTL))[CW_KMAX + l]);
          const unsigned eb = __float_as_uint(96.f * qmax * kmax) >> 23; const bool tiny = eb < 27u;
          const float sc_s = tiny ? 1.f : __uint_as_float((253u - eb) << 23), sc_inv = tiny ? 1.f : __uint_as_float((eb + 1u) << 23);
          s2 = (v2f){sc_s, sc_s}; w01 = (v2f){wq[0] * sc_inv, wq[1] * sc_inv}; w23 = (v2f){wq[2] * sc_inv, wq[3] * sc_inv}; w45 = (v2f){wq[4] * sc_inv, wq[5] * sc_inv}; w67 = (v2f){wq[6] * sc_inv, wq[7] * sc_inv}; }
        float pinf = INFINITY; asm volatile("" : "+v"(pinf));
        {
            const bf16* ikb = (const bf16*)(F.ws + WS_IKC) + ((size_t)b * SEQ + col) * 32 + 8 * q4;
            bf16x8 an[8];
#pragma unroll
            for (int u = 0; u < 8; ++u) { const int kt = wave + 8 * u; if (kt < nkt) an[u] = *(const bf16x8*)(ikb + (size_t)kt * 512); else an[u] = (bf16x8){0, 0, 0, 0, 0, 0, 0, 0}; }
#ifdef HY_PROBE_STARTUP
            asm volatile("s_waitcnt vmcnt(0)" ::: "memory"); DSTAMP(115);
#endif
#pragma unroll 1
            for (int kt0 = wave; kt0 < nkt; kt0 += 64) {
                bf16x8 ac[8];
#pragma unroll
                for (int u = 0; u < 8; ++u) { ac[u] = an[u]; const int kt = kt0 + 64 + 8 * u; if (kt < nkt) an[u] = *(const bf16x8*)(ikb + (size_t)kt * 512); }
#pragma unroll
                for (int u = 0; u < 8; ++u) { const int kt = kt0 + 8 * u;
                    if (kt < nkt) {
                        const f32x4 z = (f32x4){0.f, 0.f, 0.f, 0.f};
                        const f32x4 c0 = MFMA16(bq[0], ac[u], z), c1 = MFMA16(bq[1], ac[u], z);
                        const v2f ps2 = relu_wsum(c0, c1, s2, w01, w23, w45, w67);
                        const float mine = ps2.x + ps2.y;
                        const int key = 16 * kt + col;
                        if (key <= t0 + q4) { SCF[q4 * 8192 + key] = mine; m2 = __builtin_amdgcn_fmed3f(m1, m2, mine); m1 = __builtin_amdgcn_fmed3f(m1, mine, pinf); }
                    } }
            }
        }
        DSTAMP(110);
        m2 = fminf(m2, dppf<DPP_X1>(m2)); m2 = fminf(m2, dppf<DPP_X2>(m2)); m2 = fminf(m2, dppf<DPP_ROR4>(m2)); m2 = fminf(m2, dppf<DPP_ROR8>(m2));
        m1 = fmaxf(m1, dppf<DPP_X1>(m1)); m1 = fmaxf(m1, dppf<DPP_X2>(m1)); m1 = fmaxf(m1, dppf<DPP_ROR4>(m1)); m1 = fmaxf(m1, dppf<DPP_ROR8>(m1));
        __syncthreads();
        if (col == 0 && m1 > -INFINITY) { atomicMin(&CT[q4 * 16 + 0], fkey(m2)); atomicMax(&CT[q4 * 16 + 1], fkey(m1)); }
        __syncthreads();
        const int row = wave >> 1, hfw = wave & 1, nrow = t0 + row + 1;
        const bool all_in = nrow <= 256;
        const float lo = all_in ? -INFINITY : unkey(CT[row * 16 + 0]), hi = unkey(CT[row * 16 + 1]);
        const float scale = (hi > lo && !all_in) ? 1023.5f / (hi - lo) : 0.f;
        const float* srow = SCF + row * 8192 + 256 * hfw + 4 * lane;
#define HY_EKEY(e_) (512 * ((e_) >> 2) + ((e_) & 3))
        unsigned long long cm;
        {   unsigned mlo = 0u, mhi = 0u;
#pragma unroll
            for (int i = 15; i >= 0; --i) { const f32x4 q = *(const f32x4*)(srow + 512 * i);
#pragma unroll
                for (int j = 3; j >= 0; --j) {
                    if (i >= 8) asm("v_cmp_ge_f32 vcc, %1, %2\n\tv_addc_co_u32 %0, vcc, %0, %0, vcc" : "+v"(mhi) : "v"(q[j]), "v"(lo) : "vcc");
                    else asm("v_cmp_ge_f32 vcc, %1, %2\n\tv_addc_co_u32 %0, vcc, %0, %0, vcc" : "+v"(mlo) : "v"(q[j]), "v"(lo) : "vcc"); } }
            const int d = nrow - 256 * hfw - 4 * lane;
            int nv = 0; if (d > 0) { const int r = d & 511; nv = 4 * (d >> 9) + (r < 4 ? r : 4); }
            const unsigned long long vm = nv >= 64 ? ~0ull : ((1ull << nv) - 1ull);
            cm = (((unsigned long long)mhi << 32) | mlo) & vm; }
        int ce[8], cbn[8]; unsigned long long rest;
        {   unsigned long long w = cm; float cv[8];
#pragma unroll
            for (int k = 0; k < 8; ++k) { const bool has = w != 0ull; const int e = has ? (int)__builtin_ctzll(w) : 0; w &= w - 1ull; ce[k] = has ? e : -1; cv[k] = srow[HY_EKEY(e)]; }
            rest = w;
#pragma unroll
            for (int k = 0; k < 8; ++k) { const unsigned b = (unsigned)(int)fminf((cv[k] - lo) * scale, 1023.f); cbn[k] = (ce[k] >= 0) ? (int)b : -2;
                if (ce[k] >= 0 && !all_in) atomicAdd(&HIST[row * 512 + (b >> 1)], (b & 1u) ? 0x10000u : 1u); } }
        if (!all_in) { unsigned long long w = rest;
            while (w) { const int e0 = (int)__builtin_ctzll(w); w &= w - 1ull; const bool two = w != 0ull; const int e1 = two ? (int)__builtin_ctzll(w) : e0; w &= w - 1ull;
                const float s0 = srow[HY_EKEY(e0)], s1 = srow[HY_EKEY(e1)];
                const unsigned b0 = (unsigned)(int)fminf((s0 - lo) * scale, 1023.f), b1 = (unsigned)(int)fminf((s1 - lo) * scale, 1023.f);
                atomicAdd(&HIST[row * 512 + (b0 >> 1)], (b0 & 1u) ? 0x10000u : 1u);
                if (two) atomicAdd(&HIST[row * 512 + (b1 >> 1)], (b1 & 1u) ? 0x10000u : 1u); } }
        __syncthreads();
        DSTAMP(111);
        int bstar = -1, cabove = nrow;
        if (!all_in) {
            unsigned cnt[16]; unsigned tot = 0u;
#pragma unroll
            for (int j = 0; j < 8; ++j) { const unsigned w = HIST[row * 512 + 8 * lane + j]; cnt[2 * j] = w & 0xffffu; cnt[2 * j + 1] = w >> 16; tot += (w & 0xffffu) + (w >> 16); }
            int wtot; const int pin = wave_scan_incl((int)tot, lane, wtot);
            const unsigned above = (unsigned)(wtot - pin), incl = above + tot;
            int bs = -1, ca = 0;
            if (above < 256u && incl >= 256u) { unsigned ab = above;
#pragma unroll
                for (int j = 15; j >= 0; --j) { if (ab < 256u && ab + cnt[j] >= 256u) { bs = 16 * lane + j; ca = (int)ab; } ab += cnt[j]; } }
            const unsigned long long who = __ballot(bs >= 0); const int src = (int)__builtin_ctzll(who);
            bstar = __builtin_amdgcn_readlane(bs, src); cabove = __builtin_amdgcn_readlane(ca, src);
        }
        DSTAMP(112);
        unsigned short* outp = IDX + (m0 + row) * 256;
        {   unsigned long long upm = 0ull, eqm = 0ull;
            if (all_in) upm = cm;
            else {
#pragma unroll
              for (int k = 0; k < 8; ++k) { const unsigned long long bit = (ce[k] >= 0) ? (1ull << (ce[k] & 63)) : 0ull; upm |= (cbn[k] > bstar) ? bit : 0ull; eqm |= (cbn[k] == bstar) ? bit : 0ull; }
              cm = rest;
              while (cm) { const int i0 = (int)__builtin_ctzll(cm); const unsigned long long bit0 = cm & (0ull - cm); cm ^= bit0;
                const bool two = cm != 0ull; const int i1 = two ? (int)__builtin_ctzll(cm) : i0; const unsigned long long bit1 = cm & (0ull - cm); cm ^= bit1;
                const float s0 = srow[HY_EKEY(i0)], s1 = srow[HY_EKEY(i1)];
                const int b0 = (int)fminf((s0 - lo) * scale, 1023.f), b1 = (int)fminf((s1 - lo) * scale, 1023.f);
                upm |= (b0 > bstar ? bit0 : 0ull) | (b1 > bstar ? bit1 : 0ull); eqm |= (b0 == bstar ? bit0 : 0ull) | (b1 == bstar ? bit1 : 0ull); } }
            const int cu = __popcll(upm), cq = __popcll(eqm);
            int wt; const int pin = wave_scan_incl(cu | (cq << 16), lane, wt);
            int pu = (pin & 0xffff) - cu, pq = (pin >> 16) - cq;
            const int totq = wt >> 16;
            if (lane == 0) CT[row * 16 + 8 + hfw] = (unsigned)totq;
            while (upm) { const int i = (int)__builtin_ctzll(upm); upm &= upm - 1ull; outp[hfw ? cabove - 1 - pu : pu] = (unsigned short)(HY_EKEY(i) + 256 * hfw + 4 * lane); ++pu; }
            while (eqm) { const int i = (int)__builtin_ctzll(eqm); eqm &= eqm - 1ull;
                if (pq < 128) CAND[row * 128 + (hfw ? 127 - pq : pq)] = make_uint2(fkey(srow[HY_EKEY(i)] + 0.f), (unsigned)(HY_EKEY(i) + 256 * hfw + 4 * lane)); ++pq; }
        }
        __syncthreads();
        DSTAMP(113);
        if (hfw == 0 && !all_in) {
            const int c0 = (int)CT[row * 16 + 8], c1 = (int)CT[row * 16 + 9], c = c0 + c1, need = 256 - cabove;
            if (c <= 128) {
#define HY_CSLOT(j) ((j) < c0 ? (j) : 128 - c + (j))
                const uint2 m0c = (lane < c) ? CAND[row * 128 + HY_CSLOT(lane)] : make_uint2(0u, 0u), m1c = (lane + 64 < c) ? CAND[row * 128 + HY_CSLOT(lane + 64)] : make_uint2(0u, 0u);
                int r0 = 0, r1 = 0;
                for (int j = 0; j < c; ++j) { const uint2 o = CAND[row * 128 + HY_CSLOT(j)];
                    r0 += (o.x > m0c.x || (o.x == m0c.x && o.y < m0c.y)) ? 1 : 0; r1 += (o.x > m1c.x || (o.x == m1c.x && o.y < m1c.y)) ? 1 : 0; }
                if (lane < c && r0 < need) outp[cabove + r0] = (unsigned short)m0c.y;
                if (lane + 64 < c && r1 < need) outp[cabove + r1] = (unsigned short)m1c.y;
            } else {
                const float* sr = SCF + row * 8192 + lane; const int nit = (nrow + 63) >> 6;
                unsigned prefix = 0u;
                for (int bit = 31; bit >= 0; --bit) { const unsigned cand = prefix | (1u << bit); int cl = 0;
                    for (int i = 0; i < nit; ++i) { const int e = 64 * i + lane; if (e < nrow) { const float sv = sr[64 * i] + 0.f; const int bb = sv >= lo ? (int)fminf((sv - lo) * scale, 1023.f) : -1; cl += (bb == bstar && fkey(sv) >= cand) ? 1 : 0; } }
                    if (wave_isum(cl) >= need) prefix = cand; }
                const unsigned tau = prefix; int cg = 0;
                for (int i = 0; i < nit; ++i) { const int e = 64 * i + lane; if (e < nrow) { const float sv = sr[64 * i] + 0.f; const int bb = sv >= lo ? (int)fminf((sv - lo) * scale, 1023.f) : -1; cg += (bb == bstar && fkey(sv) > tau) ? 1 : 0; } }
                cg = wave_isum(cg);
                int pos = cabove, ties_left = need - cg;
                for (int i = 0; i < nit; ++i) { const int e = 64 * i + lane; bool gt = false, eq = false;
                    if (e < nrow) { const float sv = sr[64 * i] + 0.f; const int bb = sv >= lo ? (int)fminf((sv - lo) * scale, 1023.f) : -1; const unsigned k = fkey(sv); gt = (bb == bstar) && k > tau; eq = (bb == bstar) && k == tau; }
                    const unsigned long long mg = __ballot(gt), me = __ballot(eq);
                    const int pg = (int)__builtin_amdgcn_mbcnt_hi((unsigned)(mg >> 32), __builtin_amdgcn_mbcnt_lo((unsigned)mg, 0u));
                    const int pe = (int)__builtin_amdgcn_mbcnt_hi((unsigned)(me >> 32), __builtin_amdgcn_mbcnt_lo((unsigned)me, 0u));
                    const int ng = __popcll(mg); int ne = __popcll(me); if (ne > ties_left) ne = ties_left;
                    if (gt) outp[pos + pg] = (unsigned short)e;
                    if (eq && pe < ties_left) outp[pos + ng + pe] = (unsigned short)e;
                    pos += ng + ne; ties_left -= ne; }
            }
        }
        __syncthreads();
        DSTAMP(114);
    }
#ifdef HY_PROBE
    if (F.bid == 0 && tid == 0) { TSA[110] += dacc0; TSA[111] += dacc1; TSA[112] += dacc2; TSA[113] += dacc3; TSA[114] += dacc4; TSA[115] += dacc5; }
#endif
}
__device__ __forceinline__ void dsa2_phase(Frame& F) {
    const int gw = F.bid * NWAVES + F.wave, NGW = F.G * NWAVES, lane = F.lane, col = lane & 15, q4 = lane >> 4;
    const bf16* PROJ = (const bf16*)(F.ws + WS_R1); const unsigned short* IDX = (const unsigned short*)(F.ws + WS_IDX); bf16* OC = (bf16*)(F.ws + WS_OA) + 768;
    unsigned char* wb = F.lds + F.wave * 16896;
    bf16* Vl = (bf16*)wb; unsigned short* Is = (unsigned short*)(wb + 16384);
    typedef short v4i16_t __attribute__((ext_vector_type(4)));
    for (int m = gw; m < M; m += NGW) {
        const int t = m & (SEQ - 1), b = m >> 13; const int cnt = (t + 1 < 256) ? t + 1 : 256;
        { uint2 iv = make_uint2(0u, 0u); if (4 * lane < cnt) iv = *(const uint2*)(IDX + (size_t)m * 256 + 4 * lane);
          if (4 * lane + 1 >= cnt) iv.x &= 0xffffu; if (4 * lane + 2 >= cnt) iv.y = 0u; else if (4 * lane + 3 >= cnt) iv.y &= 0xffffu;
          *(uint2*)(Is + 4 * lane) = iv; }
        bf16x8 qb[2];
#pragma unroll
        for (int s = 0; s < 2; ++s) qb[s] = *(const bf16x8*)(PROJ + (size_t)m * DINP + C_DQ + 64 * (col & 3) + 32 * s + 8 * q4);
        LDS_WAIT(); asm volatile("" ::: "memory");
        const bf16* kbase = PROJ + (size_t)b * SEQ * DINP + C_DK + 8 * q4;
        const bf16* vsrc = PROJ + (size_t)b * SEQ * DINP + C_DV + 8 * (lane & 7);
#pragma unroll
        for (int i = 0; i < 16; ++i) { const int idx = Is[8 * i + (lane >> 3)];
            __builtin_amdgcn_global_load_lds((const unsigned*)(vsrc + (size_t)idx * DINP), (LAS unsigned*)(LAS unsigned char*)(wb + i * 1024), 16, 0, 0); }
        f32x4 sc[16];
        {   bf16x8 kn[4][2];
#pragma unroll
            for (int j = 0; j < 4; ++j) { const int idx = Is[16 * j + col]; const bf16* kr = kbase + (size_t)idx * DINP; kn[j][0] = *(const bf16x8*)(kr); kn[j][1] = *(const bf16x8*)(kr + 32); }
#pragma unroll
            for (int g = 0; g < 4; ++g) {
                bf16x8 kc[4][2];
#pragma unroll
                for (int j = 0; j < 4; ++j) { kc[j][0] = kn[j][0]; kc[j][1] = kn[j][1]; }
                if (g < 3) {
#pragma unroll
                    for (int j = 0; j < 4; ++j) { const int idx = Is[16 * (4 * (g + 1) + j) + col]; const bf16* kr = kbase + (size_t)idx * DINP; kn[j][0] = *(const bf16x8*)(kr); kn[j][1] = *(const bf16x8*)(kr + 32); }
                }
#pragma unroll
                for (int j = 0; j < 4; ++j) { f32x4 a = (f32x4){0.f, 0.f, 0.f, 0.f}; a = MFMA16(kc[j][0], qb[0], a); a = MFMA16(kc[j][1], qb[1], a); sc[4 * g + j] = a; }
            }
        }
        float mx = -1e30f;
#pragma unroll
        for (int j = 0; j < 16; ++j)
#pragma unroll
            for (int e = 0; e < 4; ++e) { const bool valid = (16 * j + 4 * q4 + e) < cnt; sc[j][e] = valid ? sc[j][e] : -1e30f; mx = fmaxf(mx, sc[j][e]); }
        mx = x32_max(x16_max(mx));
        float sum = 0.f;
#pragma unroll
        for (int j = 0; j < 16; ++j)
#pragma unroll
            for (int e = 0; e < 4; ++e) { const float p = (sc[j][e] > -1e29f) ? __builtin_amdgcn_exp2f(sc[j][e] - mx) : 0.f; sc[j][e] = p; sum += p; }
        sum = x32_sum(x16_sum(sum));
        const float inv = 1.f / sum;
        f32x4 o[4];
#pragma unroll
        for (int dt = 0; dt < 4; ++dt) o[dt] = (f32x4){0.f, 0.f, 0.f, 0.f};
        const int trq = (lane & 15) >> 2, trp = lane & 3;
#pragma unroll
        for (int half = 0; half < 2; ++half) {
            asm volatile("s_waitcnt vmcnt(0)" ::: "memory");
            if (half == 1) { }
#pragma unroll
            for (int Jl = 0; Jl < 4; ++Jl) { const int J = 4 * half + Jl;
                v4u pw; pw.x = pg8::cvtpk_s(sc[2 * J][0], sc[2 * J][1]); pw.y = pg8::cvtpk_s(sc[2 * J][2], sc[2 * J][3]); pw.z = pg8::cvtpk_s(sc[2 * J + 1][0], sc[2 * J + 1][1]); pw.w = pg8::cvtpk_s(sc[2 * J + 1][2], sc[2 * J + 1][3]);
                const bf16x8 pf = __builtin_bit_cast(bf16x8, pw);
                const bf16* r0 = Vl + (32 * Jl + 4 * q4 + trq) * 64 + 4 * trp;
#pragma unroll
                for (int dt = 0; dt < 4; ++dt) {
                    const v4i16_t lo4 = __builtin_amdgcn_ds_read_tr16_b64_v4i16((LAS v4i16_t*)(LAS unsigned char*)(r0 + 16 * dt));
                    const v4i16_t hi4 = __builtin_amdgcn_ds_read_tr16_b64_v4i16((LAS v4i16_t*)(LAS unsigned char*)(r0 + 16 * 64 + 16 * dt));
                    const bf16x8 va = (bf16x8){lo4[0], lo4[1], lo4[2], lo4[3], hi4[0], hi4[1], hi4[2], hi4[3]};
                    o[dt] = MFMA16(va, pf, o[dt]); }
            }
            if (half == 0) {
                LDS_WAIT(); asm volatile("" ::: "memory");
#pragma unroll
                for (int i = 0; i < 16; ++i) { const int idx = Is[128 + 8 * i + (lane >> 3)];
                    __builtin_amdgcn_global_load_lds((const unsigned*)(vsrc + (size_t)idx * DINP), (LAS unsigned*)(LAS unsigned char*)(wb + i * 1024), 16, 0, 0); }
            }
        }
        if (col < 4) {
#pragma unroll
            for (int dt = 0; dt < 4; ++dt) { typedef unsigned u32x2_ __attribute__((ext_vector_type(2))); u32x2_ w; w.x = pg8::cvtpk_s(o[dt][0] * inv, o[dt][1] * inv); w.y = pg8::cvtpk_s(o[dt][2] * inv, o[dt][3] * inv);
                *(u32x2_*)(OC + (size_t)m * 1024 + 64 * col + 16 * dt + 4 * q4) = w; }
        }
        LDS_WAIT(); asm volatile("" ::: "memory");
    }
}


#ifndef HY_FLAGS
#define HY_FLAGS 7
#endif
#ifndef HY_N_LAUNCHES
#define HY_N_LAUNCHES 1
#endif
constexpr int NPL = 12, NPHASES = 1 + DEPTH * NPL;
struct Args { const float* in[21]; float* out; unsigned char* ws; int ph_lo, ph_hi, flags, use_bar; };
__device__ __forceinline__ void zero_rows_bf16(Frame& F, bf16* p, size_t nelem) {
    v4u* z = (v4u*)p; const size_t n16 = nelem * 2 / 16;
    for (size_t i = (size_t)F.bid * NTHREADS + F.tid; i < n16; i += (size_t)F.G * NTHREADS) z[i] = (v4u){0u, 0u, 0u, 0u};
}
__global__ void __launch_bounds__(NTHREADS, 2) hy_fwd(Args args) {
    extern __shared__ __attribute__((aligned(16))) unsigned char lds[];
    LAS unsigned char* lds3 = (LAS unsigned char*)lds;
    volatile LAS unsigned* MISC = (volatile LAS unsigned*)(lds3 + MISC_OFF);
    const int wave_s = __builtin_amdgcn_readfirstlane((int)threadIdx.x >> 6);
    if (threadIdx.x < 64) MISC[threadIdx.x] = 0u;
    __syncthreads();
    if (args.use_bar) (void)xcd_barrier_post((unsigned*)(args.ws + WS_CTL) + CW_BAR, MISC + 8);
    const int lo = args.ph_lo, hi = args.ph_hi, flags = args.flags;
#define IN(k) (lo <= (k) && (k) < hi)
#define SEAM(k) do { if (IN(k) && IN((k) + 1)) { GAS unsigned char* w_ = (GAS unsigned char*)args.ws; asm volatile("" : "+s"(w_)); XcdBarrier b_; b_.bar = (unsigned*)(w_ + WS_CTL) + CW_BAR; b_.x = xb_xcc_id(); b_.st = MISC + 8; xcd_barrier(b_); } } while (0)
#define PH_BEGIN(k) if (IN(k)) { asm volatile("; HYPH_BEGIN %0" :: "i"(__LINE__)); Frame F = fr_fresh(lds, wave_s); bf16* XN = (bf16*)(F.ws + WS_XN); bf16* R1 = (bf16*)(F.ws + WS_R1); \
        bf16* OA = (bf16*)(F.ws + WS_OA); bf16* OB = OA + 256; bf16* OC = OA + 768; bf16* MG = (bf16*)(F.ws + WS_MG); unsigned long long* SS = (unsigned long long*)(F.ws + WS_SS); (void)XN; (void)R1; (void)OA; (void)OB; (void)OC; (void)MG; (void)SS;
#ifdef HY_PROBE
#define STAMP(id) do { if (blockIdx.x == 0 && threadIdx.x == 0) ((GAS unsigned long long*)((GAS unsigned char*)args.ws + WS_CTL + 65536))[id] = __builtin_amdgcn_s_memrealtime(); } while (0)
#else
#define STAMP(id) do { } while (0)
#endif
#define PH_END(k) asm volatile("; HYPH_END %0" :: "i"(__LINE__)); } SEAM(k); STAMP((k) + 1);

#ifdef HY_DUMP_PHASE
    if (lo == 999) {
        Frame F = fr_fresh(lds, wave_s); const bf16* src = (const bf16*)(F.ws + HY_DUMP_OFF); float* dst = (float*)F.out;
        for (size_t i = (size_t)F.bid * NTHREADS + F.tid; i < (size_t)M * DM; i += (size_t)F.G * NTHREADS) { const size_t m = i >> 10, c = i & 1023; dst[i] = (c < HY_DUMP_COLS && m < HY_DUMP_ROWS) ? bf2f(src[m * HY_DUMP_LD + c]) + bf2f(src[m * HY_DUMP_LD + c + HY_DUMP_C2]) + bf2f(src[m * HY_DUMP_LD + c + HY_DUMP_C3]) : 0.f; }
        return;
    }
#endif
    STAMP(0);
    PH_BEGIN(0) p0_prologue(F); PH_END(0)
    {
        constexpr int l = 0;
        const int pb = 1 + NPL * l;
        PH_BEGIN(pb + 0) { pg8::Gemm g{XN, wl_ptr(F, l, W_GU1), M, NGU, DM}; pg8::StaticOrder S; S.init(M, NGU, F.G, F.bid); pg8::EpiSwiGLU E{R1, FF, SS + (size_t)(3 * l + 0) * M};
            pg8::gemm_phase<pg8::EpiSwiGLU, pg8::StaticOrder, true, true>(lds3, g, S, E, F.tid);
#if defined(HY_XGEMM) && HY_XGEMM == 1
            { __syncthreads(); HY_XORDER S2; S2.init(M, NGU, F.G, F.bid); pg8::EpiNull EN; pg8::Gemm g2 = g; g2.ld = HY_XLD; pg8::gemm_phase<pg8::EpiNull, HY_XORDER, true, true>(lds3, g2, S2, EN, F.tid); }
#endif
            } PH_END(pb + 0)
        PH_BEGIN(pb + 1) { pg8::Gemm g{R1, wl_ptr(F, l, W_DN1), M, DM, FF}; pg8::StaticOrder S; S.init(M, DM, F.G, F.bid); pg8::EpiResid<true, false, (l == 0)> E{HY_IN(F, 0), ((float*)F.out), XN, SS + (size_t)(3 * l + 1) * M, DM, 0.5f};
            pg8::gemm_phase<pg8::EpiResid<true, false, (l == 0)>, pg8::StaticOrder, true, true>(lds3, g, S, E, F.tid);
#if defined(HY_XGEMM) && HY_XGEMM == 2
            { __syncthreads(); pg8::StaticOrder S2; S2.init(M, DM, F.G, F.bid); pg8::EpiNull EN; pg8::gemm_phase<pg8::EpiNull, pg8::StaticOrder, true, true>(lds3, g, S2, EN, F.tid); }
#endif
            } PH_END(pb + 1)
        if (flags != 0) {
        PH_BEGIN(pb + 2) { pg8::Gemm g{XN, wl_ptr(F, l, W_IN), M, DINP, DM}; pg8::StaticOrder S; S.init(M, DINP, F.G, F.bid); pg8::EpiScaled E{R1, DINP, SS + (size_t)(3 * l + 1) * M};
            pg8::gemm_phase<pg8::EpiScaled, pg8::StaticOrder, true, true>(lds3, g, S, E, F.tid); } PH_END(pb + 2)
        PH_BEGIN(pb + 3) { prep_phase(F, l); vt_build(F); } PH_END(pb + 3)
        PH_BEGIN(pb + 4) {
            if (flags & 2) cmp_phase(F, l);
            __syncthreads(); if (l == 0) STAMP(100);
            if (flags & 1) sb_phase(F);
            __syncthreads(); if (l == 0) STAMP(101);
            if (flags & 4) dsa1_phase(F, l);
        } PH_END(pb + 4)
        PH_BEGIN(pb + 5) {
            if (flags & 2) nsa1_phase(F, l);
            __syncthreads(); if (l == 0) STAMP(102);
            if (flags & 4) dsa2_phase(F);
        } PH_END(pb + 5)
        PH_BEGIN(pb + 6) { if (flags & 2) nsa2_phase(F, l);
#ifdef HY_XNSA2
            __syncthreads(); nsa2_phase_t<HY_XNSA2>(F, l);
#endif
 } PH_END(pb + 6)
        PH_BEGIN(pb + 7) { pg8::Gemm g{XN, wl_ptr(F, l, W_GATE), M, NGATE, DM}; pg8::StaticOrder S; S.init(M, NGATE, F.G, F.bid); pg8::EpiSigmoid E{R1, NGATE, SS + (size_t)(3 * l + 1) * M};
            pg8::gemm_phase<pg8::EpiSigmoid, pg8::StaticOrder, true, true>(lds3, g, S, E, F.tid); } PH_END(pb + 7)
        PH_BEGIN(pb + 8) { pg8::Gemm g{OA, wl_ptr(F, l, W_BRA), M, DM, 256, DM}; pg8::MergeOrder S; S.init(M, DM, F.G, F.bid); pg8::EpiMerge E{R1, MG, NGATE, DM};
            pg8::gemm_phase<pg8::EpiMerge, pg8::MergeOrder, true, true>(lds3, g, S, E, F.tid); } PH_END(pb + 8)
        PH_BEGIN(pb + 9) { pg8::Gemm g{MG, wl_ptr(F, l, W_OUT), M, DM, DM}; pg8::StaticOrder S; S.init(M, DM, F.G, F.bid); pg8::EpiResid<true, false, false> E{((float*)F.out), ((float*)F.out), XN, SS + (size_t)(3 * l + 2) * M, DM, 1.0f};
            pg8::gemm_phase<pg8::EpiResid<true, false, false>, pg8::StaticOrder, true, true>(lds3, g, S, E, F.tid); } PH_END(pb + 9)
        }
        PH_BEGIN(pb + 10) { pg8::Gemm g{XN, wl_ptr(F, l, W_GU2), M, NGU, DM}; pg8::StaticOrder S; S.init(M, NGU, F.G, F.bid); pg8::EpiSwiGLU E{R1, FF, SS + (size_t)(3 * l + 2) * M};
            pg8::gemm_phase<pg8::EpiSwiGLU, pg8::StaticOrder, true, true>(lds3, g, S, E, F.tid); } PH_END(pb + 10)
        PH_BEGIN(pb + 11) { pg8::Gemm g{R1, wl_ptr(F, l, W_DN2), M, DM, FF}; pg8::StaticOrder S; S.init(M, DM, F.G, F.bid); pg8::EpiResid<(l + 1 < DEPTH), (l + 1 == DEPTH), false> E{((float*)F.out), ((float*)F.out), XN, SS + (size_t)(3 * (l + 1 < DEPTH ? l + 1 : l)) * M, DM, 0.5f};
            pg8::gemm_phase<pg8::EpiResid<(l + 1 < DEPTH), (l + 1 == DEPTH), false>, pg8::StaticOrder, true, true>(lds3, g, S, E, F.tid); } PH_END(pb + 11)
        }
    {
        constexpr int l = 1;
        const int pb = 1 + NPL * l;
        PH_BEGIN(pb + 0) { pg8::Gemm g{XN, wl_ptr(F, l, W_GU1), M, NGU, DM}; pg8::StaticOrder S; S.init(M, NGU, F.G, F.bid); pg8::EpiSwiGLU E{R1, FF, SS + (size_t)(3 * l + 0) * M};
            pg8::gemm_phase<pg8::EpiSwiGLU, pg8::StaticOrder, true, true>(lds3, g, S, E, F.tid); } PH_END(pb + 0)
        PH_BEGIN(pb + 1) { pg8::Gemm g{R1, wl_ptr(F, l, W_DN1), M, DM, FF}; pg8::StaticOrder S; S.init(M, DM, F.G, F.bid); pg8::EpiResid<true, false, (l == 0)> E{HY_IN(F, 0), ((float*)F.out), XN, SS + (size_t)(3 * l + 1) * M, DM, 0.5f};
            pg8::gemm_phase<pg8::EpiResid<true, false, (l == 0)>, pg8::StaticOrder, true, true>(lds3, g, S, E, F.tid); } PH_END(pb + 1)
        if (flags != 0) {
        PH_BEGIN(pb + 2) { pg8::Gemm g{XN, wl_ptr(F, l, W_IN), M, DINP, DM}; pg8::StaticOrder S; S.init(M, DINP, F.G, F.bid); pg8::EpiScaled E{R1, DINP, SS + (size_t)(3 * l + 1) * M};
            pg8::gemm_phase<pg8::EpiScaled, pg8::StaticOrder, true, true>(lds3, g, S, E, F.tid); } PH_END(pb + 2)
        PH_BEGIN(pb + 3) { prep_phase(F, l); vt_build(F); } PH_END(pb + 3)
        PH_BEGIN(pb + 4) {
            if (flags & 2) cmp_phase(F, l);
            __syncthreads(); if (l == 0) STAMP(100);
            if (flags & 1) sb_phase(F);
            __syncthreads(); if (l == 0) STAMP(101);
            if (flags & 4) dsa1_phase(F, l);
        } PH_END(pb + 4)
        PH_BEGIN(pb + 5) {
            if (flags & 2) nsa1_phase(F, l);
            __syncthreads(); if (l == 0) STAMP(102);
            if (flags & 4) dsa2_phase(F);
        } PH_END(pb + 5)
        PH_BEGIN(pb + 6) { if (flags & 2) nsa2_phase(F, l); } PH_END(pb + 6)
        PH_BEGIN(pb + 7) { pg8::Gemm g{XN, wl_ptr(F, l, W_GATE), M, NGATE, DM}; pg8::StaticOrder S; S.init(M, NGATE, F.G, F.bid); pg8::EpiSigmoid E{R1, NGATE, SS + (size_t)(3 * l + 1) * M};
            pg8::gemm_phase<pg8::EpiSigmoid, pg8::StaticOrder, true, true>(lds3, g, S, E, F.tid); } PH_END(pb + 7)
        PH_BEGIN(pb + 8) { pg8::Gemm g{OA, wl_ptr(F, l, W_BRA), M, DM, 256, DM}; pg8::MergeOrder S; S.init(M, DM, F.G, F.bid); pg8::EpiMerge E{R1, MG, NGATE, DM};
            pg8::gemm_phase<pg8::EpiMerge, pg8::MergeOrder, true, true>(lds3, g, S, E, F.tid); } PH_END(pb + 8)
        PH_BEGIN(pb + 9) { pg8::Gemm g{MG, wl_ptr(F, l, W_OUT), M, DM, DM}; pg8::StaticOrder S; S.init(M, DM, F.G, F.bid); pg8::EpiResid<true, false, false> E{((float*)F.out), ((float*)F.out), XN, SS + (size_t)(3 * l + 2) * M, DM, 1.0f};
            pg8::gemm_phase<pg8::EpiResid<true, false, false>, pg8::StaticOrder, true, true>(lds3, g, S, E, F.tid); } PH_END(pb + 9)
        }
        PH_BEGIN(pb + 10) { pg8::Gemm g{XN, wl_ptr(F, l, W_GU2), M, NGU, DM}; pg8::StaticOrder S; S.init(M, NGU, F.G, F.bid); pg8::EpiSwiGLU E{R1, FF, SS + (size_t)(3 * l + 2) * M};
            pg8::gemm_phase<pg8::EpiSwiGLU, pg8::StaticOrder, true, true>(lds3, g, S, E, F.tid); } PH_END(pb + 10)
        PH_BEGIN(pb + 11) { pg8::Gemm g{R1, wl_ptr(F, l, W_DN2), M, DM, FF}; pg8::StaticOrder S; S.init(M, DM, F.G, F.bid); pg8::EpiResid<(l + 1 < DEPTH), (l + 1 == DEPTH), false> E{((float*)F.out), ((float*)F.out), XN, SS + (size_t)(3 * (l + 1 < DEPTH ? l + 1 : l)) * M, DM, 0.5f};
            pg8::gemm_phase<pg8::EpiResid<(l + 1 < DEPTH), (l + 1 == DEPTH), false>, pg8::StaticOrder, true, true>(lds3, g, S, E, F.tid); } PH_END(pb + 11)
        }
#ifdef HY_PROBE
    if (blockIdx.x == 0 && threadIdx.x == 0) {
        GAS unsigned long long* TS = (GAS unsigned long long*)((GAS unsigned char*)args.ws + WS_CTL + 65536);
        TS[NPHASES] = __builtin_amdgcn_s_memrealtime(); asm volatile("s_waitcnt vmcnt(0)" ::: "memory");
#define D(a, b) ((long long)(TS[b] - TS[a]))
        const long long d = HY_PROBE_A;
#undef D
        const unsigned long long t0 = __builtin_amdgcn_s_memrealtime();
        while ((long long)(__builtin_amdgcn_s_memrealtime() - t0) < d) __builtin_amdgcn_s_sleep(8);
    }
#endif
#undef IN
#undef SEAM
}

extern "C" void kernel_launch(void* const* d_in, const int* in_sizes, int n_in, void* d_out, int out_size, void* d_ws, size_t ws_size, hipStream_t stream) {
    static int grid = 0;
    if (grid == 0) {
        if (n_in != 21 || in_sizes[0] != M * DM || out_size != M * DM || ws_size < WS_END) { fprintf(stderr, "kernel_launch: unexpected shapes (n_in %d, x %d, out %d, ws %zu); nothing launched\n", n_in, n_in > 0 ? in_sizes[0] : -1, out_size, ws_size); grid = -1; return; }
        int dev = 0, cus = 0, per_cu = 0;
        if (hipGetDevice(&dev) != hipSuccess || hipDeviceGetAttribute(&cus, hipDeviceAttributeMultiprocessorCount, dev) != hipSuccess) { grid = -1; return; }
        if (hipFuncSetAttribute((const void*)hy_fwd, hipFuncAttributeMaxDynamicSharedMemorySize, LDS_BYTES) != hipSuccess) { fprintf(stderr, "kernel_launch: hipFuncSetAttribute failed\n"); grid = -1; return; }
        if (hipOccupancyMaxActiveBlocksPerMultiprocessor(&per_cu, (const void*)hy_fwd, NTHREADS, LDS_BYTES) != hipSuccess || per_cu < 1)
            fprintf(stderr, "kernel_launch: note: occupancy query reports %d workgroups per CU\n", per_cu);
        (void)hipGetLastError();
        grid = cus;
    }
    if (grid < 0) return;
    if (hipMemsetAsync((char*)d_ws + WS_CTL, 0, CTL_ZERO_BYTES, stream) != hipSuccess) return;
    Args a{};
    for (int i = 0; i < 21; ++i) a.in[i] = (const float*)d_in[i];
    a.out = (float*)d_out; a.ws = (unsigned char*)d_ws; a.flags = HY_FLAGS;
#if HY_N_LAUNCHES == 1
    a.ph_lo = 0; a.ph_hi = NPHASES; a.use_bar = 1;
    hipLaunchKernelGGL(hy_fwd, dim3(grid), dim3(NTHREADS), LDS_BYTES, stream, a);
#else
#ifdef HY_DUMP_PHASE
    for (int p = 0; p <= HY_DUMP_PHASE; ++p) { a.ph_lo = p; a.ph_hi = p + 1; a.use_bar = 0; hipLaunchKernelGGL(hy_fwd, dim3(grid), dim3(NTHREADS), LDS_BYTES, stream, a); }
    a.ph_lo = 999; a.ph_hi = 1000; a.use_bar = 0; hipLaunchKernelGGL(hy_fwd, dim3(grid), dim3(NTHREADS), LDS_BYTES, stream, a);
#else
    for (int p = 0; p < NPHASES; ++p) { a.ph_lo = p; a.ph_hi = p + 1; a.use_bar = 0; hipLaunchKernelGGL(hy_fwd, dim3(grid), dim3(NTHREADS), LDS_BYTES, stream, a); }
#endif
#endif
}
```

```cpp
#include <hip/hip_runtime.h>
#include <cstdio>
#include <cstdint>
namespace pg8 {
#define PG8_LAS __attribute__((address_space(3)))
typedef unsigned short bf16_t;
typedef short bf16x8 __attribute__((ext_vector_type(8)));
typedef float f32x4 __attribute__((ext_vector_type(4)));
typedef unsigned u32x4 __attribute__((ext_vector_type(4)));
constexpr int BM = 256, BK = 64, HALF = 128, HTB = HALF * BK * 2  , STAGE_BYTES = 8 * HTB, NXCD = 8, WGM = 8;

__host__ __device__ __forceinline__ int lds_byte(int r, int c) { const int st = (r >> 4) * 2 + (c >> 5), rr = r & 15, cc = c & 31, ob = rr * 64 + cc * 2; return st * 1024 + (ob ^ (((ob >> 9) & 1) << 5)); }
__host__ __device__ __forceinline__ void stage_rc(int b, int& R, int& C) { const int st = b / 1024, sb = b % 1024, swz = sb ^ (((sb >> 9) & 1) << 5); R = (st >> 1) * 16 + swz / 64; C = (st & 1) * 32 + (swz % 64) / 2; }
__host__ __device__ __forceinline__ int perm32(int rho) { const int n = rho >> 4, i = rho & 15; return 8 * (i >> 2) + 4 * n + (i & 3); }

struct Unit { int pm, pn; int ks = 0; };
struct Gemm { const bf16_t* A; const bf16_t* Bt; int M, N, K; int ld = 0; };

struct StaticOrder {
    int nM, nN, nwg, G, c;
    __host__ __device__ void init(int M, int N, int G_, int c_) { nM = M / BM; nN = N / BM; nwg = nM * nN; G = G_; c = c_; }
    __host__ __device__ bool next(int i, Unit& u) const {
        const long L = (long)i * G + c; if (L >= nwg) return false;
        int wgid = (int)L; { const int q = nwg / NXCD, r = nwg % NXCD, xcd = wgid % NXCD, off = wgid / NXCD; wgid = (xcd < r ? xcd * (q + 1) : r * (q + 1) + (xcd - r) * q) + off; }
        const int nig = WGM * nN, gid = wgid / nig, fm = gid * WGM, gsz = (nM - fm) < WGM ? (nM - fm) : WGM;
        u.pm = fm + ((wgid % nig) % gsz); u.pn = (wgid % nig) / gsz; return true;
    }
    __device__ __forceinline__ void a_ready(const Unit&) const {}
    __device__ __forceinline__ void done(const Unit&) const {}
};

__device__ __forceinline__ unsigned cvt_pk_bf16(float lo, float hi) { unsigned r; asm volatile("v_cvt_pk_bf16_f32 %0, %1, %2" : "=v"(r) : "v"(lo), "v"(hi)); return r; }
typedef float f32x2 __attribute__((ext_vector_type(2)));
__device__ __forceinline__ f32x2 gelu_pk(f32x2 v) {
    const f32x2 av = __builtin_elementwise_abs(v), d = av * 0.2316418882f + 1.0f;
    f32x2 t; t.x = __builtin_amdgcn_rcpf(d.x); t.y = __builtin_amdgcn_rcpf(d.y);
    f32x2 q = t * 0.5307027145f + (-0.7265760135f); q = q * t + 0.7107068705f; q = q * t + (-0.142248368f); q = q * t + 0.127414796f; q = q * t;
    const f32x2 s = (v * v) * (-0.72134752044f);
    f32x2 e; e.x = __builtin_amdgcn_exp2f(s.x); e.y = __builtin_amdgcn_exp2f(s.y);
    const f32x2 m = v * (q * e), r = v - m;
    f32x2 o; o.x = v.x < 0.f ? m.x : r.x; o.y = v.y < 0.f ? m.y : r.y; return o;
}

template <int ACT  > struct EpiBf16 {
    static constexpr bool PERM = true, AFTER_DRAIN = false, KEEP_ACC = false; static_assert(ACT == 0 || ACT == 1, "EpiBf16: ACT is 0 (none) or 1 (gelu_pk)");
    bf16_t* O; int ldc; const float* bias; int split_cols; size_t split_stride; float scale0;
    __device__ __forceinline__ void operator()(const f32x4 (&acc)[2][2][4][2], const Unit& u, int wr, int wc, int fr, int fq) const {
        const int row0 = u.pm * BM + wr * 64 + fr; int colt = u.pn * BM; bf16_t* base = O;
        float sc = 1.f; if (split_cols) { const int t = colt / split_cols; base += (size_t)t * split_stride; colt -= t * split_cols; if (t == 0) sc = scale0; }
        const int col0 = colt + wc * 32 + 8 * fq, bcol0 = u.pn * BM + wc * 32 + 8 * fq;
        f32x4 bv[2][2];
#pragma unroll
        for (int bj = 0; bj < 2; ++bj)
#pragma unroll
            for (int n = 0; n < 2; ++n) bv[bj][n] = bias ? *(const f32x4*)(bias + bcol0 + bj * HALF + 4 * n) : (f32x4){0.f, 0.f, 0.f, 0.f};
#pragma unroll
        for (int ai = 0; ai < 2; ++ai)
#pragma unroll
            for (int m = 0; m < 4; ++m) { bf16_t* rowp = base + (size_t)(row0 + ai * HALF + m * 16) * ldc + col0;
#pragma unroll
                for (int bj = 0; bj < 2; ++bj) { f32x4 v0 = acc[ai][bj][m][0] + bv[bj][0], v1 = acc[ai][bj][m][1] + bv[bj][1];
                    if (ACT == 1) { f32x2 a = gelu_pk((f32x2){v0[0], v0[1]}), b = gelu_pk((f32x2){v0[2], v0[3]}), c = gelu_pk((f32x2){v1[0], v1[1]}), d = gelu_pk((f32x2){v1[2], v1[3]});
                        v0 = (f32x4){a.x, a.y, b.x, b.y}; v1 = (f32x4){c.x, c.y, d.x, d.y}; }
                    v0 = v0 * sc; v1 = v1 * sc; u32x4 w; w.x = cvt_pk_bf16(v0[0], v0[1]); w.y = cvt_pk_bf16(v0[2], v0[3]); w.z = cvt_pk_bf16(v1[0], v1[1]); w.w = cvt_pk_bf16(v1[2], v1[3]);
                    *(u32x4*)(rowp + bj * HALF) = w; } }
    }
};

template <class Epi, class Sched, bool ALIGN_EPI = false, bool SP2 = false>
__device__ __forceinline__ void gemm_phase(PG8_LAS unsigned char* lds, const Gemm g, const Sched& S, const Epi& E, const int tid_in) {
    const int tid = tid_in,     wid = __builtin_amdgcn_readfirstlane(tid >> 6), lane = tid & 63, wr = wid >> 2, wc = wid & 3, fr = lane & 15, fq = lane >> 4;
    const int K = g.K, nt = K / BK, LD = g.ld ? g.ld : g.K;
    unsigned voffA[2], voffB[2];
#pragma unroll
    for (int i = 0; i < 2; ++i) { int R, C; stage_rc(tid * 16 + i * 8192, R, C); const int Rb = Epi::PERM ? ((R & ~31) + perm32(R & 31)) : R;
        voffA[i] = (unsigned)(R * LD + C) * 2u; voffB[i] = (unsigned)(Rb * LD + C) * 2u; }
    const size_t kstep = (size_t)(BK * 2);
    const size_t hstep = (size_t)HALF * LD * 2;
    const size_t tstep = 2 * hstep;
    const unsigned ldsw = (unsigned)wid * 1024u;
    const int aoff = lds_byte(wr * 64 + fr, fq * 8), boff = lds_byte(wc * 32 + fr, fq * 8);
#define PG8_SA(b, h) (((b) * 2 + (h)) * HTB)
#define PG8_SB(b, h) ((4 + (b) * 2 + (h)) * HTB)
#define PG8_STAGE(bufoff, gbase, voff) do { const char* _gb = (const char*)(gbase); asm volatile("" : "+s"(_gb)); _Pragma("unroll") for (int _i = 0; _i < 2; ++_i) \
        __builtin_amdgcn_global_load_lds((const unsigned*)(_gb + (voff)[_i]), (PG8_LAS unsigned*)(lds + (bufoff) + ldsw + _i * 8192), 16, 0, 0); } while (0)
#define PG8_LDA(dst, b, h) do { _Pragma("unroll") for (int m = 0; m < 4; ++m) _Pragma("unroll") for (int k = 0; k < 2; ++k) dst[m][k] = *(const PG8_LAS bf16x8*)(lds + PG8_SA(b, h) + aoff + m * 2048 + k * 1024); } while (0)
#define PG8_LDB(dst, b, h) do { _Pragma("unroll") for (int n = 0; n < 2; ++n) _Pragma("unroll") for (int k = 0; k < 2; ++k) dst[n][k] = *(const PG8_LAS bf16x8*)(lds + PG8_SB(b, h) + boff + n * 2048 + k * 1024); } while (0)
#define PG8_MMA(ai, bj, At, Bt) do { __builtin_amdgcn_s_setprio(1); _Pragma("unroll") for (int m = 0; m < 4; ++m) _Pragma("unroll") for (int n = 0; n < 2; ++n) _Pragma("unroll") for (int k = 0; k < 2; ++k) \
        acc[ai][bj][m][n] = __builtin_amdgcn_mfma_f32_16x16x32_bf16(Bt[n][k], At[m][k], acc[ai][bj][m][n], 0, 0, 0); __builtin_amdgcn_s_setprio(0); } while (0)
#define PG8_WAIT_V(n) asm volatile("s_waitcnt vmcnt(" #n ")" ::: "memory")
#define PG8_WAIT_L(n) asm volatile("s_waitcnt lgkmcnt(" #n ")" ::: "memory")
#define PG8_BAR __builtin_amdgcn_s_barrier()
#define PG8_SCHED __builtin_amdgcn_sched_barrier(0)
    Unit cur, nxt; int ui = 0;
    if (!S.next(0, cur)) return;
    f32x4 acc[2][2][4][2];
#pragma unroll
    for (int a = 0; a < 2; ++a)
#pragma unroll
        for (int b = 0; b < 2; ++b)
#pragma unroll
            for (int m = 0; m < 4; ++m)
#pragma unroll
                for (int n = 0; n < 2; ++n) acc[a][b][m][n] = (f32x4){0.f, 0.f, 0.f, 0.f};
    bf16x8 At[4][2], B0[2][2], B1[2][2];
    const char* cA = (const char*)g.A + (size_t)cur.pm * tstep + (size_t)cur.ks * K * 2; const char* cB = (const char*)g.Bt + (size_t)cur.pn * tstep + (size_t)cur.ks * K * 2;
    S.a_ready(cur);
    if constexpr (SP2) {
        PG8_STAGE(PG8_SB(0, 0), cB, voffB); PG8_STAGE(PG8_SB(0, 1), cB + hstep, voffB); PG8_STAGE(PG8_SA(0, 0), cA, voffA); PG8_STAGE(PG8_SA(0, 1), cA + hstep, voffA);
        if (wr == 1) PG8_BAR;
        PG8_WAIT_V(2); PG8_BAR;
        PG8_STAGE(PG8_SB(1, 0), cB + kstep, voffB); PG8_STAGE(PG8_SA(1, 0), cA + kstep, voffA); PG8_STAGE(PG8_SB(1, 1), cB + hstep + kstep, voffB);
        PG8_WAIT_V(6); PG8_BAR;
    } else {
        PG8_STAGE(PG8_SB(0, 0), cB, voffB); PG8_STAGE(PG8_SA(0, 0), cA, voffA); PG8_STAGE(PG8_SB(0, 1), cB + hstep, voffB); PG8_STAGE(PG8_SA(0, 1), cA + hstep, voffA);
        if (wr == 1) PG8_BAR;
        PG8_WAIT_V(4); PG8_BAR;
        PG8_STAGE(PG8_SB(1, 0), cB + kstep, voffB); PG8_STAGE(PG8_SA(1, 0), cA + kstep, voffA); PG8_STAGE(PG8_SB(1, 1), cB + hstep + kstep, voffB);
        PG8_WAIT_V(6); PG8_BAR;
    }
    for (;;) {
        const bool has_next = S.next(ui + 1, nxt);
        const char* nA = has_next ? (const char*)g.A + (size_t)nxt.pm * tstep + (size_t)nxt.ks * K * 2 : cA; const char* nB = has_next ? (const char*)g.Bt + (size_t)nxt.pn * tstep + (size_t)nxt.ks * K * 2 : cB;
        for (int t = 0; t < nt; t += 2) {
            const bool last = (t == nt - 2);
            const char* a1 = cA + (size_t)(t + 1) * kstep;
            const char* a2 = last ? nA : cA + (size_t)(t + 2) * kstep; const char* b2 = last ? nB : cB + (size_t)(t + 2) * kstep;
            const char* a3 = a2 + kstep; const char* b3 = b2 + kstep;
            if (last && has_next) S.a_ready(nxt);
            if constexpr (SP2) {
            PG8_LDB(B0, 0, 0); PG8_LDB(B1, 0, 1); PG8_SCHED; PG8_LDA(At, 0, 0); PG8_STAGE(PG8_SA(1, 1), a1 + hstep, voffA);
            PG8_WAIT_V(8); PG8_WAIT_L(0); PG8_BAR; PG8_MMA(0, 0, At, B0); PG8_MMA(0, 1, At, B1); PG8_BAR; PG8_SCHED;
            PG8_LDA(At, 0, 1); PG8_STAGE(PG8_SB(0, 0), b2, voffB); PG8_STAGE(PG8_SB(0, 1), b2 + hstep, voffB); PG8_STAGE(PG8_SA(0, 0), a2, voffA);
            PG8_WAIT_V(8); PG8_WAIT_L(0); PG8_BAR; PG8_MMA(1, 0, At, B0); PG8_MMA(1, 1, At, B1); PG8_BAR; PG8_SCHED;
            PG8_LDB(B0, 1, 0); PG8_LDB(B1, 1, 1); PG8_SCHED; PG8_LDA(At, 1, 0); PG8_STAGE(PG8_SA(0, 1), a2 + hstep, voffA);
            PG8_WAIT_V(8); PG8_WAIT_L(0); PG8_BAR; PG8_MMA(0, 0, At, B0); PG8_MMA(0, 1, At, B1); PG8_BAR; PG8_SCHED;
            PG8_LDA(At, 1, 1); PG8_STAGE(PG8_SB(1, 0), b3, voffB); PG8_STAGE(PG8_SB(1, 1), b3 + hstep, voffB); PG8_STAGE(PG8_SA(1, 0), a3, voffA);
            PG8_WAIT_V(8); PG8_WAIT_L(0); PG8_BAR; PG8_MMA(1, 0, At, B0); PG8_MMA(1, 1, At, B1); PG8_BAR; PG8_SCHED;
            } else {
            PG8_LDB(B0, 0, 0); PG8_SCHED; PG8_LDA(At, 0, 0); PG8_STAGE(PG8_SA(1, 1), a1 + hstep, voffA);
            PG8_WAIT_L(8); PG8_BAR; PG8_WAIT_L(0); PG8_MMA(0, 0, At, B0); PG8_BAR; PG8_SCHED;
            PG8_LDB(B1, 0, 1); PG8_STAGE(PG8_SB(0, 0), b2, voffB);
            PG8_BAR; PG8_WAIT_L(0); PG8_MMA(0, 1, At, B1); PG8_BAR;
            PG8_LDA(At, 0, 1); PG8_STAGE(PG8_SA(0, 0), a2, voffA);
            PG8_BAR; PG8_WAIT_L(0); PG8_MMA(1, 0, At, B0); PG8_BAR; PG8_SCHED;
            PG8_STAGE(PG8_SB(0, 1), b2 + hstep, voffB);
            PG8_WAIT_V(6); PG8_BAR; PG8_MMA(1, 1, At, B1); PG8_BAR;
            PG8_LDB(B0, 1, 0); PG8_SCHED; PG8_LDA(At, 1, 0); PG8_STAGE(PG8_SA(0, 1), a2 + hstep, voffA);
            PG8_WAIT_L(8); PG8_BAR; PG8_WAIT_L(0); PG8_MMA(0, 0, At, B0); PG8_BAR; PG8_SCHED;
            PG8_LDB(B1, 1, 1); PG8_STAGE(PG8_SB(1, 0), b3, voffB);
            PG8_BAR; PG8_WAIT_L(0); PG8_MMA(0, 1, At, B1); PG8_BAR;
            PG8_LDA(At, 1, 1); PG8_STAGE(PG8_SA(1, 0), a3, voffA);
            PG8_BAR; PG8_WAIT_L(0); PG8_MMA(1, 0, At, B0); PG8_BAR; PG8_SCHED;
            PG8_STAGE(PG8_SB(1, 1), b3 + hstep, voffB);
            PG8_WAIT_V(6); PG8_BAR; PG8_MMA(1, 1, At, B1); PG8_BAR;
            }
        }
        if constexpr (ALIGN_EPI) { if (wr == 0) PG8_BAR; }
        if constexpr (Epi::KEEP_ACC) { E.hook(acc, cur, wr, wc, fr, fq); S.done(cur); }
        else if constexpr (!Epi::AFTER_DRAIN) { E(acc, cur, wr, wc, fr, fq); S.done(cur); }
        if (!has_next) break;
        if (!(Epi::KEEP_ACC && nxt.ks != 0)) {
#pragma unroll
        for (int a = 0; a < 2; ++a)
#pragma unroll
            for (int b = 0; b < 2; ++b)
#pragma unroll
                for (int m = 0; m < 4; ++m)
#pragma unroll
                    for (int n = 0; n < 2; ++n) acc[a][b][m][n] = (f32x4){0.f, 0.f, 0.f, 0.f};
        }
        cur = nxt; cA = nA; cB = nB; ++ui;
        if constexpr (ALIGN_EPI) { if (wr == 1) PG8_BAR; }
    }
    PG8_WAIT_V(0);
    if constexpr (!ALIGN_EPI) { if (wr == 0) PG8_BAR; }
    PG8_BAR;
    if constexpr (Epi::AFTER_DRAIN) { E.fused(acc, cur, wr, wc, fr, fq, lds, wid, lane); S.done(cur); }
#undef PG8_SA
#undef PG8_SB
#undef PG8_STAGE
#undef PG8_LDA
#undef PG8_LDB
#undef PG8_MMA
#undef PG8_WAIT_V
#undef PG8_WAIT_L
#undef PG8_BAR
#undef PG8_SCHED
}
}
namespace pg8 {
struct HotOrder : StaticOrder { __host__ __device__ bool next(int i, Unit& u) const { const bool ok = StaticOrder::next(i, u); u.pm &= 7; return ok; } };
typedef float f32x2_t __attribute__((ext_vector_type(2))); typedef __bf16 bf16x2_t __attribute__((ext_vector_type(2)));
__device__ __forceinline__ unsigned cvtpk_s(float lo, float hi) { f32x2_t v = {lo, hi}; bf16x2_t b = __builtin_convertvector(v, bf16x2_t); return __builtin_bit_cast(unsigned, b); }
__device__ __forceinline__ float silu_f(float x) { return x * __builtin_amdgcn_rcpf(1.0f + __builtin_amdgcn_exp2f(-1.4426950408889634f * x)); }
__device__ __forceinline__ float sigm_f(float x) { return __builtin_amdgcn_rcpf(1.0f + __builtin_amdgcn_exp2f(-1.4426950408889634f * x)); }
struct EpiSwiGLU {
    static constexpr bool PERM = true, AFTER_DRAIN = false, KEEP_ACC = false;
    bf16_t* O; int ldc; const unsigned long long* SSQ;
    __device__ __forceinline__ void operator()(const f32x4 (&acc)[2][2][4][2], const Unit& u, int wr, int wc, int fr, int fq) const {
        const int row0 = u.pm * BM + wr * 64 + fr, col0 = u.pn * HALF + wc * 32 + 8 * fq;
#pragma unroll
        for (int ai = 0; ai < 2; ++ai)
#pragma unroll
            for (int m = 0; m < 4; ++m) { bf16_t* rowp = O + (size_t)(row0 + ai * HALF + m * 16) * ldc + col0;
                const float rs = __builtin_amdgcn_rsqf((float)SSQ[row0 + ai * HALF + m * 16] * (1.0f / (1024.0f * 1048576.0f)) + 1e-6f);
                const f32x4 g0 = acc[ai][0][m][0] * rs, g1 = acc[ai][0][m][1] * rs, u0 = acc[ai][1][m][0] * rs, u1 = acc[ai][1][m][1] * rs;
                u32x4 w; w.x = cvtpk_s(silu_f(g0[0]) * u0[0], silu_f(g0[1]) * u0[1]); w.y = cvtpk_s(silu_f(g0[2]) * u0[2], silu_f(g0[3]) * u0[3]);
                w.z = cvtpk_s(silu_f(g1[0]) * u1[0], silu_f(g1[1]) * u1[1]); w.w = cvtpk_s(silu_f(g1[2]) * u1[2], silu_f(g1[3]) * u1[3]);
                *(u32x4*)rowp = w; }
    }
};
template <bool XBW, bool F32OUT, bool BASEF32> struct EpiResid {
    static constexpr bool PERM = true, AFTER_DRAIN = false, KEEP_ACC = false;
    const float* base_; float* out_; bf16_t* XB_; unsigned long long* SSQ_; int ldc_; float alpha_;
    __device__ __forceinline__ void operator()(const f32x4 (&acc)[2][2][4][2], const Unit& u, int wr, int wc, int fr, int fq) const {
        const float* base = base_; float* out = out_; const int ldc = ldc_; const float alpha = alpha_; bf16_t* XB = XB_; unsigned long long* SSQ = SSQ_;
        const int row0 = u.pm * BM + wr * 64 + fr, col0 = u.pn * BM + wc * 32 + 8 * fq;
        constexpr int MB = BASEF32 ? 2 : 4;
#pragma unroll
        for (int ai = 0; ai < 2; ++ai)
#pragma unroll
            for (int mb = 0; mb < 4; mb += MB) {
                u32x4 bw[MB][2]; f32x4 bf[MB][2][2];
#pragma unroll
                for (int mm = 0; mm < MB; ++mm)
#pragma unroll
                    for (int bj = 0; bj < 2; ++bj) { const size_t off = (size_t)(row0 + ai * HALF + (mb + mm) * 16) * ldc + col0 + bj * HALF;
                        if (BASEF32) { bf[mm][bj][0] = *(const f32x4*)(base + off); bf[mm][bj][1] = *(const f32x4*)(base + off + 4); }
                        else bw[mm][bj] = *(const u32x4*)(XB + off); }
#pragma unroll
                for (int mm = 0; mm < MB; ++mm) { const int m = mb + mm; float ss = 0.f;
#pragma unroll
                    for (int bj = 0; bj < 2; ++bj) { const size_t off = (size_t)(row0 + ai * HALF + m * 16) * ldc + col0 + bj * HALF;
                        f32x4 b0, b1;
                        if (BASEF32) { b0 = bf[mm][bj][0]; b1 = bf[mm][bj][1]; }
                        else { const u32x4 q = bw[mm][bj]; b0 = (f32x4){__uint_as_float(q.x << 16), __uint_as_float(q.x & 0xffff0000u), __uint_as_float(q.y << 16), __uint_as_float(q.y & 0xffff0000u)};
                            b1 = (f32x4){__uint_as_float(q.z << 16), __uint_as_float(q.z & 0xffff0000u), __uint_as_float(q.w << 16), __uint_as_float(q.w & 0xffff0000u)}; }
                        const f32x4 o0 = b0 + acc[ai][bj][m][0] * alpha, o1 = b1 + acc[ai][bj][m][1] * alpha;
                        if (F32OUT) { *(f32x4*)(out + off) = o0; *(f32x4*)(out + off + 4) = o1; }
                        if (XBW) { ss += ((o0[0] * o0[0] + o0[1] * o0[1]) + (o0[2] * o0[2] + o0[3] * o0[3])) + ((o1[0] * o1[0] + o1[1] * o1[1]) + (o1[2] * o1[2] + o1[3] * o1[3]));
                            u32x4 w; w.x = cvtpk_s(o0[0], o0[1]); w.y = cvtpk_s(o0[2], o0[3]); w.z = cvtpk_s(o1[0], o1[1]); w.w = cvtpk_s(o1[2], o1[3]); *(u32x4*)(XB + off) = w; } }
                    if (XBW) {
                        { auto r_ = __builtin_amdgcn_permlane16_swap(__float_as_uint(ss), __float_as_uint(ss), false, false); ss = __uint_as_float(r_[0]) + __uint_as_float(r_[1]); }
                        { auto r_ = __builtin_amdgcn_permlane32_swap(__float_as_uint(ss), __float_as_uint(ss), false, false); ss = __uint_as_float(r_[0]) + __uint_as_float(r_[1]); }
                        if (fq == 0) atomicAdd(SSQ + (row0 + ai * HALF + m * 16), (unsigned long long)(ss * 1048576.0f)); } }
                __builtin_amdgcn_sched_barrier(0); }
    }
};
struct EpiScaled {
    static constexpr bool PERM = true, AFTER_DRAIN = false, KEEP_ACC = false;
    bf16_t* O; int ldc; const unsigned long long* SSQ;
    __device__ __forceinline__ void operator()(const f32x4 (&acc)[2][2][4][2], const Unit& u, int wr, int wc, int fr, int fq) const {
        const int row0 = u.pm * BM + wr * 64 + fr, col0 = u.pn * BM + wc * 32 + 8 * fq;
#pragma unroll
        for (int ai = 0; ai < 2; ++ai)
#pragma unroll
            for (int m = 0; m < 4; ++m) { bf16_t* rowp = O + (size_t)(row0 + ai * HALF + m * 16) * ldc + col0;
                const float rs = __builtin_amdgcn_rsqf((float)SSQ[row0 + ai * HALF + m * 16] * (1.0f / (1024.0f * 1048576.0f)) + 1e-6f);
#pragma unroll
                for (int bj = 0; bj < 2; ++bj) { const f32x4 v0 = acc[ai][bj][m][0] * rs, v1 = acc[ai][bj][m][1] * rs;
                    u32x4 w; w.x = cvtpk_s(v0[0], v0[1]); w.y = cvtpk_s(v0[2], v0[3]); w.z = cvtpk_s(v1[0], v1[1]); w.w = cvtpk_s(v1[2], v1[3]);
                    *(u32x4*)(rowp + bj * HALF) = w; } }
    }
};
struct EpiSigmoid {
    static constexpr bool PERM = true, AFTER_DRAIN = false, KEEP_ACC = false;
    bf16_t* O; int ldc; const unsigned long long* SSQ;
    __device__ __forceinline__ void operator()(const f32x4 (&acc)[2][2][4][2], const Unit& u, int wr, int wc, int fr, int fq) const {
        const int row0 = u.pm * BM + wr * 64 + fr, col0 = u.pn * BM + wc * 32 + 8 * fq;
#pragma unroll
        for (int ai = 0; ai < 2; ++ai)
#pragma unroll
            for (int m = 0; m < 4; ++m) { bf16_t* rowp = O + (size_t)(row0 + ai * HALF + m * 16) * ldc + col0;
                const float rs = __builtin_amdgcn_rsqf((float)SSQ[row0 + ai * HALF + m * 16] * (1.0f / (1024.0f * 1048576.0f)) + 1e-6f);
#pragma unroll
                for (int bj = 0; bj < 2; ++bj) { const f32x4 v0 = acc[ai][bj][m][0] * rs, v1 = acc[ai][bj][m][1] * rs;
                    u32x4 w; w.x = cvtpk_s(sigm_f(v0[0]), sigm_f(v0[1])); w.y = cvtpk_s(sigm_f(v0[2]), sigm_f(v0[3])); w.z = cvtpk_s(sigm_f(v1[0]), sigm_f(v1[1])); w.w = cvtpk_s(sigm_f(v1[2]), sigm_f(v1[3]));
                    *(u32x4*)(rowp + bj * HALF) = w; } }
    }
};
struct EpiGated {
    static constexpr bool PERM = true, AFTER_DRAIN = false, KEEP_ACC = false;
    const bf16_t* G; int ldg; int gcol; bf16_t* MG; int ldm; int first;
    __device__ __forceinline__ void operator()(const f32x4 (&acc)[2][2][4][2], const Unit& u, int wr, int wc, int fr, int fq) const {
        const int row0 = u.pm * BM + wr * 64 + fr, col0 = u.pn * BM + wc * 32 + 8 * fq;
#pragma unroll
        for (int ai = 0; ai < 2; ++ai)
#pragma unroll
            for (int m = 0; m < 4; ++m) { const size_t r = (size_t)(row0 + ai * HALF + m * 16);
#pragma unroll
                for (int bj = 0; bj < 2; ++bj) { const f32x4 v0 = acc[ai][bj][m][0], v1 = acc[ai][bj][m][1];
                    const u32x4 g = *(const u32x4*)(G + r * ldg + gcol + col0 + bj * HALF);
                    u32x4 p = (u32x4){0u, 0u, 0u, 0u}; if (!first) p = *(const u32x4*)(MG + r * ldm + col0 + bj * HALF);
#define HY_LO(x) __uint_as_float((x) << 16)
#define HY_HI(x) __uint_as_float((x) & 0xffff0000u)
                    u32x4 w;
                    w.x = cvtpk_s(HY_LO(p.x) + HY_LO(g.x) * v0[0], HY_HI(p.x) + HY_HI(g.x) * v0[1]);
                    w.y = cvtpk_s(HY_LO(p.y) + HY_LO(g.y) * v0[2], HY_HI(p.y) + HY_HI(g.y) * v0[3]);
                    w.z = cvtpk_s(HY_LO(p.z) + HY_LO(g.z) * v1[0], HY_HI(p.z) + HY_HI(g.z) * v1[1]);
                    w.w = cvtpk_s(HY_LO(p.w) + HY_LO(g.w) * v1[2], HY_HI(p.w) + HY_HI(g.w) * v1[3]);
#undef HY_LO
#undef HY_HI
                    *(u32x4*)(MG + r * ldm + col0 + bj * HALF) = w; }
                asm volatile("" ::: "memory"); }
    }
};

struct EpiNull {
    static constexpr bool PERM = true, AFTER_DRAIN = false, KEEP_ACC = false;
    __device__ __forceinline__ void operator()(const f32x4 (&acc)[2][2][4][2], const Unit&, int, int, int, int) const {
#pragma unroll
        for (int a = 0; a < 2; ++a)
#pragma unroll
            for (int b = 0; b < 2; ++b)
#pragma unroll
                for (int m = 0; m < 4; ++m)
#pragma unroll
                    for (int n = 0; n < 2; ++n) asm volatile("" :: "v"(acc[a][b][m][n]));
    }
};
struct MergeOrder {
    StaticOrder base;
    __host__ __device__ void init(int M, int N, int G_, int c_) { base.init(M, N, G_, c_); }
    __host__ __device__ bool next(int i, Unit& u) const { const bool ok = base.next(i >> 2, u); u.ks = i & 3; return ok; }
    __device__ __forceinline__ void a_ready(const Unit&) const {}
    __device__ __forceinline__ void done(const Unit&) const {}
};
struct EpiMerge {
    static constexpr bool PERM = true, AFTER_DRAIN = false, KEEP_ACC = true;
    const bf16_t* G_; bf16_t* MG_; int ldg_, ldm_;
    __device__ __forceinline__ void operator()(const f32x4 (&)[2][2][4][2], const Unit&, int, int, int, int) const {}
    __device__ __forceinline__ void hook(f32x4 (&acc)[2][2][4][2], const Unit& u, int wr, int wc, int fr, int fq) const {
        const int ks = u.ks; if (ks == 1) return;
        const bf16_t* G = G_; bf16_t* MG = MG_; const int ldg = ldg_, ldm = ldm_;
        const int row0 = u.pm * BM + wr * 64 + fr, col0 = u.pn * BM + wc * 32 + 8 * fq;
        const int gnum = (ks == 0) ? 0 : (ks == 2) ? 1024 : 2048, gden = (ks == 0) ? 1024 : 2048;
#define HY_LO(x) __uint_as_float((x) << 16)
#define HY_HI(x) __uint_as_float((x) & 0xffff0000u)
#pragma unroll
        for (int ai = 0; ai < 2; ++ai)
#pragma unroll
            for (int m = 0; m < 4; ++m) { const size_t r = (size_t)(row0 + ai * HALF + m * 16);
#pragma unroll
                for (int bj = 0; bj < 2; ++bj) {
                    const u32x4 gn = *(const u32x4*)(G + r * ldg + gnum + col0 + bj * HALF);
                    if (ks != 3) { const u32x4 gd = *(const u32x4*)(G + r * ldg + gden + col0 + bj * HALF);
#define HY_SC(acc_, n_, d_) acc_ *= (n_) * __builtin_amdgcn_rcpf(fmaxf((d_), 1e-30f))
                        HY_SC(acc[ai][bj][m][0][0], HY_LO(gn.x), HY_LO(gd.x)); HY_SC(acc[ai][bj][m][0][1], HY_HI(gn.x), HY_HI(gd.x)); HY_SC(acc[ai][bj][m][0][2], HY_LO(gn.y), HY_LO(gd.y)); HY_SC(acc[ai][bj][m][0][3], HY_HI(gn.y), HY_HI(gd.y));
                        HY_SC(acc[ai][bj][m][1][0], HY_LO(gn.z), HY_LO(gd.z)); HY_SC(acc[ai][bj][m][1][1], HY_HI(gn.z), HY_HI(gd.z)); HY_SC(acc[ai][bj][m][1][2], HY_LO(gn.w), HY_LO(gd.w)); HY_SC(acc[ai][bj][m][1][3], HY_HI(gn.w), HY_HI(gd.w));
#undef HY_SC
                    } else { u32x4 w;
                        w.x = cvtpk_s(acc[ai][bj][m][0][0] * HY_LO(gn.x), acc[ai][bj][m][0][1] * HY_HI(gn.x)); w.y = cvtpk_s(acc[ai][bj][m][0][2] * HY_LO(gn.y), acc[ai][bj][m][0][3] * HY_HI(gn.y));
                        w.z = cvtpk_s(acc[ai][bj][m][1][0] * HY_LO(gn.z), acc[ai][bj][m][1][1] * HY_HI(gn.z)); w.w = cvtpk_s(acc[ai][bj][m][1][2] * HY_LO(gn.w), acc[ai][bj][m][1][3] * HY_HI(gn.w));
                        *(u32x4*)(MG + r * ldm + col0 + bj * HALF) = w; }
                    asm volatile("" ::: "memory"); } }
#undef HY_LO
#undef HY_HI
    }
};
}
#define GAS __attribute__((address_space(1)))
#define LAS __attribute__((address_space(3)))
typedef unsigned short bf16;
typedef unsigned v4u __attribute__((ext_vector_type(4)));
typedef float f32x4 __attribute__((ext_vector_type(4)));
typedef short bf16x8 __attribute__((ext_vector_type(8)));
typedef GAS unsigned gu32;
typedef GAS unsigned long long gu64;
#define RLX_AGENT __ATOMIC_RELAXED, __HIP_MEMORY_SCOPE_AGENT
#define LDS_WAIT() asm volatile("s_waitcnt lgkmcnt(0)" ::: "memory")
#define VM_WAIT() asm volatile("s_waitcnt vmcnt(0)" ::: "memory")
__device__ __forceinline__ unsigned long long rt() { return __builtin_amdgcn_s_memrealtime(); }
__device__ __forceinline__ unsigned f2bf(float f) { unsigned u = __builtin_bit_cast(unsigned, f); return (u + 0x7fffu + ((u >> 16) & 1u)) >> 16; }
__device__ __forceinline__ unsigned pk2(float lo, float hi) { return f2bf(lo) | (f2bf(hi) << 16); }

#define XB_TMO      128
#define XB_XCNT(j)  (256  + 64 * (j))
#define XB_XSUB(j)  (1280 + 64 * (j))
#define XB_XGEN(j)  (2304 + 64 * (j))
#define XB_TOP      3328
#define XB_TOPGEN   3392
#define XCD_BAR_WORDS 3456
#define XB_SPIN_CAP (1u << 18)

__device__ __forceinline__ unsigned xb_ld(unsigned* p)              { return __hip_atomic_load(p, __ATOMIC_RELAXED, __HIP_MEMORY_SCOPE_AGENT); }
__device__ __forceinline__ unsigned xb_add(unsigned* p, unsigned v) { return __hip_atomic_fetch_add(p, v, __ATOMIC_RELAXED, __HIP_MEMORY_SCOPE_AGENT); }
__device__ __forceinline__ unsigned xb_xcc_id() { return (unsigned)__builtin_amdgcn_s_getreg((3 << 11) | 20) & 0xFu; }
#define XB_SPIN(cond, bar) do { unsigned _sp = 0; while (cond) { __builtin_amdgcn_s_sleep(1); \
    if ((++_sp & 255u) == 0u) { if (xb_ld(&(bar)[XB_TMO])) break; if (_sp > XB_SPIN_CAP) { atomicAdd(&(bar)[XB_TMO], 1u); break; } } } } while (0)

struct XcdBarrier {
    unsigned* bar; unsigned x;
    volatile LAS unsigned* st;
};

__device__ __forceinline__ XcdBarrier xcd_barrier_post(unsigned* bar, volatile LAS unsigned* st) {
    XcdBarrier b; b.bar = bar; b.x = xb_xcc_id(); b.st = st;
    if (threadIdx.x == 0) (void)xb_add(&bar[XB_XCNT(b.x)], 1u);
    return b;
}
__device__ __forceinline__ void xcd_barrier_complete(unsigned* bar, unsigned x, unsigned& nloc, unsigned& nx) {
    const unsigned G = gridDim.x * gridDim.y * gridDim.z;
    unsigned sum, cnt, mine, sp = 0u;
    for (;;) {
        sum = 0u; cnt = 0u; mine = 0u;
#pragma unroll
        for (unsigned j = 0; j < 16; ++j) { const unsigned c = xb_ld(&bar[XB_XCNT(j)]); sum += c; cnt += (c > 0u) ? 1u : 0u; mine = (j == x) ? c : mine; }
        if (sum == G) break;
        __builtin_amdgcn_s_sleep(1);
        if ((++sp & 255u) == 0u) { if (xb_ld(&bar[XB_TMO])) break; if (sp > XB_SPIN_CAP) { atomicAdd(&bar[XB_TMO], 1u); break; } }
    }
    nloc = mine > 0u ? mine : 1u; nx = cnt > 0u ? cnt : 1u;
}

__device__ __forceinline__ void xcd_barrier(const XcdBarrier& b) {
    asm volatile("s_waitcnt vmcnt(0)" ::: "memory");
    __syncthreads();
    if (threadIdx.x == 0) {
        unsigned* bar = b.bar;
        __builtin_amdgcn_s_waitcnt(0);
        unsigned nloc = b.st[0], nx = b.st[1];
        if (nloc == 0u) { xcd_barrier_complete(bar, b.x, nloc, nx); b.st[0] = nloc; b.st[1] = nx; }
        const unsigned old = xb_add(&bar[XB_XSUB(b.x)], 1u);
        const unsigned gen = old / nloc;
        if (old + 1u == (gen + 1u) * nloc) {
            __builtin_amdgcn_fence(__ATOMIC_RELEASE, "agent");
            asm volatile("s_waitcnt vmcnt(0)" ::: "memory");
            const unsigned og = xb_add(&bar[XB_TOP], 1u);
            const unsigned tg = og / nx;
            if (og + 1u == (tg + 1u) * nx) xb_add(&bar[XB_TOPGEN], 1u);
            else XB_SPIN(xb_ld(&bar[XB_TOPGEN]) == tg, bar);
            __builtin_amdgcn_fence(__ATOMIC_ACQUIRE, "agent");
            xb_add(&bar[XB_XGEN(b.x)], 1u);
            asm volatile("s_waitcnt vmcnt(0)" ::: "memory");
        } else {
            XB_SPIN(xb_ld(&bar[XB_XGEN(b.x)]) == gen, bar);
            __builtin_amdgcn_fence(__ATOMIC_ACQUIRE, "agent");
            asm volatile("s_waitcnt vmcnt(0)" ::: "memory");
        }
    }
    __syncthreads();
}

typedef float f32x16 __attribute__((ext_vector_type(16)));
constexpr int NWAVES = 8, NTHREADS = 512;
constexpr int BATCH = 4, SEQ = 8192, DM = 1024, M = BATCH * SEQ, FF = 2816, NGU = 2 * FF, DIN = 2752, DINP = 2816, NGATE = 3072, DEPTH = 2;
constexpr float NORM_EPS = 1e-6f;
constexpr float QSCALE = 0.125f * 1.4426950408889634f;
constexpr int C_SBQ = 0, C_SBK = 256, C_SBV = 512, C_NQ = 768, C_NKC = 1280, C_NVC = 1408, C_NKS = 1536, C_NVS = 1664, C_NKW = 1792, C_NVW = 1920, C_DQ = 2048, C_DK = 2304, C_DV = 2368, C_IQ = 2432,
              C_IK = 2688, C_NG = 2720, C_IW = 2744;
__host__ __device__ constexpr int proj_col(int c) { return c < 2048 ? c : c < 2072 ? c + 672 : c < 2744 ? c - 24 : c; }
constexpr size_t MiB = 1u << 20;
constexpr size_t WS_CTL = 0, CTL_ZERO_BYTES = 1 * MiB;
constexpr size_t WS_TAB = 1 * MiB, TAB_CS_MAIN = 0, TAB_CS_IDX = 524288, TAB_CS_CMP = 786432, TAB_BIASPE = 819200;
constexpr size_t WS_W = 2 * MiB, WL_STRIDE = 50 * MiB;
constexpr size_t W_GU1 = 0, W_DN1 = 11534336, W_IN = 17301504, W_GATE = 23068672, W_BRA = 29360128, W_BRB = 29884416, W_BRC = 30932992, W_OUT = 31457280,
                 W_GU2 = 33554432, W_DN2 = 45088768, W_C1 = 50855936, W_C2 = 51904512, W_LEND = 51937280;
static_assert(W_LEND <= WL_STRIDE, "weights per layer");
constexpr size_t WS_XN = 102 * MiB;
constexpr size_t WS_R1 = 166 * MiB;
constexpr size_t WS_VT = WS_R1 + 176 * MiB;
constexpr size_t WS_OA = 358 * MiB, WS_OB = 374 * MiB, WS_OC = 406 * MiB;
constexpr size_t WS_KC = 422 * MiB, WS_VC = WS_KC + 524288;
constexpr size_t WS_SEL = 423 * MiB;
constexpr size_t WS_IDX = 424 * MiB;
constexpr size_t WS_IKC = 440 * MiB;
constexpr size_t WS_SS = 442 * MiB;
constexpr size_t WS_MG = 444 * MiB;
constexpr size_t WS_END = 508 * MiB;
constexpr int CW_KMAX = 64;
constexpr int CW_BAR = 4096;
constexpr int RING_BYTES = 131072;
constexpr int LDS_BYTES = 147456;
constexpr int MISC_OFF = LDS_BYTES - 256;

#define CAS __attribute__((address_space(4)))
#define HY_IN(F_, k_) ((const float*)(const GAS float*)(F_).kin[k_])
struct Frame {
    unsigned char* lds;
    int tid, lane, wave, G, bid;
    const CAS unsigned long long* kin; GAS float* out; GAS unsigned char* ws;
};
__device__ __forceinline__ Frame fr_fresh(unsigned char* lds, int wave_s) {
    Frame F; F.lds = lds;
    int wv = wave_s; asm volatile("" : "+s"(wv));
    int lane = (int)__builtin_amdgcn_mbcnt_hi(~0u, __builtin_amdgcn_mbcnt_lo(~0u, 0u)); asm volatile("" : "+v"(lane));
    F.lane = lane; F.wave = wv; F.tid = wv * 64 + lane;
    const CAS unsigned long long* kin = (const CAS unsigned long long*)__builtin_amdgcn_kernarg_segment_ptr(); asm volatile("" : "+s"(kin));
    F.kin = kin; F.out = (GAS float*)kin[21]; F.ws = (GAS unsigned char*)kin[22];
    int G = gridDim.x, bid = blockIdx.x; asm volatile("" : "+s"(G), "+s"(bid));
    F.G = G; F.bid = bid;
    return F;
}
template <int CTRL> __device__ __forceinline__ float dppf(float x) { return __builtin_bit_cast(float, __builtin_amdgcn_update_dpp(0, __builtin_bit_cast(int, x), CTRL, 0xf, 0xf, true)); }
template <int CTRL> __device__ __forceinline__ int dppi(int x) { return __builtin_amdgcn_update_dpp(0, x, CTRL, 0xf, 0xf, true); }
constexpr int DPP_X1 = 0xB1, DPP_X2 = 0x4E, DPP_ROR4 = 0x124, DPP_ROR8 = 0x128, DPP_SHL4 = 0x104, DPP_SHR4 = 0x114;
__device__ __forceinline__ float x16_other(float x, int lane) { auto r = __builtin_amdgcn_permlane16_swap(__float_as_uint(x), __float_as_uint(x), false, false); return __uint_as_float((lane & 16) ? r[0] : r[1]); }
__device__ __forceinline__ float x32_other(float x, int lane) { auto r = __builtin_amdgcn_permlane32_swap(__float_as_uint(x), __float_as_uint(x), false, false); return __uint_as_float((lane & 32) ? r[0] : r[1]); }
__device__ __forceinline__ float x16_sum(float x) { auto r = __builtin_amdgcn_permlane16_swap(__float_as_uint(x), __float_as_uint(x), false, false); return __uint_as_float(r[0]) + __uint_as_float(r[1]); }
__device__ __forceinline__ float x32_sum(float x) { auto r = __builtin_amdgcn_permlane32_swap(__float_as_uint(x), __float_as_uint(x), false, false); return __uint_as_float(r[0]) + __uint_as_float(r[1]); }
__device__ __forceinline__ float x16_max(float x) { auto r = __builtin_amdgcn_permlane16_swap(__float_as_uint(x), __float_as_uint(x), false, false); return fmaxf(__uint_as_float(r[0]), __uint_as_float(r[1])); }
__device__ __forceinline__ float x32_max(float x) { auto r = __builtin_amdgcn_permlane32_swap(__float_as_uint(x), __float_as_uint(x), false, false); return fmaxf(__uint_as_float(r[0]), __uint_as_float(r[1])); }
__device__ __forceinline__ float x16_min(float x) { auto r = __builtin_amdgcn_permlane16_swap(__float_as_uint(x), __float_as_uint(x), false, false); return fminf(__uint_as_float(r[0]), __uint_as_float(r[1])); }
__device__ __forceinline__ float x32_min(float x) { auto r = __builtin_amdgcn_permlane32_swap(__float_as_uint(x), __float_as_uint(x), false, false); return fminf(__uint_as_float(r[0]), __uint_as_float(r[1])); }
__device__ __forceinline__ float row16_sum(float v) { v += dppf<DPP_X1>(v); v += dppf<DPP_X2>(v); v += dppf<DPP_ROR4>(v); v += dppf<DPP_ROR8>(v); return v; }
__device__ __forceinline__ float wave_sum(float v) { return x32_sum(x16_sum(row16_sum(v))); }
__device__ __forceinline__ float wave_max(float v) { v = fmaxf(v, dppf<DPP_X1>(v)); v = fmaxf(v, dppf<DPP_X2>(v)); v = fmaxf(v, dppf<DPP_ROR4>(v)); v = fmaxf(v, dppf<DPP_ROR8>(v)); return x32_max(x16_max(v)); }
__device__ __forceinline__ float bf2f(unsigned short h) { return __uint_as_float((unsigned)h << 16); }
__device__ __forceinline__ float bflo(unsigned w) { return __uint_as_float(w << 16); }
__device__ __forceinline__ float bfhi(unsigned w) { return __uint_as_float(w & 0xffff0000u); }
__device__ __forceinline__ bf16* wl_ptr(const Frame& F, int l, size_t off) { return (bf16*)(F.ws + WS_W + (size_t)l * WL_STRIDE + off); }

__device__ __forceinline__ void transpose_item(const float* W, int K, int N, bf16* WT, int mode, float* scr, int item, int lane, const float* gain, int dpitch, int dkoff) {
    const int nblk = N / 32, kb = item / nblk, nb = item % nblk, k0 = 64 * kb, n0 = 32 * nb;
    int drow = n0;
    if (mode == 1) drow = (n0 < FF) ? (n0 / 128) * 256 + (n0 % 128) : ((n0 - FF) / 128) * 256 + 128 + ((n0 - FF) % 128);
    {
        const int n4 = (lane & 7) * 4; f32x4 wv[8]; float gv[8];
#pragma unroll
        for (int i = 0; i < 8; ++i) { const int kk = 8 * i + (lane >> 3); wv[i] = *(const f32x4*)(W + (size_t)(k0 + kk) * N + n0 + n4); gv[i] = gain ? gain[k0 + kk] : 1.0f; }
#pragma unroll
        for (int i = 0; i < 8; ++i) { const int kk = 8 * i + (lane >> 3); float* d = scr + kk * 33 + n4; d[0] = wv[i][0] * gv[i]; d[1] = wv[i][1] * gv[i]; d[2] = wv[i][2] * gv[i]; d[3] = wv[i][3] * gv[i]; } }
    LDS_WAIT(); asm volatile("" ::: "memory");
    const int c = lane & 7;
#pragma unroll
    for (int j = 0; j < 4; ++j) { const int n = (lane >> 3) + 8 * j; const float* s = scr + (8 * c) * 33 + n;
        v4u o; o.x = pk2(s[0 * 33], s[1 * 33]); o.y = pk2(s[2 * 33], s[3 * 33]); o.z = pk2(s[4 * 33], s[5 * 33]); o.w = pk2(s[6 * 33], s[7 * 33]);
        *(v4u*)(WT + (size_t)(mode == 2 ? proj_col(n0 + n) : drow + n) * dpitch + dkoff + k0 + 8 * c) = o; }
    LDS_WAIT(); asm volatile("" ::: "memory");
}
#define HY_TR(src, K_, N_, dst, mode, gain) do { const int items_ = ((K_) / 64) * ((N_) / 32); for (int it_ = gw; it_ < items_; it_ += NGW) transpose_item((src), (K_), (N_), (dst), (mode), scr, it_, F.lane, (gain), (K_), 0); } while (0)
#define HY_TRC(src, K_, N_, dst, dkoff_) do { const int items_ = ((K_) / 64) * ((N_) / 32); for (int it_ = gw; it_ < items_; it_ += NGW) transpose_item((src), (K_), (N_), (dst), 0, scr, it_, F.lane, nullptr, DM, (dkoff_)); } while (0)
__device__ __forceinline__ void p0_prologue(Frame& F) {
    float* scr = (float*)(F.lds + F.wave * 16384);
    const int gw = F.bid * NWAVES + F.wave, NGW = F.G * NWAVES;
    for (int l = 0; l < DEPTH; ++l) {
        HY_TR(HY_IN(F, 2) + (size_t)l * DM * NGU, DM, NGU, wl_ptr(F, l, W_GU1), 1, HY_IN(F, 1) + (size_t)l * DM);
        HY_TR(HY_IN(F, 3) + (size_t)l * FF * DM, FF, DM, wl_ptr(F, l, W_DN1), 0, nullptr);
        HY_TR(HY_IN(F, 5) + (size_t)l * DM * DIN, DM, DIN, wl_ptr(F, l, W_IN), 2, HY_IN(F, 4) + (size_t)l * DM);
        HY_TR(HY_IN(F, 6) + (size_t)l * DM * NGATE, DM, NGATE, wl_ptr(F, l, W_GATE), 0, HY_IN(F, 4) + (size_t)l * DM);
        HY_TRC(HY_IN(F, 14) + (size_t)l * 256 * DM, 256, DM, wl_ptr(F, l, W_BRA), 0);
        HY_TRC(HY_IN(F, 15) + (size_t)l * 512 * DM, 512, DM, wl_ptr(F, l, W_BRA), 256);
        HY_TRC(HY_IN(F, 16) + (size_t)l * 256 * DM, 256, DM, wl_ptr(F, l, W_BRA), 768);
        HY_TR(HY_IN(F, 17) + (size_t)l * DM * DM, DM, DM, wl_ptr(F, l, W_OUT), 0, nullptr);
        HY_TR(HY_IN(F, 19) + (size_t)l * DM * NGU, DM, NGU, wl_ptr(F, l, W_GU2), 1, HY_IN(F, 18) + (size_t)l * DM);
        HY_TR(HY_IN(F, 20) + (size_t)l * FF * DM, FF, DM, wl_ptr(F, l, W_DN2), 0, nullptr);
        for (int kv = 0; kv < 2; ++kv) {
            HY_TR(HY_IN(F, 10) + ((size_t)l * 2 + kv) * 2048 * 128, 2048, 128, wl_ptr(F, l, W_C1) + (size_t)kv * 128 * 2048, 0, nullptr);
            HY_TR(HY_IN(F, 11) + ((size_t)l * 2 + kv) * 128 * 64, 128, 64, wl_ptr(F, l, W_C2) + (size_t)kv * 64 * 128, 0, nullptr);
        }
        { v4u* z = (v4u*)(wl_ptr(F, l, W_IN) + (size_t)DIN * DM); const int n16 = (DINP - DIN) * DM * 2 / 16;
          for (int i = (F.bid * NTHREADS + F.tid); i < n16; i += F.G * NTHREADS) z[i] = (v4u){0u, 0u, 0u, 0u}; }
    }
    { unsigned long long* SS = (unsigned long long*)(F.ws + WS_SS); bf16* XN = (bf16*)(F.ws + WS_XN); const float* X = HY_IN(F, 0);
      for (int i = F.bid * NTHREADS + F.tid; i < (DEPTH * 3 - 1) * M; i += F.G * NTHREADS) SS[M + i] = 0ull;
      for (int m = gw; m < M; m += NGW) { const f32x4* xr = (const f32x4*)(X + (size_t)m * DM) + F.lane; f32x4 v[4]; float s = 0.f;
#pragma unroll
          for (int j = 0; j < 4; ++j) { v[j] = xr[64 * j]; s += (v[j].x * v[j].x + v[j].y * v[j].y) + (v[j].z * v[j].z + v[j].w * v[j].w); }
          s = wave_sum(s); if (F.lane == 0) SS[m] = (unsigned long long)(s * 1048576.0f);
          unsigned long long* o8 = (unsigned long long*)(XN + (size_t)m * DM) + F.lane;
#pragma unroll
          for (int j = 0; j < 4; ++j) o8[64 * j] = (unsigned long long)pk2(v[j].x, v[j].y) | ((unsigned long long)pk2(v[j].z, v[j].w) << 32); } }
    { float* tm = (float*)(F.ws + WS_TAB + TAB_CS_MAIN); float* ti = (float*)(F.ws + WS_TAB + TAB_CS_IDX); float* tc = (float*)(F.ws + WS_TAB + TAB_CS_CMP);
      const int gt = F.bid * NTHREADS + F.tid, NGT = F.G * NTHREADS;
      for (int e = gt; e < SEQ * 8; e += NGT) { const int t = e >> 3, i = e & 7; const float inv = (float)pow(500000.0, -(double)i / 8.0); const float ang = (float)t * inv;
          tm[2 * e] = (float)cos((double)ang); tm[2 * e + 1] = (float)sin((double)ang); }
      for (int e = gt; e < SEQ * 4; e += NGT) { const int t = e >> 2, i = e & 3; const float inv = (float)pow(500000.0, -(double)i / 4.0); const float ang = (float)t * inv;
          ti[2 * e] = (float)cos((double)ang); ti[2 * e + 1] = (float)sin((double)ang); }
      for (int e = gt; e < 512 * 8; e += NGT) { const int c = e >> 3, i = e & 7; const float inv = (float)pow(500000.0, -(double)i / 8.0); const float ang = (float)(16 * c + 31) * inv;
          tc[2 * e] = (float)cos((double)ang); tc[2 * e + 1] = (float)sin((double)ang); }
    }
    { float* bp = (float*)(F.ws + WS_TAB + TAB_BIASPE);
      for (int o = gw; o < DEPTH * 2 * 128; o += NGW) { const int lk = o >> 7, n = o & 127; const float* pe = HY_IN(F, 9) + (size_t)lk * 2048; const float* w1 = HY_IN(F, 10) + (size_t)lk * 2048 * 128;
          float s = 0.f; for (int k = F.lane; k < 2048; k += 64) s += pe[k] * w1[(size_t)k * 128 + n];
          s = wave_sum(s); if (F.lane == 0) bp[o] = s; } }
}
__device__ __forceinline__ void norm_phase(Frame& F, const float* X, const float* g, bf16* XN) {
    const int gw = F.bid * NWAVES + F.wave, NGW = F.G * NWAVES;
    f32x4 gv[4];
#pragma unroll
    for (int j = 0; j < 4; ++j) gv[j] = ((const f32x4*)g)[F.lane + 64 * j];
    for (int m = gw; m < M; m += NGW) {
        const f32x4* xr = (const f32x4*)(X + (size_t)m * DM) + F.lane;
        f32x4 v[4]; float s = 0.f;
#pragma unroll
        for (int j = 0; j < 4; ++j) { v[j] = xr[64 * j]; s += (v[j].x * v[j].x + v[j].y * v[j].y) + (v[j].z * v[j].z + v[j].w * v[j].w); }
        const float rstd = rsqrtf(wave_sum(s) * (1.f / DM) + NORM_EPS);
        unsigned long long* o8 = (unsigned long long*)(XN + (size_t)m * DM) + F.lane;
#pragma unroll
        for (int j = 0; j < 4; ++j) o8[64 * j] = (unsigned long long)pk2(v[j].x * rstd * gv[j].x, v[j].y * rstd * gv[j].y) | ((unsigned long long)pk2(v[j].z * rstd * gv[j].z, v[j].w * rstd * gv[j].w) << 32);
    }
}

__device__ __forceinline__ void prep_phase(Frame& F, int l) {
    const int gw = F.bid * NWAVES + F.wave, NGW = F.G * NWAVES, lane = F.lane;
    bf16* PROJ = (bf16*)(F.ws + WS_R1);
    const float* cs_main = (const float*)(F.ws + WS_TAB + TAB_CS_MAIN); const float* cs_idx = (const float*)(F.ws + WS_TAB + TAB_CS_IDX);
    const float g_nq = HY_IN(F, 7)[l * 64 + lane], g_ks = HY_IN(F, 8)[(l * 3 + 1) * 64 + lane], g_kw = HY_IN(F, 8)[(l * 3 + 2) * 64 + lane], g_dq = HY_IN(F, 12)[l * 64 + lane], g_dk = HY_IN(F, 13)[l * 64 + lane];
    unsigned kmx = 0u;
    float nxv[17], nxiq, nxik, nrc, nrs, nic, nis; bf16 nraw;
#define HY_PREP_LOAD(mm_) do { const int t_ = (mm_) & (SEQ - 1); const bf16* p_ = PROJ + (size_t)(mm_) * DINP; const int ri_ = lane & 7, i4_ = lane & 3; \
        nrc = cs_main[(t_ * 8 + ri_) * 2]; nrs = cs_main[(t_ * 8 + ri_) * 2 + 1]; nic = cs_idx[(t_ * 4 + i4_) * 2]; nis = cs_idx[(t_ * 4 + i4_) * 2 + 1]; \
        nxiq = bf2f(p_[C_IQ + 32 * (lane >> 3) + (lane & 7)]); nxik = bf2f(p_[C_IK + (lane & 7)]); nraw = p_[C_IK + (lane & 31)]; \
        _Pragma("unroll") for (int v = 0; v < 17; ++v) { const int col = (v < 8) ? C_NQ + 64 * v : (v < 10) ? C_NKS + 64 * (v - 8) : (v < 12) ? C_NKW + 64 * (v - 10) : (v < 16) ? C_DQ + 64 * (v - 12) : C_DK; \
            nxv[v] = bf2f(p_[col + lane]); } } while (0)
    HY_PREP_LOAD(gw);
    for (int m = gw; m < M; m += NGW) {
        bf16* p = PROJ + (size_t)m * DINP;
        const float rc = nrc, rs = nrs, xiq = nxiq, xik = nxik, ic = nic, is = nis; const bf16 xik_raw = nraw; kmx = max(kmx, ((unsigned)xik_raw & 0x7fffu) << 16);
        float xv[17];
#pragma unroll
        for (int v = 0; v < 17; ++v) xv[v] = nxv[v];
        if (m + NGW < M) HY_PREP_LOAD(m + NGW);
#pragma unroll
        for (int v = 0; v < 17; ++v) { const int col = (v < 8) ? C_NQ + 64 * v : (v < 10) ? C_NKS + 64 * (v - 8) : (v < 12) ? C_NKW + 64 * (v - 10) : (v < 16) ? C_DQ + 64 * (v - 12) : C_DK;
            const float gain = (v < 8) ? g_nq : (v < 10) ? g_ks : (v < 12) ? g_kw : (v < 16) ? g_dq : g_dk, post = (v < 8 || (v >= 12 && v < 16)) ? QSCALE : 1.f;
            const float x = xv[v];
            const float ss = wave_sum(x * x);
            float y = x * rsqrtf(ss * (1.f / 64.f) + NORM_EPS) * gain;
            const float pr = dppf<DPP_ROR8>(y);
            if (lane < 8) y = y * rc - pr * rs; else if (lane < 16) y = y * rc + pr * rs;
            p[col + lane] = (bf16)f2bf(y * post);
        }
        { const int hh = lane >> 3, dd = lane & 7; const float c = ic, s = is;
          const float x = xiq; const float pr = __shfl_xor(x, 4);
          const float y = (dd < 4) ? x * c - pr * s : x * c + pr * s; p[C_IQ + 32 * hh + dd] = (bf16)f2bf(y);
          const float xk = xik; const float prk = __shfl_xor(xk, 4);
          const float yk = (dd < 4) ? xk * c - prk * s : xk * c + prk * s;
          bf16* ikc = (bf16*)(F.ws + WS_IKC) + (size_t)m * 32;
          if (lane < 8) ikc[lane] = (bf16)f2bf(yk); else if (lane < 32) ikc[lane] = xik_raw; }
    }
#undef HY_PREP_LOAD
    { const float km = wave_max(__uint_as_float(kmx)); if (lane == 0) atomicMax((unsigned*)(F.ws + WS_CTL) + CW_KMAX + l, __float_as_uint(km)); }
}


#define MFMA16(a, b, c) __builtin_amdgcn_mfma_f32_16x16x32_bf16((a), (b), (c), 0, 0, 0)
#define MFMA32(a, b, c) __builtin_amdgcn_mfma_f32_32x32x16_bf16((a), (b), (c), 0, 0, 0)
__device__ __forceinline__ void cmp_phase(Frame& F, int l) {
    const int lane = F.lane, wave = F.wave, r = lane & 15, q = lane >> 4, kq = wave & 3, wg = wave >> 2;
    const bf16* PROJ = (const bf16*)(F.ws + WS_R1); bf16* KC = (bf16*)(F.ws + WS_KC); bf16* VC = (bf16*)(F.ws + WS_VC);
    const bf16* W1 = wl_ptr(F, l, W_C1); const bf16* W2 = wl_ptr(F, l, W_C2);
    const float* bp = (const float*)(F.ws + WS_TAB + TAB_BIASPE) + l * 256; const float* cs_cmp = (const float*)(F.ws + WS_TAB + TAB_CS_CMP);
    const float* kn0 = HY_IN(F, 8) + (size_t)(l * 3 + 0) * 64;
    float* Pw = (float*)(F.lds + wave * 8192);
    bf16* Hs = (bf16*)(F.lds + 65536 + wg * 8192);
    const int niter = (512 + 2 * F.G - 1) / (2 * F.G);
    for (int it = 0; it < niter; ++it) {
        const int task = it * 2 * F.G + F.bid * 2 + wg; const bool live = task < 512;
        const int kv = (task >> 8) & 1, rem = task & 255, bg = rem >> 5, ct = rem & 31, b = bg >> 1, g = bg & 1;
        f32x4 acc[8];
#pragma unroll
        for (int nt = 0; nt < 8; ++nt) acc[nt] = (f32x4){0.f, 0.f, 0.f, 0.f};
        if (live) {
            int c_r = 16 * ct + r; if (c_r > 510) c_r = 510;
            const bf16* arow = PROJ + ((size_t)b * SEQ + 16 * c_r) * DINP + (kv ? C_NVC : C_NKC) + g * 64 + 8 * q;
            const bf16* w1 = W1 + (size_t)kv * 128 * 2048 + (size_t)r * 2048 + 8 * q;
#pragma unroll 4
            for (int k4 = 0; k4 < 16; ++k4) { const int ks = 16 * kq + k4;
                const bf16x8 a = *(const bf16x8*)(arow + (size_t)(ks >> 1) * DINP + (ks & 1) * 32);
#pragma unroll
                for (int nt = 0; nt < 8; ++nt) { const bf16x8 bb = *(const bf16x8*)(w1 + (size_t)nt * 16 * 2048 + 32 * ks); acc[nt] = MFMA16(a, bb, acc[nt]); }
            }
        }
#pragma unroll
        for (int nt = 0; nt < 8; ++nt)
#pragma unroll
            for (int e = 0; e < 4; ++e) Pw[(4 * q + e) * 128 + 16 * nt + r] = acc[nt][e];
        __syncthreads();
        if (live && kq == 0) {
#pragma unroll
            for (int nt = 0; nt < 8; ++nt)
#pragma unroll
                for (int e = 0; e < 4; ++e) { const float* pp = Pw + (4 * q + e) * 128 + 16 * nt + r; acc[nt][e] = (pp[0] + pp[2048]) + (pp[4096] + pp[6144]); }
#pragma unroll
            for (int nt = 0; nt < 8; ++nt) { const float bias = bp[kv * 128 + 16 * nt + r];
#pragma unroll
                for (int e = 0; e < 4; ++e) Hs[(4 * q + e) * 136 + 16 * nt + r] = (bf16)f2bf(pg8::silu_f(acc[nt][e] + bias)); }
            LDS_WAIT(); asm volatile("" ::: "memory");
            f32x4 acc2[4];
#pragma unroll
            for (int n2 = 0; n2 < 4; ++n2) acc2[n2] = (f32x4){0.f, 0.f, 0.f, 0.f};
#pragma unroll
            for (int s = 0; s < 4; ++s) { const bf16x8 a = *(const bf16x8*)(Hs + r * 136 + 32 * s + 8 * q);
#pragma unroll
                for (int n2 = 0; n2 < 4; ++n2) { const bf16x8 bb = *(const bf16x8*)(W2 + (size_t)kv * 64 * 128 + (size_t)(16 * n2 + r) * 128 + 32 * s + 8 * q); acc2[n2] = MFMA16(a, bb, acc2[n2]); } }
            LDS_WAIT(); asm volatile("" ::: "memory");
            bf16* dst = kv ? VC : KC;
#pragma unroll
            for (int e = 0; e < 4; ++e) {
                const int c = 16 * ct + 4 * q + e;
                float y[4];
#pragma unroll
                for (int n2 = 0; n2 < 4; ++n2) y[n2] = acc2[n2][e];
                if (kv == 0) {
                    float ss = (y[0] * y[0] + y[1] * y[1]) + (y[2] * y[2] + y[3] * y[3]);
                    ss = row16_sum(ss);
                    const float rstd = rsqrtf(ss * (1.f / 64.f) + NORM_EPS);
#pragma unroll
                    for (int n2 = 0; n2 < 4; ++n2) y[n2] = y[n2] * rstd * kn0[16 * n2 + r];
                    const float pr = dppf<DPP_ROR8>(y[0]); const int ri = r & 7; const float cc = cs_cmp[(c * 8 + ri) * 2], sn = cs_cmp[(c * 8 + ri) * 2 + 1];
                    y[0] = (r < 8) ? y[0] * cc - pr * sn : y[0] * cc + pr * sn;
                }
#pragma unroll
                for (int n2 = 0; n2 < 4; ++n2) { const bf16 val = (c == 511) ? (bf16)0 : (bf16)f2bf(y[n2]);
                    if (kv == 0) dst[((size_t)bg * 512 + c) * 64 + 16 * n2 + r] = val;
                    else { const int pc = (c & ~12) | (((c >> 2) & 1) << 3) | (((c >> 3) & 1) << 2); dst[((size_t)bg * 64 + 16 * n2 + r) * 512 + pc] = val; } }
            }
        }
        __syncthreads();
    }
}

__device__ __forceinline__ void nsa_unit(int u, int& bg, int& tile) {
    const int i = u >> 8, v = u & 255, j = v & 31; bg = v >> 5;
    tile = (i == 0) ? j : (i == 1) ? 63 - j : (i == 2) ? 64 + j : 127 - j;
}
__device__ __forceinline__ bf16x8 pack8(const f32x16& p, int base) {
    v4u w; w.x = pg8::cvtpk_s(p[base], p[base + 1]); w.y = pg8::cvtpk_s(p[base + 2], p[base + 3]); w.z = pg8::cvtpk_s(p[base + 4], p[base + 5]); w.w = pg8::cvtpk_s(p[base + 6], p[base + 7]);
    return __builtin_bit_cast(bf16x8, w);
}
__device__ __forceinline__ unsigned fkey(float f) { const unsigned u = __float_as_uint(f); return (u & 0x80000000u) ? ~u : (u | 0x80000000u); }
__device__ __forceinline__ void nsa1_phase(Frame& F, int l) {
    const int lane = F.lane, wave = F.wave, r = lane & 31, hf = lane >> 5, hh = r >> 3, tk = r & 7;
    const bf16* PROJ = (const bf16*)(F.ws + WS_R1); const bf16* KCg = (const bf16*)(F.ws + WS_KC); const bf16* VCt = (const bf16*)(F.ws + WS_VC);
    bf16* OB = (bf16*)(F.ws + WS_OA) + 256; unsigned long long* SEL = (unsigned long long*)(F.ws + WS_SEL);
    float* IMP = (float*)(F.lds + wave * 16512);
    float* INV = IMP + 4096;
    const float Bcmp = 11.66f * wave_max(fabsf(HY_IN(F, 7)[l * 64 + lane])) * wave_max(fabsf(HY_IN(F, 8)[(l * 3 + 0) * 64 + lane]));
    const bool fixed_ref = Bcmp < 60.f;
    for (int u = F.bid; u < 1024; u += F.G) {
        int bg, tile; nsa_unit(u, bg, tile); const int b = bg >> 1, g = bg & 1, t0 = tile * 64 + 8 * wave;
        const int t = t0 + tk; const size_t m = (size_t)b * SEQ + t;
        bf16x8 qf[4];
#pragma unroll
        for (int s = 0; s < 4; ++s) qf[s] = *(const bf16x8*)(PROJ + m * DINP + C_NQ + (4 * g + hh) * 64 + 16 * s + 8 * hf);
        const int nv = (t >= 31) ? ((t - 31) >> 4) + 1 : 0;
        const int tl = t0 + 7; const int nvw = (tl >= 31) ? ((tl - 31) >> 4) + 1 : 0, nkt = (nvw + 31) >> 5;
        if (!fixed_ref) {
#pragma unroll
            for (int i = 0; i < 16; ++i) IMP[64 * i + lane] = 0.f; }
        const bf16* kb = KCg + (size_t)bg * 512 * 64 + r * 64 + 8 * hf;
        const bf16* vb = VCt + (size_t)bg * 64 * 512 + (size_t)r * 512 + 8 * hf;
        f32x16 o0, o1;
#pragma unroll
        for (int i = 0; i < 16; ++i) { o0[i] = 0.f; o1[i] = 0.f; }
        float inv;
        if (fixed_ref) {
            float lsum = 0.f, prevlast = 0.f;
#define HY_GLD1(dst_, ptr_) asm volatile("global_load_dwordx4 %0, %1, off" : "=v"(dst_) : "v"(ptr_) : "memory")
#define HY_VMW1(x_) asm volatile("s_waitcnt vmcnt(7)" : "+v"(x_) :: "memory")
#define HY_VADDR(kt_, j_) (vb + (((j_) >> 1) ? 32 * 512 : 0) + 32 * (kt_) + (((j_) & 1) ? 16 : 0))
            asm volatile("s_waitcnt vmcnt(0)" : "+v"(qf[0]), "+v"(qf[1]), "+v"(qf[2]), "+v"(qf[3]) :: "memory");
            bf16x8 ka[4], va[4];
#pragma unroll
            for (int s = 0; s < 4; ++s) { const bf16* pp = kb + 16 * s; HY_GLD1(ka[s], pp); }
#pragma unroll
            for (int j = 0; j < 4; ++j) { const bf16* pp = HY_VADDR(0, j); HY_GLD1(va[j], pp); }
            float* impw = IMP + (tk * 4 + hh) * 128 + hf;
#pragma unroll 1
            for (int kt = 0; kt < nkt; ++kt) {
                const int ktn = (kt + 1 < nkt) ? kt + 1 : kt;
                f32x16 sT;
#pragma unroll
                for (int i = 0; i < 16; ++i) sT[i] = -Bcmp;
#pragma unroll
                for (int s = 0; s < 4; ++s) { HY_VMW1(ka[s]); sT = MFMA32(ka[s], qf[s], sT); const bf16* pp = kb + (size_t)ktn * 2048 + 16 * s; HY_GLD1(ka[s], pp); }
                float ps = 0.f;
#pragma unroll
                for (int i = 0; i < 16; ++i) { const int c = 32 * kt + (i & 3) + 8 * (i >> 2) + 4 * hf; sT[i] = (c < nv) ? __builtin_amdgcn_exp2f(sT[i]) : 0.f; ps += sT[i]; }
                lsum += ps;
                float I[4], pl[4];
#pragma unroll
                for (int k = 0; k < 4; ++k) { I[k] = (sT[4 * k] + sT[4 * k + 1]) + (sT[4 * k + 2] + sT[4 * k + 3]); pl[k] = x32_other(sT[4 * k + 3], lane); }
                I[0] += hf ? pl[0] : prevlast; I[1] += hf ? pl[1] : pl[0]; I[2] += hf ? pl[2] : pl[1]; I[3] += hf ? pl[3] : pl[2];
                prevlast = pl[3];
#pragma unroll
                for (int k = 0; k < 4; ++k) impw[8 * kt + 2 * k] = I[k];
                const bf16x8 pf0 = pack8(sT, 0), pf1 = pack8(sT, 8);
                { HY_VMW1(va[0]); o0 = MFMA32(va[0], pf0, o0); const bf16* p0_ = HY_VADDR(ktn, 0); HY_GLD1(va[0], p0_); }
                { HY_VMW1(va[1]); o0 = MFMA32(va[1], pf1, o0); const bf16* p1_ = HY_VADDR(ktn, 1); HY_GLD1(va[1], p1_); }
                { HY_VMW1(va[2]); o1 = MFMA32(va[2], pf0, o1); const bf16* p2_ = HY_VADDR(ktn, 2); HY_GLD1(va[2], p2_); }
                { HY_VMW1(va[3]); o1 = MFMA32(va[3], pf1, o1); const bf16* p3_ = HY_VADDR(ktn, 3); HY_GLD1(va[3], p3_); }
            }
            asm volatile("s_waitcnt vmcnt(0)" : "+v"(ka[0]), "+v"(ka[1]), "+v"(ka[2]), "+v"(ka[3]), "+v"(va[0]), "+v"(va[1]), "+v"(va[2]), "+v"(va[3]) :: "memory");
#undef HY_GLD1
#undef HY_VMW1
#undef HY_VADDR
            const float lt = x32_sum(lsum); inv = (nv > 0) ? 1.f / lt : 0.f;
            if (hf == 0) INV[tk * 4 + hh] = inv;
#pragma unroll
            for (int i = 0; i < 16; ++i) { o0[i] *= inv; o1[i] *= inv; }
        } else {
        float mrun = -1e30f, lrun = 0.f;
        bf16x8 ka[4];
#pragma unroll
        for (int s = 0; s < 4; ++s) ka[s] = *(const bf16x8*)(kb + 16 * s);
#pragma unroll 1
        for (int kt = 0; kt < nkt; ++kt) {
            bf16x8 kn[4];
            const int ktn = (kt + 1 < nkt) ? kt + 1 : kt;
#pragma unroll
            for (int s = 0; s < 4; ++s) kn[s] = *(const bf16x8*)(kb + (size_t)ktn * 2048 + 16 * s);
            f32x16 sT;
#pragma unroll
            for (int i = 0; i < 16; ++i) sT[i] = 0.f;
#pragma unroll
            for (int s = 0; s < 4; ++s) sT = MFMA32(ka[s], qf[s], sT);
            float mx = -1e30f;
#pragma unroll
            for (int i = 0; i < 16; ++i) { const int c = 32 * kt + (i & 3) + 8 * (i >> 2) + 4 * hf; sT[i] = (c < nv) ? sT[i] : -1e30f; mx = fmaxf(mx, sT[i]); }
            const float mn = fmaxf(mrun, mx); float ps = 0.f;
#pragma unroll
            for (int i = 0; i < 16; ++i) ps += (sT[i] > -1e29f) ? __builtin_amdgcn_exp2f(sT[i] - mn) : 0.f;
            lrun = lrun * __builtin_amdgcn_exp2f(mrun - mn) + ps; mrun = mn;
#pragma unroll
            for (int s = 0; s < 4; ++s) ka[s] = kn[s];
        }
        float mf;
        { const float mo = x32_other(mrun, lane), lo_ = x32_other(lrun, lane); mf = fmaxf(mrun, mo);
          const float lf = lrun * __builtin_amdgcn_exp2f(mrun - mf) + lo_ * __builtin_amdgcn_exp2f(mo - mf); inv = (nv > 0) ? 1.f / lf : 0.f; }
        float prevlast = 0.f;
        bf16x8 va[4];
#pragma unroll
        for (int s = 0; s < 4; ++s) ka[s] = *(const bf16x8*)(kb + 16 * s);
        va[0] = *(const bf16x8*)(vb); va[1] = *(const bf16x8*)(vb + 16); va[2] = *(const bf16x8*)(vb + 32 * 512); va[3] = *(const bf16x8*)(vb + 32 * 512 + 16);
#pragma unroll 1
        for (int kt = 0; kt < nkt; ++kt) {
            bf16x8 kn[4], vn[4];
            const int ktn = (kt + 1 < nkt) ? kt + 1 : kt;
#pragma unroll
            for (int s = 0; s < 4; ++s) kn[s] = *(const bf16x8*)(kb + (size_t)ktn * 2048 + 16 * s);
            vn[0] = *(const bf16x8*)(vb + 32 * ktn); vn[1] = *(const bf16x8*)(vb + 32 * ktn + 16); vn[2] = *(const bf16x8*)(vb + 32 * 512 + 32 * ktn); vn[3] = *(const bf16x8*)(vb + 32 * 512 + 32 * ktn + 16);
            f32x16 sT;
#pragma unroll
            for (int i = 0; i < 16; ++i) sT[i] = 0.f;
#pragma unroll
            for (int s = 0; s < 4; ++s) sT = MFMA32(ka[s], qf[s], sT);
#pragma unroll
            for (int i = 0; i < 16; ++i) { const int c = 32 * kt + (i & 3) + 8 * (i >> 2) + 4 * hf; sT[i] = (c < nv) ? __builtin_amdgcn_exp2f(sT[i] - mf) * inv : 0.f; }
            float I[4], pl[4];
#pragma unroll
            for (int k = 0; k < 4; ++k) { I[k] = (sT[4 * k] + sT[4 * k + 1]) + (sT[4 * k + 2] + sT[4 * k + 3]); pl[k] = x32_other(sT[4 * k + 3], lane); }
            I[0] += hf ? pl[0] : prevlast; I[1] += hf ? pl[1] : pl[0]; I[2] += hf ? pl[2] : pl[1]; I[3] += hf ? pl[3] : pl[2];
            prevlast = pl[3];
#pragma unroll
            for (int k = 0; k < 4; ++k) { I[k] += dppf<DPP_ROR8>(I[k]); I[k] = x16_sum(I[k]); }
            if (hh == 0) {
#pragma unroll
                for (int k = 0; k < 4; ++k) IMP[tk * 128 + 8 * kt + 2 * k + hf] = I[k]; }
            const bf16x8 pf0 = pack8(sT, 0), pf1 = pack8(sT, 8);
            o0 = MFMA32(va[0], pf0, o0); o0 = MFMA32(va[1], pf1, o0); o1 = MFMA32(va[2], pf0, o1); o1 = MFMA32(va[3], pf1, o1);
#pragma unroll
            for (int s = 0; s < 4; ++s) { ka[s] = kn[s]; va[s] = vn[s]; }
        }
        }
        { const float g0 = pg8::sigm_f(bf2f(PROJ[m * DINP + C_NG + (4 * g + hh) * 3 + 0]));
          bf16* op = OB + m * 1024 + (4 * g + hh) * 64;
#pragma unroll
          for (int i = 0; i < 16; ++i) { const int d = (i & 3) + 8 * (i >> 2) + 4 * hf; op[d] = (bf16)f2bf(g0 * o0[i]); op[32 + d] = (bf16)f2bf(g0 * o1[i]); } }
        LDS_WAIT(); asm volatile("" ::: "memory");
#define HY_TOPK_KEYS(t2k_, u0_, u1_) do { const int t2_ = t0 + (t2k_), cur_ = t2_ >> 6, n0_ = lane, n1_ = lane + 64; float i0_, i1_; \
            if (fixed_ref) { i0_ = 0.f; i1_ = 0.f; \
                if (n0_ < 8 * nkt) { _Pragma("unroll") for (int h4 = 0; h4 < 4; ++h4) i0_ += IMP[((t2k_) * 4 + h4) * 128 + n0_] * INV[(t2k_) * 4 + h4]; } \
                if (n1_ < 8 * nkt) { _Pragma("unroll") for (int h4 = 0; h4 < 4; ++h4) i1_ += IMP[((t2k_) * 4 + h4) * 128 + n1_] * INV[(t2k_) * 4 + h4]; } \
            } else { i0_ = IMP[(t2k_) * 128 + n0_]; i1_ = IMP[(t2k_) * 128 + n1_]; } \
            const bool f0_ = (n0_ == 0) || (n0_ == cur_) || (n0_ == cur_ - 1), f1_ = (n1_ == cur_) || (n1_ == cur_ - 1); \
            const float sc0_ = (n0_ * 64 <= t2_) ? (f0_ ? 1.0e4f : i0_) : -INFINITY, sc1_ = (n1_ * 64 <= t2_) ? (f1_ ? 1.0e4f : i1_) : -INFINITY; \
            u0_ = fkey(sc0_); u1_ = fkey(sc1_); } while (0)
#define HY_TOPK_EMIT(t2k_, u0_, u1_, tau_) do { const int t2_ = t0 + (t2k_); \
            const int cgt_ = __popcll(__ballot(u0_ > tau_)) + __popcll(__ballot(u1_ > tau_)), need_ = 16 - cgt_; \
            const unsigned long long e0_ = __ballot(u0_ == tau_), e1_ = __ballot(u1_ == tau_); \
            const int pre0_ = (int)__builtin_amdgcn_mbcnt_hi((unsigned)(e0_ >> 32), __builtin_amdgcn_mbcnt_lo((unsigned)e0_, 0u)); \
            const int pre1_ = (int)__builtin_amdgcn_mbcnt_hi((unsigned)(e1_ >> 32), __builtin_amdgcn_mbcnt_lo((unsigned)e1_, 0u)) + __popcll(e0_); \
            const unsigned long long m0_ = __ballot((u0_ > tau_) || (u0_ == tau_ && pre0_ < need_)), m1_ = __ballot((u1_ > tau_) || (u1_ == tau_ && pre1_ < need_)); \
            if (lane == 0) { SEL[((size_t)bg * SEQ + t2_) * 2] = m0_; SEL[((size_t)bg * SEQ + t2_) * 2 + 1] = m1_; } } while (0)
        {   unsigned u0[8], u1[8], pf[8];
#pragma unroll
            for (int k = 0; k < 8; ++k) { HY_TOPK_KEYS(k, u0[k], u1[k]); pf[k] = 0u; }
#pragma unroll 1
            for (int bit = 31; bit >= 0; --bit) {
#pragma unroll
                for (int k = 0; k < 8; ++k) { const unsigned c = pf[k] | (1u << bit); const int n = __popcll(__ballot(u0[k] >= c)) + __popcll(__ballot(u1[k] >= c)); if (n >= 16) pf[k] = c; } }
#pragma unroll
            for (int k = 0; k < 8; ++k) HY_TOPK_EMIT(k, u0[k], u1[k], pf[k]);
        }
#undef HY_TOPK_KEYS
#undef HY_TOPK_EMIT
        LDS_WAIT(); asm volatile("" ::: "memory");
    }
}

__device__ __forceinline__ void vt_build(Frame& F) {
    const int gw = F.bid * NWAVES + F.wave, NGW = F.G * NWAVES, lane = F.lane;
    const bf16* PROJ = (const bf16*)(F.ws + WS_R1); bf16* VT = (bf16*)(F.ws + WS_VT);
    const int spk = (lane & ~12) | (((lane >> 2) & 1) << 3) | (((lane >> 3) & 1) << 2);
    for (int it = gw; it < 2048; it += NGW) {
        const int tile = it & 127, br = (it >> 7) & 1, bg = it >> 8, b = bg >> 1, g = bg & 1;
        const bf16* src = PROJ + ((size_t)b * SEQ + (size_t)tile * 64 + lane) * DINP + (br ? C_NVW : C_NVS) + 64 * g;
        uint4 v[8];
#pragma unroll
        for (int c = 0; c < 8; ++c) v[c] = *(const uint4*)(src + 8 * c);
        bf16* dst = VT + (size_t)it * 4096 + spk;
#pragma unroll
        for (int c = 0; c < 8; ++c) { bf16* d_ = dst + (8 * c) * 64;
            d_[0] = (bf16)(v[c].x & 0xffffu); d_[64] = (bf16)(v[c].x >> 16); d_[128] = (bf16)(v[c].y & 0xffffu); d_[192] = (bf16)(v[c].y >> 16);
            d_[256] = (bf16)(v[c].z & 0xffffu); d_[320] = (bf16)(v[c].z >> 16); d_[384] = (bf16)(v[c].w & 0xffffu); d_[448] = (bf16)(v[c].w >> 16); }
    }
}
#define HY_SWZ(r_, hf_, s_) (((2 * (s_) + (hf_)) ^ (((r_) >> 1) & 7)) * 8)
struct FlashState { float m, l; f32x16 o0, o1; };
__device__ __forceinline__ void flash_tile(const bf16* Kt, const bf16* Vt, const bf16x8 (&qf)[4], FlashState& st, int r, int hf, int key0, int t, int lo_excl, bool allow) {
    f32x16 s0, s1;
#pragma unroll
    for (int i = 0; i < 16; ++i) { s0[i] = 0.f; s1[i] = 0.f; }
#pragma unroll
    for (int s = 0; s < 4; ++s) { const bf16x8 a0 = *(const bf16x8*)(Kt + r * 64 + HY_SWZ(r, hf, s)), a1 = *(const bf16x8*)(Kt + (32 + r) * 64 + HY_SWZ(r, hf, s));
        s0 = MFMA32(a0, qf[s], s0); s1 = MFMA32(a1, qf[s], s1); }
    float mx = -1e30f;
#pragma unroll
    for (int i = 0; i < 16; ++i) { const int key = key0 + (i & 3) + 8 * (i >> 2) + 4 * hf;
        const bool ok0 = allow && key <= t && key > lo_excl, ok1 = allow && (key + 32) <= t && (key + 32) > lo_excl;
        s0[i] = ok0 ? s0[i] : -1e30f; s1[i] = ok1 ? s1[i] : -1e30f; mx = fmaxf(mx, fmaxf(s0[i], s1[i])); }
    mx = x32_max(mx);
    const float mn = fmaxf(st.m, mx), alpha = __builtin_amdgcn_exp2f(st.m - mn);
    float ps = 0.f;
#pragma unroll
    for (int i = 0; i < 16; ++i) { s0[i] = (s0[i] > -1e29f) ? __builtin_amdgcn_exp2f(s0[i] - mn) : 0.f; s1[i] = (s1[i] > -1e29f) ? __builtin_amdgcn_exp2f(s1[i] - mn) : 0.f; ps += s0[i] + s1[i]; }
    st.l = st.l * alpha + ps; st.m = mn;
#pragma unroll
    for (int i = 0; i < 16; ++i) { st.o0[i] *= alpha; st.o1[i] *= alpha; }
    const bf16x8 p00 = pack8(s0, 0), p01 = pack8(s0, 8), p10 = pack8(s1, 0), p11 = pack8(s1, 8);
    { const bf16* v0 = Vt + r * 64; const bf16* v1 = Vt + (32 + r) * 64;
      st.o0 = MFMA32(*(const bf16x8*)(v0 + HY_SWZ(r, hf, 0)), p00, st.o0); st.o0 = MFMA32(*(const bf16x8*)(v0 + HY_SWZ(r, hf, 1)), p01, st.o0); st.o0 = MFMA32(*(const bf16x8*)(v0 + HY_SWZ(r, hf, 2)), p10, st.o0); st.o0 = MFMA32(*(const bf16x8*)(v0 + HY_SWZ(r, hf, 3)), p11, st.o0);
      st.o1 = MFMA32(*(const bf16x8*)(v1 + HY_SWZ(r, hf, 0)), p00, st.o1); st.o1 = MFMA32(*(const bf16x8*)(v1 + HY_SWZ(r, hf, 1)), p01, st.o1); st.o1 = MFMA32(*(const bf16x8*)(v1 + HY_SWZ(r, hf, 2)), p10, st.o1); st.o1 = MFMA32(*(const bf16x8*)(v1 + HY_SWZ(r, hf, 3)), p11, st.o1); }
}
template <bool MASK>
__device__ __forceinline__ void flash_tile_fixed(const bf16* Kt, const bf16* Vt, const bf16x8 (&qf)[4], float& lsum, f32x16& o0, f32x16& o1, int r, int hf, const f32x16& cneg, bool allow, int key0, int t, int lo_excl) {
    f32x16 s0, s1;
    { const bf16x8 a0 = *(const bf16x8*)(Kt + r * 64 + HY_SWZ(r, hf, 0)), a1 = *(const bf16x8*)(Kt + (32 + r) * 64 + HY_SWZ(r, hf, 0)); s0 = MFMA32(a0, qf[0], cneg); s1 = MFMA32(a1, qf[0], cneg); }
#pragma unroll
    for (int s = 1; s < 4; ++s) { const bf16x8 a0 = *(const bf16x8*)(Kt + r * 64 + HY_SWZ(r, hf, s)), a1 = *(const bf16x8*)(Kt + (32 + r) * 64 + HY_SWZ(r, hf, s));
        s0 = MFMA32(a0, qf[s], s0); s1 = MFMA32(a1, qf[s], s1); }
    float ps = 0.f;
#pragma unroll
    for (int i = 0; i < 16; ++i) {
        float p0 = __builtin_amdgcn_exp2f(s0[i]), p1 = __builtin_amdgcn_exp2f(s1[i]);
        if (MASK) { const int key = key0 + (i & 3) + 8 * (i >> 2) + 4 * hf; p0 = (key <= t && key > lo_excl) ? p0 : 0.f; p1 = (key + 32 <= t && key + 32 > lo_excl) ? p1 : 0.f; }
        s0[i] = p0; s1[i] = p1; ps += p0 + p1; }
    lsum += allow ? ps : 0.f;
    const unsigned am = allow ? 0xffffffffu : 0u;
    v4u q00 = __builtin_bit_cast(v4u, pack8(s0, 0)), q01 = __builtin_bit_cast(v4u, pack8(s0, 8)), q10 = __builtin_bit_cast(v4u, pack8(s1, 0)), q11 = __builtin_bit_cast(v4u, pack8(s1, 8));
    q00 &= am; q01 &= am; q10 &= am; q11 &= am;
    const bf16x8 p00 = __builtin_bit_cast(bf16x8, q00), p01 = __builtin_bit_cast(bf16x8, q01), p10 = __builtin_bit_cast(bf16x8, q10), p11 = __builtin_bit_cast(bf16x8, q11);
    const bf16* v0 = Vt + r * 64; const bf16* v1 = Vt + (32 + r) * 64;
    o0 = MFMA32(*(const bf16x8*)(v0 + HY_SWZ(r, hf, 0)), p00, o0); o0 = MFMA32(*(const bf16x8*)(v0 + HY_SWZ(r, hf, 1)), p01, o0); o0 = MFMA32(*(const bf16x8*)(v0 + HY_SWZ(r, hf, 2)), p10, o0); o0 = MFMA32(*(const bf16x8*)(v0 + HY_SWZ(r, hf, 3)), p11, o0);
    o1 = MFMA32(*(const bf16x8*)(v1 + HY_SWZ(r, hf, 0)), p00, o1); o1 = MFMA32(*(const bf16x8*)(v1 + HY_SWZ(r, hf, 1)), p01, o1); o1 = MFMA32(*(const bf16x8*)(v1 + HY_SWZ(r, hf, 2)), p10, o1); o1 = MFMA32(*(const bf16x8*)(v1 + HY_SWZ(r, hf, 3)), p11, o1);
}
#define HY_FENCE8(a_, b_) asm volatile("" : "+v"(a_[0]), "+v"(a_[1]), "+v"(a_[2]), "+v"(a_[3]), "+v"(b_[0]), "+v"(b_[1]), "+v"(b_[2]), "+v"(b_[3]))
__device__ __forceinline__ void ft_kload(const bf16* Kt, int r, int hf, bf16x8 (&f0)[4], bf16x8 (&f1)[4]) {
#pragma unroll
    for (int s = 0; s < 4; ++s) { f0[s] = *(const bf16x8*)(Kt + r * 64 + HY_SWZ(r, hf, s)); f1[s] = *(const bf16x8*)(Kt + (32 + r) * 64 + HY_SWZ(r, hf, s)); }
}
__device__ __forceinline__ void ft_qkm(const bf16x8 (&f0)[4], const bf16x8 (&f1)[4], const bf16x8 (&qf)[4], const f32x16& cneg, f32x16& s0, f32x16& s1) {
    __builtin_amdgcn_s_setprio(1);
    s0 = MFMA32(f0[0], qf[0], cneg); s1 = MFMA32(f1[0], qf[0], cneg);
#pragma unroll
    for (int s = 1; s < 4; ++s) { s0 = MFMA32(f0[s], qf[s], s0); s1 = MFMA32(f1[s], qf[s], s1); }
    __builtin_amdgcn_s_setprio(0);
}
template <bool MASK>
__device__ __forceinline__ void ft_sm_pv(const bf16* Vt, f32x16& s0, f32x16& s1, float& lsum, f32x16& o0, f32x16& o1, int r, int hf, bool allow, int key0, int t, int lo_excl) {
    bf16x8 va[4], vb[4];
    { const bf16* v0 = Vt + r * 64; const bf16* v1 = Vt + (32 + r) * 64;
#pragma unroll
      for (int s = 0; s < 4; ++s) { va[s] = *(const bf16x8*)(v0 + HY_SWZ(r, hf, s)); vb[s] = *(const bf16x8*)(v1 + HY_SWZ(r, hf, s)); } }
    __builtin_amdgcn_sched_barrier(0);
    float ps = 0.f;
#pragma unroll
    for (int i = 0; i < 16; ++i) {
        float p0 = __builtin_amdgcn_exp2f(s0[i]), p1 = __builtin_amdgcn_exp2f(s1[i]);
        if (MASK) { const int key = key0 + (i & 3) + 8 * (i >> 2) + 4 * hf; p0 = (key <= t && key > lo_excl) ? p0 : 0.f; p1 = (key + 32 <= t && key + 32 > lo_excl) ? p1 : 0.f; }
        s0[i] = p0; s1[i] = p1; ps += p0 + p1; }
    lsum += allow ? ps : 0.f;
    const unsigned am = allow ? 0xffffffffu : 0u;
    v4u q00 = __builtin_bit_cast(v4u, pack8(s0, 0)), q01 = __builtin_bit_cast(v4u, pack8(s0, 8)), q10 = __builtin_bit_cast(v4u, pack8(s1, 0)), q11 = __builtin_bit_cast(v4u, pack8(s1, 8));
    q00 &= am; q01 &= am; q10 &= am; q11 &= am;
    const bf16x8 p00 = __builtin_bit_cast(bf16x8, q00), p01 = __builtin_bit_cast(bf16x8, q01), p10 = __builtin_bit_cast(bf16x8, q10), p11 = __builtin_bit_cast(bf16x8, q11);
    HY_FENCE8(va, vb);
    __builtin_amdgcn_s_setprio(1);
    o0 = MFMA32(va[0], p00, o0); o0 = MFMA32(va[1], p01, o0); o0 = MFMA32(va[2], p10, o0); o0 = MFMA32(va[3], p11, o0);
    o1 = MFMA32(vb[0], p00, o1); o1 = MFMA32(vb[1], p01, o1); o1 = MFMA32(vb[2], p10, o1); o1 = MFMA32(vb[3], p11, o1);
    __builtin_amdgcn_s_setprio(0);
    __builtin_amdgcn_sched_barrier(0);
}
template <bool MASK>
__device__ __forceinline__ void ft_exp_chunk(f32x16& s0, f32x16& s1, float& ps, int c, int hf, int key0, int t, int lo_excl) {
    asm volatile("" : "+v"(s0), "+v"(s1));
#pragma unroll
    for (int i = 2 * c; i < 2 * c + 2; ++i) {
        float p0 = __builtin_amdgcn_exp2f(s0[i]), p1 = __builtin_amdgcn_exp2f(s1[i]);
        if (MASK) { const int key = key0 + (i & 3) + 8 * (i >> 2) + 4 * hf; p0 = (key <= t && key > lo_excl) ? p0 : 0.f; p1 = (key + 32 <= t && key + 32 > lo_excl) ? p1 : 0.f; }
        s0[i] = p0; s1[i] = p1; ps += p0 + p1; }
    asm volatile("" : "+v"(ps), "+v"(s0), "+v"(s1));
}
__device__ __forceinline__ void ft_pack(const f32x16& s0, const f32x16& s1, bool allow, bf16x8& p00, bf16x8& p01, bf16x8& p10, bf16x8& p11) {
    const unsigned am = allow ? 0xffffffffu : 0u;
    v4u q00 = __builtin_bit_cast(v4u, pack8(s0, 0)), q01 = __builtin_bit_cast(v4u, pack8(s0, 8)), q10 = __builtin_bit_cast(v4u, pack8(s1, 0)), q11 = __builtin_bit_cast(v4u, pack8(s1, 8));
    q00 &= am; q01 &= am; q10 &= am; q11 &= am;
    p00 = __builtin_bit_cast(bf16x8, q00); p01 = __builtin_bit_cast(bf16x8, q01); p10 = __builtin_bit_cast(bf16x8, q10); p11 = __builtin_bit_cast(bf16x8, q11);
}
__device__ __forceinline__ void ft_vload(const bf16* Vt, int r, int hf, bf16x8 (&va)[4], bf16x8 (&vb)[4]) {
    const bf16* v0 = Vt + r * 64; const bf16* v1 = Vt + (32 + r) * 64;
#pragma unroll
    for (int s = 0; s < 4; ++s) { va[s] = *(const bf16x8*)(v0 + HY_SWZ(r, hf, s)); vb[s] = *(const bf16x8*)(v1 + HY_SWZ(r, hf, s)); }
}
template <bool M0, bool M1>
__device__ __forceinline__ void flash_pair_fixed(const bf16* K0, const bf16* V0, const bf16* K1, const bf16* V1, const bf16x8 (&qf)[4], float& lsum, f32x16& o0, f32x16& o1, int r, int hf, const f32x16& cneg,
                                                 bool allow0, bool allow1, int key0, int t, int lo_excl) {
    f32x16 a0, a1, b0, b1;
    bf16x8 f0[4], f1[4], va[4], vb[4], pa0, pa1, pa2, pa3, pb0, pb1, pb2, pb3;
    ft_kload(K0, r, hf, f0, f1); HY_FENCE8(f0, f1);
    ft_qkm(f0, f1, qf, cneg, a0, a1);
    __builtin_amdgcn_sched_barrier(0);
    ft_kload(K1, r, hf, f0, f1); ft_vload(V0, r, hf, va, vb); HY_FENCE8(f0, f1);
    float psa = 0.f;
#pragma unroll
    for (int c = 0; c < 8; ++c) { const int s = c >> 1;
        if (c & 1) b1 = (s == 0) ? MFMA32(f1[0], qf[0], cneg) : MFMA32(f1[s], qf[s], b1); else b0 = (s == 0) ? MFMA32(f0[0], qf[0], cneg) : MFMA32(f0[s], qf[s], b0);
        __builtin_amdgcn_sched_barrier(0);
        ft_exp_chunk<M0>(a0, a1, psa, c, hf, key0, t, lo_excl);
        __builtin_amdgcn_sched_barrier(0); }
    lsum += allow0 ? psa : 0.f;
    ft_pack(a0, a1, allow0, pa0, pa1, pa2, pa3);
    HY_FENCE8(va, vb);
    __builtin_amdgcn_sched_barrier(0);
    float psb = 0.f;
#define HY_PVM(c_) do { const int s_ = (c_) >> 1; const bf16x8& pp_ = (s_ == 0) ? pa0 : (s_ == 1) ? pa1 : (s_ == 2) ? pa2 : pa3; if ((c_) & 1) o1 = MFMA32(vb[s_], pp_, o1); else o0 = MFMA32(va[s_], pp_, o0); } while (0)
    HY_PVM(0); HY_PVM(1); HY_PVM(2);
    __builtin_amdgcn_sched_barrier(0);
#pragma unroll
    for (int c = 0; c < 8; ++c) {
        ft_exp_chunk<M1>(b0, b1, psb, c, hf, key0 + 64, t, lo_excl);
        __builtin_amdgcn_sched_barrier(0);
        if (c < 5) { HY_PVM(c + 3); __builtin_amdgcn_sched_barrier(0); } }
#undef HY_PVM
    lsum += allow1 ? psb : 0.f;
    ft_pack(b0, b1, allow1, pb0, pb1, pb2, pb3);
    ft_vload(V1, r, hf, va, vb); HY_FENCE8(va, vb);
    __builtin_amdgcn_sched_barrier(0);
#pragma unroll
    for (int s = 0; s < 4; ++s) { const bf16x8& pp = (s == 0) ? pb0 : (s == 1) ? pb1 : (s == 2) ? pb2 : pb3; o0 = MFMA32(va[s], pp, o0); o1 = MFMA32(vb[s], pp, o1); }
    __builtin_amdgcn_sched_barrier(0);
}
#define HY_SBAR() __builtin_amdgcn_sched_barrier(0)
#define HY_PIN(x) asm volatile("" : "+v"(x))
template <bool FIRST, bool MASK>
__device__ __forceinline__ void pipe_step(const bf16* Kc, const bf16* Vp, const bf16x8 (&qf)[4], const f32x16& cneg, f32x16& c0, f32x16& c1, const f32x16& p0, const f32x16& p1, bool allow_prev,
                                          float& lsum, f32x16& o0, f32x16& o1, int r, int hf, int key0, int t, int lo_excl,
                                          bool dma, const bf16* gk, const bf16* gv, unsigned char* dk, unsigned char* dv) {
    bf16x8 f0[4], f1[4], va[4], vb[4]; v4u pw[4];
    ft_kload(Kc, r, hf, f0, f1);
    HY_FENCE8(f0, f1);
    HY_SBAR();
    const bf16* v0 = Vp + r * 64; const bf16* v1 = Vp + (32 + r) * 64;
    float sacc = 0.f; const unsigned am = allow_prev ? 0xffffffffu : 0u;
#pragma unroll
    for (int g = 0; g < 8; ++g) { const int s = g >> 1;
        if (g & 1) c1 = (s == 0) ? MFMA32(f1[0], qf[0], cneg) : MFMA32(f1[s], qf[s], c1); else c0 = (s == 0) ? MFMA32(f0[0], qf[0], cneg) : MFMA32(f0[s], qf[s], c0);
        if (!FIRST) { if (g & 1) vb[s] = *(const bf16x8*)(v1 + HY_SWZ(r, hf, s)); else va[s] = *(const bf16x8*)(v0 + HY_SWZ(r, hf, s));
            const int bb = 4 * (g & 3); const float x0 = (g < 4) ? p0[bb] : p1[bb], x1 = (g < 4) ? p0[bb + 1] : p1[bb + 1], x2 = (g < 4) ? p0[bb + 2] : p1[bb + 2], x3 = (g < 4) ? p0[bb + 3] : p1[bb + 3];
            sacc += (x0 + x1) + (x2 + x3);
            const unsigned w0 = pg8::cvtpk_s(x0, x1) & am, w1 = pg8::cvtpk_s(x2, x3) & am;
            if (g & 1) { pw[g >> 1].z = w0; pw[g >> 1].w = w1; } else { pw[g >> 1].x = w0; pw[g >> 1].y = w1; }
            HY_PIN(pw[g >> 1]); HY_PIN(sacc); }
        HY_SBAR(); }
    if (!FIRST) { lsum += allow_prev ? sacc : 0.f; HY_FENCE8(va, vb); }
    if (dma) { __builtin_amdgcn_global_load_lds((const unsigned*)gk, (LAS unsigned*)(LAS unsigned char*)dk, 16, 0, 0); __builtin_amdgcn_global_load_lds((const unsigned*)gv, (LAS unsigned*)(LAS unsigned char*)dv, 16, 0, 0); }
    HY_SBAR();
#pragma unroll
    for (int g = 0; g < 8; ++g) { const int s = g >> 1;
        if (!FIRST) { const bf16x8 pp = __builtin_bit_cast(bf16x8, pw[s]); if (g & 1) o1 = MFMA32(vb[s], pp, o1); else o0 = MFMA32(va[s], pp, o0); }
#pragma unroll
        for (int i = 2 * g; i < 2 * g + 2; ++i) {
            float q0 = __builtin_amdgcn_exp2f(c0[i]), q1 = __builtin_amdgcn_exp2f(c1[i]);
            if (MASK) { const int key = key0 + (i & 3) + 8 * (i >> 2) + 4 * hf; q0 = (key <= t && key > lo_excl) ? q0 : 0.f; q1 = (key + 32 <= t && key + 32 > lo_excl) ? q1 : 0.f; }
            c0[i] = q0; c1[i] = q1; }
        HY_PIN(c0); HY_PIN(c1);
        HY_SBAR(); }
}
__device__ __forceinline__ void pipe_drain(const bf16* Vp, const f32x16& p0, const f32x16& p1, bool allow_prev, float& lsum, f32x16& o0, f32x16& o1, int r, int hf) {
    bf16x8 va[4], vb[4]; ft_vload(Vp, r, hf, va, vb);
    float sacc = 0.f;
#pragma unroll
    for (int i = 0; i < 16; ++i) sacc += p0[i] + p1[i];
    lsum += allow_prev ? sacc : 0.f;
    bf16x8 q00, q01, q10, q11; ft_pack(p0, p1, allow_prev, q00, q01, q10, q11);
    HY_FENCE8(va, vb);
    o0 = MFMA32(va[0], q00, o0); o1 = MFMA32(vb[0], q00, o1); o0 = MFMA32(va[1], q01, o0); o1 = MFMA32(vb[1], q01, o1);
    o0 = MFMA32(va[2], q10, o0); o1 = MFMA32(vb[2], q10, o1); o0 = MFMA32(va[3], q11, o0); o1 = MFMA32(vb[3], q11, o1);
}
template <int MODE>
__device__ __forceinline__ void nsa2_phase_t(Frame& F, int l) {
    const int wave = F.wave; const int lane0 = F.lane;
    const bf16* PROJ = (const bf16*)(F.ws + WS_R1); bf16* OB = (bf16*)(F.ws + WS_OA) + 256; const unsigned long long* SEL = (const unsigned long long*)(F.ws + WS_SEL);
#define HY_KB2(buf, sub) ((bf16*)(F.lds + (buf) * 16384 + (sub) * 8192))
#define HY_VB2(buf, sub) ((bf16*)(F.lds + 32768 + (buf) * 16384 + (sub) * 8192))
#define HY_KB(buf) ((bf16*)(F.lds + (buf) * 9216))
#define HY_VB(buf) ((bf16*)(F.lds + 18432 + (buf) * 9216))
    const bf16* VT = (const bf16*)(F.ws + WS_VT);
    float Bsel, Bwin;
    { const float gq = wave_max(fabsf(HY_IN(F, 7)[l * 64 + lane0])), gks = wave_max(fabsf(HY_IN(F, 8)[(l * 3 + 1) * 64 + lane0])), gkw = wave_max(fabsf(HY_IN(F, 8)[(l * 3 + 2) * 64 + lane0]));
      Bsel = 11.66f * gq * gks; Bwin = 11.66f * gq * gkw; }
    const bool fixed_ref = (Bsel < 60.f) && (Bwin < 60.f);
    for (int u = F.bid; u < 1024; u += F.G) {
        int lane = (int)__builtin_amdgcn_mbcnt_hi(~0u, __builtin_amdgcn_mbcnt_lo(~0u, 0u)); asm volatile("" : "+v"(lane));
        const int tid = wave * 64 + lane, r = lane & 31, hf = lane >> 5, hh = r >> 3, tk = r & 7, srow = tid >> 3, sch = (tid & 7) ^ ((srow >> 1) & 7);
        int bg, tile; nsa_unit(u, bg, tile); const int b = bg >> 1, g = bg & 1, t0 = tile * 64;
        const int t = t0 + 8 * wave + tk; const size_t m = (size_t)b * SEQ + t;
        bf16x8 qf[4];
#pragma unroll
        for (int s = 0; s < 4; ++s) qf[s] = *(const bf16x8*)(PROJ + m * DINP + C_NQ + (4 * g + hh) * 64 + 16 * s + 8 * hf);
        const unsigned long long sm0 = SEL[((size_t)bg * SEQ + t) * 2], sm1 = SEL[((size_t)bg * SEQ + t) * 2 + 1];
        const float g1 = pg8::sigm_f(bf2f(PROJ[m * DINP + C_NG + (4 * g + hh) * 3 + 1])), g2 = pg8::sigm_f(bf2f(PROJ[m * DINP + C_NG + (4 * g + hh) * 3 + 2]));
        float* stash = (float*)(F.lds + 73728 + wave * 8192);
#pragma unroll 1
        for (int ph = 0; ph < 2; ++ph) {
            const int kcol = (ph == 0 ? C_NKS : C_NKW) + 64 * g + 8 * sch; const bf16* vtb = VT + (size_t)((bg * 2 + ph) * 128) * 4096 + srow * 64 + 8 * sch;
            const int jlo = (ph == 0) ? 0 : (tile > 8 ? tile - 8 : 0);
            const int lo_excl = (ph == 0) ? -(1 << 30) : t - 512;
            FlashState st; st.m = -1e30f; st.l = 0.f;
            f32x16 cneg;
#pragma unroll
            for (int i = 0; i < 16; ++i) cneg[i] = -(ph == 0 ? Bsel : Bwin);
            asm volatile("" : "+v"(cneg));
#pragma unroll
            for (int i = 0; i < 16; ++i) { st.o0[i] = 0.f; st.o1[i] = 0.f; }
            if (fixed_ref) {
                const int n = tile - jlo + 1;
#define HY_SLK(i_) ((const bf16*)(F.lds + ((i_) & 3) * 8192))
#define HY_SLV(i_) ((const bf16*)(F.lds + 32768 + ((i_) & 3) * 8192))
#define HY_DMAT(i_) do { const size_t row_ = (size_t)b * SEQ + (size_t)(jlo + (i_)) * 64 + srow; \
                    __builtin_amdgcn_global_load_lds((const unsigned*)(PROJ + row_ * DINP + kcol), (LAS unsigned*)(LAS unsigned char*)(F.lds + ((i_) & 3) * 8192 + wave * 1024), 16, 0, 0); \
                    __builtin_amdgcn_global_load_lds((const unsigned*)(vtb + (size_t)(jlo + (i_)) * 4096), (LAS unsigned*)(LAS unsigned char*)(F.lds + 32768 + ((i_) & 3) * 8192 + wave * 1024), 16, 0, 0); } while (0)
#define HY_GK(i_) (PROJ + ((size_t)b * SEQ + (size_t)(jlo + (i_)) * 64 + srow) * DINP + kcol)
#define HY_GV(i_) (vtb + (size_t)(jlo + (i_)) * 4096)
#define HY_DK(i_) (F.lds + ((i_) & 3) * 8192 + wave * 1024)
#define HY_DV(i_) (F.lds + 32768 + ((i_) & 3) * 8192 + wave * 1024)
#define HY_ALLOW(j_) ((ph == 1) ? true : ((j_) < 64 ? ((sm0 >> (j_)) & 1ull) != 0ull : ((sm1 >> ((j_) - 64)) & 1ull) != 0ull))
#define HY_WBAR(i_) do { if ((i_) + 2 < n) asm volatile("s_waitcnt vmcnt(2) lgkmcnt(0)\n\ts_barrier" ::: "memory"); else asm volatile("s_waitcnt vmcnt(0) lgkmcnt(0)\n\ts_barrier" ::: "memory"); } while (0)
                HY_DMAT(0); if (n > 1) HY_DMAT(1);
                asm volatile("s_waitcnt vmcnt(0) lgkmcnt(0)\n\ts_barrier" ::: "memory");
                f32x16 pa0, pa1, pb0, pb1;
                if (n == 1 || (ph == 1 && tile >= 8)) pipe_step<true, true>(HY_SLK(0), HY_SLK(0), qf, cneg, pa0, pa1, pa0, pa1, false, st.l, st.o0, st.o1, r, hf, jlo * 64, t, lo_excl, (n > 2), HY_GK(2), HY_GV(2), HY_DK(2), HY_DV(2));
                else pipe_step<true, false>(HY_SLK(0), HY_SLK(0), qf, cneg, pa0, pa1, pa0, pa1, false, st.l, st.o0, st.o1, r, hf, jlo * 64, t, lo_excl, (n > 2), HY_GK(2), HY_GV(2), HY_DK(2), HY_DV(2));
                HY_WBAR(0);
                int i = 1;
#pragma unroll 1
                for (; i + 2 < n; i += 2) {
                    pipe_step<false, false>(HY_SLK(i), HY_SLV(i - 1), qf, cneg, pb0, pb1, pa0, pa1, HY_ALLOW(jlo + i - 1), st.l, st.o0, st.o1, r, hf, (jlo + i) * 64, t, lo_excl, (i + 2 < n), HY_GK(i + 2), HY_GV(i + 2), HY_DK(i + 2), HY_DV(i + 2));
                    HY_WBAR(i);
                    pipe_step<false, false>(HY_SLK(i + 1), HY_SLV(i), qf, cneg, pa0, pa1, pb0, pb1, HY_ALLOW(jlo + i), st.l, st.o0, st.o1, r, hf, (jlo + i + 1) * 64, t, lo_excl, (i + 3 < n), HY_GK(i + 3), HY_GV(i + 3), HY_DK(i + 3), HY_DV(i + 3));
                    HY_WBAR(i + 1);
                }
                if (i + 1 < n) {
                    pipe_step<false, false>(HY_SLK(i), HY_SLV(i - 1), qf, cneg, pb0, pb1, pa0, pa1, HY_ALLOW(jlo + i - 1), st.l, st.o0, st.o1, r, hf, (jlo + i) * 64, t, lo_excl, false, (const bf16*)0, (const bf16*)0, (unsigned char*)0, (unsigned char*)0);
                    HY_WBAR(i);
                    pipe_step<false, true>(HY_SLK(i + 1), HY_SLV(i), qf, cneg, pa0, pa1, pb0, pb1, HY_ALLOW(jlo + i), st.l, st.o0, st.o1, r, hf, (jlo + i + 1) * 64, t, lo_excl, false, (const bf16*)0, (const bf16*)0, (unsigned char*)0, (unsigned char*)0);
                    HY_WBAR(i + 1);
                    pipe_drain(HY_SLV(i + 1), pa0, pa1, HY_ALLOW(jlo + i + 1), st.l, st.o0, st.o1, r, hf);
                } else if (i < n) {
                    pipe_step<false, true>(HY_SLK(i), HY_SLV(i - 1), qf, cneg, pb0, pb1, pa0, pa1, HY_ALLOW(jlo + i - 1), st.l, st.o0, st.o1, r, hf, (jlo + i) * 64, t, lo_excl, false, (const bf16*)0, (const bf16*)0, (unsigned char*)0, (unsigned char*)0);
                    HY_WBAR(i);
                    pipe_drain(HY_SLV(i), pb0, pb1, HY_ALLOW(jlo + i), st.l, st.o0, st.o1, r, hf);
                } else pipe_drain(HY_SLV(0), pa0, pa1, HY_ALLOW(jlo), st.l, st.o0, st.o1, r, hf);
                asm volatile("s_waitcnt lgkmcnt(0)\n\ts_barrier" ::: "memory");
#undef HY_SLK
#undef HY_SLV
#undef HY_DMAT
#undef HY_GK
#undef HY_GV
#undef HY_DK
#undef HY_DV
#undef HY_ALLOW
#undef HY_WBAR
            } else {
#define HY_DMA1(buf, sb_, jt_) do { const size_t row_ = (size_t)b * SEQ + (size_t)(jt_) * 64 + srow; \
                __builtin_amdgcn_global_load_lds((const unsigned*)(PROJ + row_ * DINP + kcol), (LAS unsigned*)(LAS unsigned char*)(F.lds + (buf) * 16384 + (sb_) * 8192 + wave * 1024), 16, 0, 0); \
                __builtin_amdgcn_global_load_lds((const unsigned*)(vtb + (size_t)(jt_) * 4096), (LAS unsigned*)(LAS unsigned char*)(F.lds + 32768 + (buf) * 16384 + (sb_) * 8192 + wave * 1024), 16, 0, 0); } while (0)
#define HY_DMA2(buf, jj_) do { HY_DMA1(buf, 0, (jj_)); HY_DMA1(buf, 1, ((jj_) + 1 <= tile ? (jj_) + 1 : tile)); } while (0)
            if (MODE != 2) HY_DMA2(0, jlo);
            asm volatile("s_waitcnt vmcnt(0)" ::: "memory");
            __syncthreads();
#pragma unroll 1
            for (int jj = jlo; jj <= tile; jj += 2) {
                const int cb = ((jj - jlo) >> 1) & 1;
                const bool more = jj + 2 <= tile;
                if (more && MODE != 2) { if (cb == 0) HY_DMA2(1, jj + 2); else HY_DMA2(0, jj + 2); }
                if (MODE != 1) {   const int j1 = jj + 1; const bool has1 = j1 <= tile;
                    const bool al0 = (ph == 1) ? true : (jj < 64 ? ((sm0 >> jj) & 1ull) != 0ull : ((sm1 >> (jj - 64)) & 1ull) != 0ull);
                    const bool al1 = has1 && ((ph == 1) ? true : (j1 < 64 ? ((sm0 >> j1) & 1ull) != 0ull : ((sm1 >> (j1 - 64)) & 1ull) != 0ull));
                    const bool any0 = __any(al0), any1 = has1 && __any(al1);
#pragma unroll
                    for (int sb = 0; sb < 2; ++sb) { const int j = jj + sb; const bool allow = sb ? al1 : al0;
                        if (sb ? any1 : any0) flash_tile(HY_KB2(cb, sb), HY_VB2(cb, sb), qf, st, r, hf, j * 64, t, lo_excl, allow); } }
                asm volatile("s_waitcnt vmcnt(0)" ::: "memory");
                __syncthreads();
            }
#undef HY_DMA1
#undef HY_DMA2
            }
            float lt = x32_sum(st.l);
            const float sc = (ph == 0 ? g1 : g2) / lt;
            if (ph == 0) {
#pragma unroll
                for (int k = 0; k < 4; ++k) { *(f32x4*)(stash + k * 256 + lane * 4) = (f32x4){st.o0[4 * k] * sc, st.o0[4 * k + 1] * sc, st.o0[4 * k + 2] * sc, st.o0[4 * k + 3] * sc};
                    *(f32x4*)(stash + (4 + k) * 256 + lane * 4) = (f32x4){st.o1[4 * k] * sc, st.o1[4 * k + 1] * sc, st.o1[4 * k + 2] * sc, st.o1[4 * k + 3] * sc}; }
            } else if (MODE != 0) { asm volatile("" :: "v"(st.o0), "v"(st.o1), "v"(st.l));
            } else {
                bf16* op = OB + m * 1024 + (4 * g + hh) * 64;
#pragma unroll
                for (int k = 0; k < 4; ++k) { const f32x4 r0 = *(const f32x4*)(stash + k * 256 + lane * 4), r1 = *(const f32x4*)(stash + (4 + k) * 256 + lane * 4);
#pragma unroll
                    for (int e4 = 0; e4 < 4; ++e4) { const int i = 4 * k + e4, d = (i & 3) + 8 * (i >> 2) + 4 * hf;
                        op[d] = (bf16)f2bf((r0[e4] + st.o0[i] * sc) + bf2f(op[d])); op[32 + d] = (bf16)f2bf((r1[e4] + st.o1[i] * sc) + bf2f(op[32 + d])); } }
            }
        }
    }
}
__device__ __forceinline__ void nsa2_phase(Frame& F, int l) { nsa2_phase_t<0>(F, l); }

__device__ __forceinline__ void sb_half(const f32x16& sT, int kb, int t, int hf, int lane_, float& carry, f32x16& wout) {
    const float C = 0.125f * 1.4426950408889634f;
    float sp[16];
#pragma unroll
    for (int i = 0; i < 16; ++i) { const int key = kb + (i & 3) + 8 * (i >> 2) + 4 * hf; const float z2 = sT[i] * C;
        const float s2 = fmaxf(z2, 0.f) + __builtin_amdgcn_logf(1.f + __builtin_amdgcn_exp2f(-fabsf(z2)));
        sp[i] = (key < t) ? s2 : 0.f; wout[i] = z2; }
    float T[4], P[4];
#pragma unroll
    for (int k = 0; k < 4; ++k) { T[k] = (sp[4 * k] + sp[4 * k + 1]) + (sp[4 * k + 2] + sp[4 * k + 3]); P[k] = x32_other(T[k], lane_); }
    float H[4]; float acc = 0.f;
#pragma unroll
    for (int k = 3; k >= 0; --k) { H[k] = acc + (hf ? 0.f : P[k]); acc += T[k] + P[k]; }
#pragma unroll
    for (int k = 0; k < 4; ++k) {
        const float base = carry + H[k];
        const float t3 = base, t2 = t3 + sp[4 * k + 3], t1 = t2 + sp[4 * k + 2], t0_ = t1 + sp[4 * k + 1];
        const float tl[4] = {t0_, t1, t2, t3};
#pragma unroll
        for (int e = 0; e < 4; ++e) { const int i = 4 * k + e; const int key = kb + e + 8 * k + 4 * hf;
            wout[i] = (key < t) ? __builtin_amdgcn_exp2f(wout[i] - sp[i] - tl[e]) : 0.f; }
    }
    carry += acc;
}
__device__ __forceinline__ void sb_phase(Frame& F) {
    const int lane = F.lane, wave = F.wave, tid = F.tid, r = lane & 31, hf = lane >> 5;
    const bf16* PROJ = (const bf16*)(F.ws + WS_R1); bf16* OA = (bf16*)(F.ws + WS_OA);
    unsigned* DONE = (unsigned*)(F.lds + 36864);
    const int skey = lane, sch = wave, spk = (skey & ~12) | (((skey >> 2) & 1) << 3) | (((skey >> 3) & 1) << 2);
    for (int u = F.bid; u < 512; u += F.G) {
        const int i2 = u >> 8, v = u & 255, bh = v >> 4, jq = v & 15, qb = i2 ? 31 - jq : jq, b = bh >> 2, h = bh & 3;
        const int t0 = qb * 256, t = t0 + 32 * wave + r; const size_t m = (size_t)b * SEQ + t;
        bf16x8 qf[4];
#pragma unroll
        for (int s = 0; s < 4; ++s) qf[s] = *(const bf16x8*)(PROJ + m * DINP + C_SBQ + 64 * h + 16 * s + 8 * hf);
        f32x16 o0, o1;
#pragma unroll
        for (int i = 0; i < 16; ++i) { o0[i] = 0.f; o1[i] = 0.f; }
        float carry = 0.f; bool fin = false;
        const int jtop = 4 * qb + 3, jmine = (t0 + 32 * wave + 31) >> 6;
        const int kcol = C_SBK + 64 * h + 8 * sch, vcol = C_SBV + 64 * h + 8 * sch;
        if (tid == 0) *DONE = 0u;
        uint4 kq, vq;
        { const size_t row = (size_t)b * SEQ + (size_t)jtop * 64 + skey; kq = *(const uint4*)(PROJ + row * DINP + kcol); vq = *(const uint4*)(PROJ + row * DINP + vcol); }
#define HY_STAGE(buf) do { *(uint4*)(HY_KB(buf) + skey * 72 + 8 * sch) = kq; bf16* vd_ = HY_VB(buf) + (8 * sch) * 72 + spk; \
        vd_[0] = (bf16)(vq.x & 0xffffu); vd_[72] = (bf16)(vq.x >> 16); vd_[144] = (bf16)(vq.y & 0xffffu); vd_[216] = (bf16)(vq.y >> 16); \
        vd_[288] = (bf16)(vq.z & 0xffffu); vd_[360] = (bf16)(vq.z >> 16); vd_[432] = (bf16)(vq.w & 0xffffu); vd_[504] = (bf16)(vq.w >> 16); } while (0)
        HY_STAGE(0);
        __syncthreads();
#pragma unroll 1
        for (int j = jtop; j >= 0; --j) {
            const int cb = (jtop - j) & 1;
            if (j > 0) { const size_t row = (size_t)b * SEQ + (size_t)(j - 1) * 64 + skey; kq = *(const uint4*)(PROJ + row * DINP + kcol); vq = *(const uint4*)(PROJ + row * DINP + vcol); }
            if (!fin && j <= jmine) {
                const bf16* Kt = HY_KB(cb); const bf16* Vt = HY_VB(cb);
                f32x16 s0, s1;
#pragma unroll
                for (int i = 0; i < 16; ++i) { s0[i] = 0.f; s1[i] = 0.f; }
#pragma unroll
                for (int s = 0; s < 4; ++s) { const bf16x8 a0 = *(const bf16x8*)(Kt + r * 72 + 16 * s + 8 * hf), a1 = *(const bf16x8*)(Kt + (32 + r) * 72 + 16 * s + 8 * hf);
                    s0 = MFMA32(a0, qf[s], s0); s1 = MFMA32(a1, qf[s], s1); }
                f32x16 w0, w1;
                sb_half(s1, 64 * j + 32, t, hf, lane, carry, w1);
                sb_half(s0, 64 * j, t, hf, lane, carry, w0);
                const bf16x8 p00 = pack8(w0, 0), p01 = pack8(w0, 8), p10 = pack8(w1, 0), p11 = pack8(w1, 8);
                const bf16* v0 = Vt + r * 72 + 8 * hf; const bf16* v1 = Vt + (32 + r) * 72 + 8 * hf;
                o0 = MFMA32(*(const bf16x8*)(v0), p00, o0); o0 = MFMA32(*(const bf16x8*)(v0 + 16), p01, o0); o0 = MFMA32(*(const bf16x8*)(v0 + 32), p10, o0); o0 = MFMA32(*(const bf16x8*)(v0 + 48), p11, o0);
                o1 = MFMA32(*(const bf16x8*)(v1), p00, o1); o1 = MFMA32(*(const bf16x8*)(v1 + 16), p01, o1); o1 = MFMA32(*(const bf16x8*)(v1 + 32), p10, o1); o1 = MFMA32(*(const bf16x8*)(v1 + 48), p11, o1);
                if (__all(carry > 127.f)) { fin = true; if (lane == 0) atomicAdd(DONE, 1u); }
            }
            if (j > 0) { if (cb == 0) HY_STAGE(1); else HY_STAGE(0); }
            __syncthreads();
            const unsigned nd = *DONE;
            __syncthreads();
            if (nd == 8u) break;
        }
#undef HY_STAGE
        bf16* op = OA + m * 1024 + 64 * h;
#pragma unroll
        for (int i = 0; i < 16; ++i) { const int d = (i & 3) + 8 * (i >> 2) + 4 * hf; op[d] = (bf16)f2bf(o0[i]); op[32 + d] = (bf16)f2bf(o1[i]); }
        __syncthreads();
    }
}

__device__ __forceinline__ int wave_isum(int v) {
    v += dppi<DPP_X1>(v); v += dppi<DPP_X2>(v); v += dppi<DPP_ROR4>(v); v += dppi<DPP_ROR8>(v);
    { auto r = __builtin_amdgcn_permlane16_swap((unsigned)v, (unsigned)v, false, false); v = (int)(r[0] + r[1]); }
    { auto r = __builtin_amdgcn_permlane32_swap((unsigned)v, (unsigned)v, false, false); v = (int)(r[0] + r[1]); }
    return v;
}
__device__ __forceinline__ int wave_scan_incl(int v, int lane, int& total) {
    int p = v, t = v, x;
    x = dppi<DPP_X1>(t); p += (lane & 1) ? x : 0; t += x;
    x = dppi<DPP_X2>(t); p += (lane & 2) ? x : 0; t += x;
    x = dppi<0x141>(t); p += (lane & 4) ? x : 0; t += x;
    x = dppi<DPP_ROR8>(t); p += (lane & 8) ? x : 0; t += x;
    { auto r = __builtin_amdgcn_permlane16_swap((unsigned)t, (unsigned)t, false, false); x = (int)((lane & 16) ? r[0] : r[1]); } p += (lane & 16) ? x : 0; t += x;
    { auto r = __builtin_amdgcn_permlane32_swap((unsigned)t, (unsigned)t, false, false); x = (int)((lane & 32) ? r[0] : r[1]); } p += (lane & 32) ? x : 0; t += x;
    total = t; return p;
}
__device__ __forceinline__ float unkey(unsigned k) { return __uint_as_float((k & 0x80000000u) ? (k & 0x7fffffffu) : ~k); }
#ifndef HY_SCORE_PLAIN
#define HY_SCORE_PLAIN 1
#endif
typedef float v2f __attribute__((ext_vector_type(2)));
__device__ __forceinline__ v2f relu_wsum(const f32x4& c0, const f32x4& c1, v2f s2, v2f w01, v2f w23, v2f w45, v2f w67) {
    const v2f a = {c0[0], c0[1]}, b = {c0[2], c0[3]}, c = {c1[0], c1[1]}, d = {c1[2], c1[3]};
    v2f t0, t1, t2, t3;
    asm("s_nop 7\n\ts_nop 3\n\t"
        "v_pk_mul_f32 %0, %4, %8 clamp\n\t"
        "v_pk_mul_f32 %1, %5, %8 clamp\n\t"
        "v_pk_mul_f32 %2, %6, %8 clamp\n\t"
        "v_pk_mul_f32 %3, %7, %8 clamp\n\t"
        "v_pk_mul_f32 %0, %0, %9\n\t"
        "v_pk_mul_f32 %1, %1, %10\n\t"
        "v_pk_fma_f32 %0, %2, %11, %0\n\t"
        "v_pk_fma_f32 %1, %3, %12, %1\n\t"
        "s_nop 0\n\t"
        "v_pk_add_f32 %0, %0, %1\n\t"
        "s_nop 0"
        : "=&v"(t0), "=&v"(t1), "=&v"(t2), "=&v"(t3) : "v"(a), "v"(b), "v"(c), "v"(d), "v"(s2), "v"(w01), "v"(w23), "v"(w45), "v"(w67));
    return t0;
}
#define HY_LBAR() asm volatile("s_waitcnt lgkmcnt(0)\n\ts_barrier" ::: "memory")
__device__ __forceinline__ void dsa1_phase(Frame& F, int l) {
    const int lane = F.lane, wave = F.wave, tid = F.tid, col = lane & 15, q4 = lane >> 4, tk = col >> 2, hd = col & 3;
    const bf16* PROJ = (const bf16*)(F.ws + WS_R1); unsigned short* IDX = (unsigned short*)(F.ws + WS_IDX);
    float* SCF = (float*)F.lds;
    unsigned* HIST = (unsigned*)(F.lds + RING_BYTES);
    uint2* CAND = (uint2*)(F.lds + RING_BYTES + 8192);
    unsigned* CT = (unsigned*)(F.lds + RING_BYTES + 12288);
#ifdef HY_PROBE
    GAS unsigned long long* TSA = (GAS unsigned long long*)((GAS unsigned char*)F.ws + WS_CTL + 65536); unsigned long long tprev = __builtin_amdgcn_s_memrealtime();
    unsigned long long dacc0 = 0, dacc1 = 0, dacc2 = 0, dacc3 = 0, dacc4 = 0, dacc5 = 0;
#define DSTAMP(id) do { const unsigned long long tn_ = __builtin_amdgcn_s_memrealtime(); const unsigned long long dd_ = tn_ - tprev; tprev = tn_; \
        if ((id) == 110) dacc0 += dd_; else if ((id) == 111) dacc1 += dd_; else if ((id) == 112) dacc2 += dd_; else if ((id) == 113) dacc3 += dd_; else if ((id) == 114) dacc4 += dd_; else dacc5 += dd_; } while (0)
#else
#define DSTAMP(id) do { } while (0)
#endif
    const int nrounds = (8192 + F.G - 1) / F.G;
    bf16x8 bqn[2]; uint4 w8n;
#define HY_UNIT_OF(rd_) ((rd_) * F.G + (((rd_) & 1) ? (F.G - 1 - F.bid) : F.bid))
#define HY_QLOAD(un_) do { const size_t mq_ = (size_t)((un_) & 3) * SEQ + (size_t)(((un_) >> 2) * 4); \
        bqn[0] = *(const bf16x8*)(PROJ + (mq_ + tk) * DINP + C_IQ + 32 * hd + 8 * q4); bqn[1] = *(const bf16x8*)(PROJ + (mq_ + tk) * DINP + C_IQ + 32 * (4 + hd) + 8 * q4); \
        w8n = *(const uint4*)(PROJ + (mq_ + q4) * DINP + C_IW); } while (0)
    if (HY_UNIT_OF(0) < 8192) HY_QLOAD(HY_UNIT_OF(0));
    for (int rd = 0; rd < nrounds; ++rd) {
        const int unit = HY_UNIT_OF(rd);
        if (unit >= 8192) break;
        const int b = unit & 3, t0 = (unit >> 2) * 4; const size_t m0 = (size_t)b * SEQ + t0;
        const int nkt = ((t0 + 3) >> 4) + 1;
        bf16x8 bq[2]; float wq[8];
        bq[0] = bqn[0]; bq[1] = bqn[1];
        { const uint4 w8 = w8n;
          wq[0] = bflo(w8.x) * 0.0625f; wq[1] = bfhi(w8.x) * 0.0625f; wq[2] = bflo(w8.y) * 0.0625f; wq[3] = bfhi(w8.y) * 0.0625f; wq[4] = bflo(w8.z) * 0.0625f; wq[5] = bfhi(w8.z) * 0.0625f; wq[6] = bflo(w8.w) * 0.0625f; wq[7] = bfhi(w8.w) * 0.0625f; }
#pragma unroll
        for (int i = 0; i < 4; ++i) HIST[tid + 512 * i] = 0u;
        if (tid < 64) CT[tid] = ((tid & 15) == 0) ? 0xffffffffu : 0u;
        float m1 = -INFINITY, m2 = -INFINITY;
        v2f s2, w01, w23, w45, w67;
        { unsigned qm = 0u;
#pragma unroll
          for (int hg = 0; hg < 2; ++hg) { const v4u qq = __builtin_bit_cast(v4u, bq[hg]);
#pragma unroll
              for (int j = 0; j < 4; ++j) { qm = max(qm, qq[j] & 0x7fff0000u); qm = max(qm, (qq[j] << 16) & 0x7fff0000u); } }
          const float qmax = wave_max(__uint_as_float(qm)), kmax = __uint_as_float(((const unsigned*)(F.ws + WS_CTL))[CW_KMAX + l]);
          const unsigned eb = __float_as_uint(96.f * qmax * kmax) >> 23; const bool tiny = eb < 27u;
          const float sc_s = tiny ? 1.f : __uint_as_float((253u - eb) << 23), sc_inv = tiny ? 1.f : __uint_as_float((eb + 1u) << 23);
          s2 = (v2f){sc_s, sc_s}; w01 = (v2f){wq[0] * sc_inv, wq[1] * sc_inv}; w23 = (v2f){wq[2] * sc_inv, wq[3] * sc_inv}; w45 = (v2f){wq[4] * sc_inv, wq[5] * sc_inv}; w67 = (v2f){wq[6] * sc_inv, wq[7] * sc_inv}; }
        float pinf = INFINITY; asm volatile("" : "+v"(pinf));
        {
            const bf16* ikb = (const bf16*)(F.ws + WS_IKC) + ((size_t)b * SEQ + col) * 32 + 8 * q4;
#define HY_GLD(dst_, ptr_) asm volatile("global_load_dwordx4 %0, %1, off" : "=v"(dst_) : "v"(ptr_) : "memory")
#define HY_VMW7(x_) asm volatile("s_waitcnt vmcnt(7)" : "+v"(x_) :: "memory")
            asm volatile("s_waitcnt vmcnt(0)" : "+v"(bq[0]), "+v"(bq[1]), "+v"(wq[0]), "+v"(wq[1]), "+v"(wq[2]), "+v"(wq[3]), "+v"(wq[4]), "+v"(wq[5]), "+v"(wq[6]), "+v"(wq[7]) :: "memory");
            bf16x8 an[8];
#pragma unroll
            for (int u = 0; u < 8; ++u) { int kt = wave + 8 * u; kt = kt < nkt ? kt : nkt - 1; const bf16* pp = ikb + (size_t)kt * 512; HY_GLD(an[u], pp); }
#ifdef HY_PROBE_STARTUP
            asm volatile("s_waitcnt vmcnt(0)" ::: "memory"); DSTAMP(115);
#endif
#pragma unroll 1
            for (int kt0 = wave; kt0 < nkt; kt0 += 64) {
#pragma unroll
                for (int u = 0; u < 8; ++u) { const int kt = kt0 + 8 * u;
                    HY_VMW7(an[u]);
                    const f32x4 z = (f32x4){0.f, 0.f, 0.f, 0.f};
                    const f32x4 c0 = MFMA16(bq[0], an[u], z), c1 = MFMA16(bq[1], an[u], z);
                    { int ktn = kt + 64; ktn = ktn < nkt ? ktn : nkt - 1; const bf16* pp = ikb + (size_t)ktn * 512; HY_GLD(an[u], pp); }
                    if (kt < nkt) {
#if HY_SCORE_PLAIN
#define HY_RELU(x) __int_as_float(max(__float_as_int(x), 0))
                        float mine = HY_RELU(c0[0]) * wq[0];
                        mine = __builtin_fmaf(HY_RELU(c0[1]), wq[1], mine); mine = __builtin_fmaf(HY_RELU(c0[2]), wq[2], mine); mine = __builtin_fmaf(HY_RELU(c0[3]), wq[3], mine);
                        mine = __builtin_fmaf(HY_RELU(c1[0]), wq[4], mine); mine = __builtin_fmaf(HY_RELU(c1[1]), wq[5], mine); mine = __builtin_fmaf(HY_RELU(c1[2]), wq[6], mine); mine = __builtin_fmaf(HY_RELU(c1[3]), wq[7], mine);
#undef HY_RELU
#else
                        const v2f ps2 = relu_wsum(c0, c1, s2, w01, w23, w45, w67);
                        const float mine = ps2.x + ps2.y;
#endif
                        const int key = 16 * kt + col;
                        if (key <= t0 + q4) { SCF[q4 * 8192 + key] = mine; m2 = __builtin_amdgcn_fmed3f(m1, m2, mine); m1 = __builtin_amdgcn_fmed3f(m1, mine, pinf); }
                    } }
            }
            asm volatile("s_waitcnt vmcnt(0)" : "+v"(an[0]), "+v"(an[1]), "+v"(an[2]), "+v"(an[3]), "+v"(an[4]), "+v"(an[5]), "+v"(an[6]), "+v"(an[7]) :: "memory");
            if (rd + 1 < nrounds && HY_UNIT_OF(rd + 1) < 8192) HY_QLOAD(HY_UNIT_OF(rd + 1));
        }
        DSTAMP(110);
        m2 = fminf(m2, dppf<DPP_X1>(m2)); m2 = fminf(m2, dppf<DPP_X2>(m2)); m2 = fminf(m2, dppf<DPP_ROR4>(m2)); m2 = fminf(m2, dppf<DPP_ROR8>(m2));
        m1 = fmaxf(m1, dppf<DPP_X1>(m1)); m1 = fmaxf(m1, dppf<DPP_X2>(m1)); m1 = fmaxf(m1, dppf<DPP_ROR4>(m1)); m1 = fmaxf(m1, dppf<DPP_ROR8>(m1));
        HY_LBAR();
        if (col == 0 && m1 > -INFINITY) { atomicMin(&CT[q4 * 16 + 0], fkey(m2)); atomicMax(&CT[q4 * 16 + 1], fkey(m1)); }
        HY_LBAR();
        const int row = wave >> 1, hfw = wave & 1, nrow = t0 + row + 1;
        const bool all_in = nrow <= 256;
        const float lo = all_in ? -INFINITY : unkey(CT[row * 16 + 0]), hi = unkey(CT[row * 16 + 1]);
        const float scale = (hi > lo && !all_in) ? 1023.5f / (hi - lo) : 0.f;
        const float* srow = SCF + row * 8192 + 256 * hfw + 4 * lane;
#define HY_EKEY(e_) (512 * ((e_) >> 2) + ((e_) & 3))
        unsigned long long cm;
        {   unsigned mlo = 0u, mhi = 0u;
#pragma unroll
            for (int i = 15; i >= 0; --i) { const f32x4 q = *(const f32x4*)(srow + 512 * i);
#pragma unroll
                for (int j = 3; j >= 0; --j) {
                    if (i >= 8) asm("v_cmp_ge_f32 vcc, %1, %2\n\tv_addc_co_u32 %0, vcc, %0, %0, vcc" : "+v"(mhi) : "v"(q[j]), "v"(lo) : "vcc");
                    else asm("v_cmp_ge_f32 vcc, %1, %2\n\tv_addc_co_u32 %0, vcc, %0, %0, vcc" : "+v"(mlo) : "v"(q[j]), "v"(lo) : "vcc"); } }
            const int d = nrow - 256 * hfw - 4 * lane;
            int nv = 0; if (d > 0) { const int r = d & 511; nv = 4 * (d >> 9) + (r < 4 ? r : 4); }
            const unsigned long long vm = nv >= 64 ? ~0ull : ((1ull << nv) - 1ull);
            cm = (((unsigned long long)mhi << 32) | mlo) & vm; }
        int ce[8], cbn[8]; unsigned long long rest;
        {   unsigned long long w = cm; float cv[8];
#pragma unroll
            for (int k = 0; k < 8; ++k) { const bool has = w != 0ull; const int e = has ? (int)__builtin_ctzll(w) : 0; w &= w - 1ull; ce[k] = has ? e : -1; cv[k] = srow[HY_EKEY(e)]; }
            rest = w;
#pragma unroll
            for (int k = 0; k < 8; ++k) { const unsigned b = (unsigned)(int)fminf((cv[k] - lo) * scale, 1023.f); cbn[k] = (ce[k] >= 0) ? (int)b : -2;
                if (ce[k] >= 0 && !all_in) atomicAdd(&HIST[row * 512 + (b >> 1)], (b & 1u) ? 0x10000u : 1u); } }
        if (!all_in) { unsigned long long w = rest;
            while (w) { const int e0 = (int)__builtin_ctzll(w); w &= w - 1ull; const bool two = w != 0ull; const int e1 = two ? (int)__builtin_ctzll(w) : e0; w &= w - 1ull;
                const float s0 = srow[HY_EKEY(e0)], s1 = srow[HY_EKEY(e1)];
                const unsigned b0 = (unsigned)(int)fminf((s0 - lo) * scale, 1023.f), b1 = (unsigned)(int)fminf((s1 - lo) * scale, 1023.f);
                atomicAdd(&HIST[row * 512 + (b0 >> 1)], (b0 & 1u) ? 0x10000u : 1u);
                if (two) atomicAdd(&HIST[row * 512 + (b1 >> 1)], (b1 & 1u) ? 0x10000u : 1u); } }
        HY_LBAR();
        DSTAMP(111);
        int bstar = -1, cabove = nrow;
        if (!all_in) {
            unsigned cnt[16]; unsigned tot = 0u;
#pragma unroll
            for (int j = 0; j < 8; ++j) { const unsigned w = HIST[row * 512 + 8 * lane + j]; cnt[2 * j] = w & 0xffffu; cnt[2 * j + 1] = w >> 16; tot += (w & 0xffffu) + (w >> 16); }
            int wtot; const int pin = wave_scan_incl((int)tot, lane, wtot);
            const unsigned above = (unsigned)(wtot - pin), incl = above + tot;
            int bs = -1, ca = 0;
            if (above < 256u && incl >= 256u) { unsigned ab = above;
#pragma unroll
                for (int j = 15; j >= 0; --j) { if (ab < 256u && ab + cnt[j] >= 256u) { bs = 16 * lane + j; ca = (int)ab; } ab += cnt[j]; } }
            const unsigned long long who = __ballot(bs >= 0); const int src = (int)__builtin_ctzll(who);
            bstar = __builtin_amdgcn_readlane(bs, src); cabove = __builtin_amdgcn_readlane(ca, src);
        }
        DSTAMP(112);
        unsigned short* outp = IDX + (m0 + row) * 256;
        {   unsigned long long upm = 0ull, eqm = 0ull;
            if (all_in) upm = cm;
            else {
#pragma unroll
              for (int k = 0; k < 8; ++k) { const unsigned long long bit = (ce[k] >= 0) ? (1ull << (ce[k] & 63)) : 0ull; upm |= (cbn[k] > bstar) ? bit : 0ull; eqm |= (cbn[k] == bstar) ? bit : 0ull; }
              cm = rest;
              while (cm) { const int i0 = (int)__builtin_ctzll(cm); const unsigned long long bit0 = cm & (0ull - cm); cm ^= bit0;
                const bool two = cm != 0ull; const int i1 = two ? (int)__builtin_ctzll(cm) : i0; const unsigned long long bit1 = cm & (0ull - cm); cm ^= bit1;
                const float s0 = srow[HY_EKEY(i0)], s1 = srow[HY_EKEY(i1)];
                const int b0 = (int)fminf((s0 - lo) * scale, 1023.f), b1 = (int)fminf((s1 - lo) * scale, 1023.f);
                upm |= (b0 > bstar ? bit0 : 0ull) | (b1 > bstar ? bit1 : 0ull); eqm |= (b0 == bstar ? bit0 : 0ull) | (b1 == bstar ? bit1 : 0ull); } }
            const int cu = __popcll(upm), cq = __popcll(eqm);
            int wt; const int pin = wave_scan_incl(cu | (cq << 16), lane, wt);
            int pu = (pin & 0xffff) - cu, pq = (pin >> 16) - cq;
            const int totq = wt >> 16;
            if (lane == 0) CT[row * 16 + 8 + hfw] = (unsigned)totq;
            while (upm) { const int i = (int)__builtin_ctzll(upm); upm &= upm - 1ull; outp[hfw ? cabove - 1 - pu : pu] = (unsigned short)(HY_EKEY(i) + 256 * hfw + 4 * lane); ++pu; }
            while (eqm) { const int i = (int)__builtin_ctzll(eqm); eqm &= eqm - 1ull;
                if (pq < 128) CAND[row * 128 + (hfw ? 127 - pq : pq)] = make_uint2(fkey(srow[HY_EKEY(i)] + 0.f), (unsigned)(HY_EKEY(i) + 256 * hfw + 4 * lane)); ++pq; }
        }
        HY_LBAR();
        DSTAMP(113);
        if (hfw == 0 && !all_in) {
            const int c0 = (int)CT[row * 16 + 8], c1 = (int)CT[row * 16 + 9], c = c0 + c1, need = 256 - cabove;
            if (c <= 128) {
#define HY_CSLOT(j) ((j) < c0 ? (j) : 128 - c + (j))
                const uint2 m0c = (lane < c) ? CAND[row * 128 + HY_CSLOT(lane)] : make_uint2(0u, 0u), m1c = (lane + 64 < c) ? CAND[row * 128 + HY_CSLOT(lane + 64)] : make_uint2(0u, 0u);
                int r0 = 0, r1 = 0;
                for (int j = 0; j < c; ++j) { const uint2 o = CAND[row * 128 + HY_CSLOT(j)];
                    r0 += (o.x > m0c.x || (o.x == m0c.x && o.y < m0c.y)) ? 1 : 0; r1 += (o.x > m1c.x || (o.x == m1c.x && o.y < m1c.y)) ? 1 : 0; }
                if (lane < c && r0 < need) outp[cabove + r0] = (unsigned short)m0c.y;
                if (lane + 64 < c && r1 < need) outp[cabove + r1] = (unsigned short)m1c.y;
            } else {
                const float* sr = SCF + row * 8192 + lane; const int nit = (nrow + 63) >> 6;
                unsigned prefix = 0u;
                for (int bit = 31; bit >= 0; --bit) { const unsigned cand = prefix | (1u << bit); int cl = 0;
                    for (int i = 0; i < nit; ++i) { const int e = 64 * i + lane; if (e < nrow) { const float sv = sr[64 * i] + 0.f; const int bb = sv >= lo ? (int)fminf((sv - lo) * scale, 1023.f) : -1; cl += (bb == bstar && fkey(sv) >= cand) ? 1 : 0; } }
                    if (wave_isum(cl) >= need) prefix = cand; }
                const unsigned tau = prefix; int cg = 0;
                for (int i = 0; i < nit; ++i) { const int e = 64 * i + lane; if (e < nrow) { const float sv = sr[64 * i] + 0.f; const int bb = sv >= lo ? (int)fminf((sv - lo) * scale, 1023.f) : -1; cg += (bb == bstar && fkey(sv) > tau) ? 1 : 0; } }
                cg = wave_isum(cg);
                int pos = cabove, ties_left = need - cg;
                for (int i = 0; i < nit; ++i) { const int e = 64 * i + lane; bool gt = false, eq = false;
                    if (e < nrow) { const float sv = sr[64 * i] + 0.f; const int bb = sv >= lo ? (int)fminf((sv - lo) * scale, 1023.f) : -1; const unsigned k = fkey(sv); gt = (bb == bstar) && k > tau; eq = (bb == bstar) && k == tau; }
                    const unsigned long long mg = __ballot(gt), me = __ballot(eq);
                    const int pg = (int)__builtin_amdgcn_mbcnt_hi((unsigned)(mg >> 32), __builtin_amdgcn_mbcnt_lo((unsigned)mg, 0u));
                    const int pe = (int)__builtin_amdgcn_mbcnt_hi((unsigned)(me >> 32), __builtin_amdgcn_mbcnt_lo((unsigned)me, 0u));
                    const int ng = __popcll(mg); int ne = __popcll(me); if (ne > ties_left) ne = ties_left;
                    if (gt) outp[pos + pg] = (unsigned short)e;
                    if (eq && pe < ties_left) outp[pos + ng + pe] = (unsigned short)e;
                    pos += ng + ne; ties_left -= ne; }
            }
        }
        HY_LBAR();
        DSTAMP(114);
    }
#ifdef HY_PROBE
    if (F.bid == 0 && tid == 0) { TSA[110] += dacc0; TSA[111] += dacc1; TSA[112] += dacc2; TSA[113] += dacc3; TSA[114] += dacc4; TSA[115] += dacc5; }
#endif
}
__device__ __forceinline__ void dsa2_phase(Frame& F) {
    const int gw = F.bid * NWAVES + F.wave, NGW = F.G * NWAVES, lane = F.lane, col = lane & 15, q4 = lane >> 4;
    const bf16* PROJ = (const bf16*)(F.ws + WS_R1); const unsigned short* IDX = (const unsigned short*)(F.ws + WS_IDX); bf16* OC = (bf16*)(F.ws + WS_OA) + 768;
    unsigned char* wb = F.lds + F.wave * 17408;
    bf16* Vl = (bf16*)wb;
    typedef short v4i16_t __attribute__((ext_vector_type(4)));
#define HY_IDX_LOAD(iv_, mm_) do { const int cnt_ = (((mm_) & (SEQ - 1)) + 1 < 256) ? ((mm_) & (SEQ - 1)) + 1 : 256; iv_ = make_uint2(0u, 0u); if (4 * lane < cnt_) iv_ = *(const uint2*)(IDX + (size_t)(mm_) * 256 + 4 * lane); } while (0)
#define HY_IDX_PUT(iv_, mm_, buf_) do { const int cnt_ = (((mm_) & (SEQ - 1)) + 1 < 256) ? ((mm_) & (SEQ - 1)) + 1 : 256; uint2 w_ = iv_;                                         \
        if (4 * lane + 1 >= cnt_) w_.x &= 0xffffu; if (4 * lane + 2 >= cnt_) w_.y = 0u; else if (4 * lane + 3 >= cnt_) w_.y &= 0xffffu; if (4 * lane >= cnt_) w_ = make_uint2(0u, 0u); \
        *(uint2*)((unsigned short*)(wb + 16384 + 512 * (buf_)) + 4 * lane) = w_; } while (0)
    uint2 ivn; bf16x8 qbn[2];
    if (gw < M) { HY_IDX_LOAD(ivn, gw);
#pragma unroll
        for (int s = 0; s < 2; ++s) qbn[s] = *(const bf16x8*)(PROJ + (size_t)gw * DINP + C_DQ + 64 * (col & 3) + 32 * s + 8 * q4);
        HY_IDX_PUT(ivn, gw, 0); }
    int pbuf = 0;
    for (int m = gw; m < M; m += NGW, pbuf ^= 1) {
        const int t = m & (SEQ - 1), b = m >> 13; const int cnt = (t + 1 < 256) ? t + 1 : 256;
        const unsigned short* Is = (const unsigned short*)(wb + 16384 + 512 * pbuf);
        bf16x8 qb[2]; qb[0] = qbn[0]; qb[1] = qbn[1];
        const int mn = m + NGW; const bool hasn = mn < M;
        LDS_WAIT(); asm volatile("" ::: "memory");
        const bf16* kbase = PROJ + (size_t)b * SEQ * DINP + C_DK + 8 * q4;
        const bf16* vsrc = PROJ + (size_t)b * SEQ * DINP + C_DV + 8 * (lane & 7);
#pragma unroll
        for (int i = 0; i < 16; ++i) { const int idx = Is[8 * i + (lane >> 3)];
            __builtin_amdgcn_global_load_lds((const unsigned*)(vsrc + (size_t)idx * DINP), (LAS unsigned*)(LAS unsigned char*)(wb + i * 1024), 16, 0, 0); }
        if (hasn) { HY_IDX_LOAD(ivn, mn);
#pragma unroll
            for (int s = 0; s < 2; ++s) qbn[s] = *(const bf16x8*)(PROJ + (size_t)mn * DINP + C_DQ + 64 * (col & 3) + 32 * s + 8 * q4); }
        f32x4 sc[16];
        {
            bf16x8 k0[4][2], k1[4][2], k2[4][2];
#define HY_KLOAD(dst_, g_) do { _Pragma("unroll") for (int j = 0; j < 4; ++j) { const int idx = Is[16 * (4 * (g_) + j) + col]; const bf16* kr = kbase + (size_t)idx * DINP; dst_[j][0] = *(const bf16x8*)(kr); dst_[j][1] = *(const bf16x8*)(kr + 32); } } while (0)
#define HY_KMUL(src_, g_) do { _Pragma("unroll") for (int j = 0; j < 4; ++j) { f32x4 a = (f32x4){0.f, 0.f, 0.f, 0.f}; a = MFMA16(src_[j][0], qb[0], a); a = MFMA16(src_[j][1], qb[1], a); sc[4 * (g_) + j] = a; } } while (0)
            HY_KLOAD(k0, 0); HY_KLOAD(k1, 1);
            HY_KLOAD(k2, 2); HY_KMUL(k0, 0);
            HY_KLOAD(k0, 3); HY_KMUL(k1, 1);
            HY_KMUL(k2, 2);
            HY_KMUL(k0, 3);
#undef HY_KLOAD
#undef HY_KMUL
        }
        float mx = -1e30f;
#pragma unroll
        for (int j = 0; j < 16; ++j)
#pragma unroll
            for (int e = 0; e < 4; ++e) { const bool valid = (16 * j + 4 * q4 + e) < cnt; sc[j][e] = valid ? sc[j][e] : -1e30f; mx = fmaxf(mx, sc[j][e]); }
        mx = x32_max(x16_max(mx));
        float sum = 0.f;
#pragma unroll
        for (int j = 0; j < 16; ++j)
#pragma unroll
            for (int e = 0; e < 4; ++e) { const float p = (sc[j][e] > -1e29f) ? __builtin_amdgcn_exp2f(sc[j][e] - mx) : 0.f; sc[j][e] = p; sum += p; }
        sum = x32_sum(x16_sum(sum));
        const float inv = 1.f / sum;
        f32x4 o[4];
#pragma unroll
        for (int dt = 0; dt < 4; ++dt) o[dt] = (f32x4){0.f, 0.f, 0.f, 0.f};
        const int trq = (lane & 15) >> 2, trp = lane & 3;
#pragma unroll
        for (int half = 0; half < 2; ++half) {
            asm volatile("s_waitcnt vmcnt(0)" ::: "memory");
            if (half == 1) { }
#pragma unroll
            for (int Jl = 0; Jl < 4; ++Jl) { const int J = 4 * half + Jl;
                v4u pw; pw.x = pg8::cvtpk_s(sc[2 * J][0], sc[2 * J][1]); pw.y = pg8::cvtpk_s(sc[2 * J][2], sc[2 * J][3]); pw.z = pg8::cvtpk_s(sc[2 * J + 1][0], sc[2 * J + 1][1]); pw.w = pg8::cvtpk_s(sc[2 * J + 1][2], sc[2 * J + 1][3]);
                const bf16x8 pf = __builtin_bit_cast(bf16x8, pw);
                const bf16* r0 = Vl + (32 * Jl + 4 * q4 + trq) * 64 + 4 * trp;
#pragma unroll
                for (int dt = 0; dt < 4; ++dt) {
                    const v4i16_t lo4 = __builtin_amdgcn_ds_read_tr16_b64_v4i16((LAS v4i16_t*)(LAS unsigned char*)(r0 + 16 * dt));
                    const v4i16_t hi4 = __builtin_amdgcn_ds_read_tr16_b64_v4i16((LAS v4i16_t*)(LAS unsigned char*)(r0 + 16 * 64 + 16 * dt));
                    const bf16x8 va = (bf16x8){lo4[0], lo4[1], lo4[2], lo4[3], hi4[0], hi4[1], hi4[2], hi4[3]};
                    o[dt] = MFMA16(va, pf, o[dt]); }
            }
            if (half == 0) {
                LDS_WAIT(); asm volatile("" ::: "memory");
#pragma unroll
                for (int i = 0; i < 16; ++i) { const int idx = Is[128 + 8 * i + (lane >> 3)];
                    __builtin_amdgcn_global_load_lds((const unsigned*)(vsrc + (size_t)idx * DINP), (LAS unsigned*)(LAS unsigned char*)(wb + i * 1024), 16, 0, 0); }
            }
        }
        if (col < 4) {
#pragma unroll
            for (int dt = 0; dt < 4; ++dt) { typedef unsigned u32x2_ __attribute__((ext_vector_type(2))); u32x2_ w; w.x = pg8::cvtpk_s(o[dt][0] * inv, o[dt][1] * inv); w.y = pg8::cvtpk_s(o[dt][2] * inv, o[dt][3] * inv);
                *(u32x2_*)(OC + (size_t)m * 1024 + 64 * col + 16 * dt + 4 * q4) = w; }
        }
        if (hasn) HY_IDX_PUT(ivn, mn, pbuf ^ 1);
        LDS_WAIT(); asm volatile("" ::: "memory");
    }
#undef HY_IDX_LOAD
#undef HY_IDX_PUT
}


#ifndef HY_FLAGS
#define HY_FLAGS 7
#endif
#ifndef HY_N_LAUNCHES
#define HY_N_LAUNCHES 1
#endif
constexpr int NPL = 12, NPHASES = 1 + DEPTH * NPL;
struct Args { const float* in[21]; float* out; unsigned char* ws; int ph_lo, ph_hi, flags, use_bar; };
__device__ __forceinline__ void zero_rows_bf16(Frame& F, bf16* p, size_t nelem) {
    v4u* z = (v4u*)p; const size_t n16 = nelem * 2 / 16;
    for (size_t i = (size_t)F.bid * NTHREADS + F.tid; i < n16; i += (size_t)F.G * NTHREADS) z[i] = (v4u){0u, 0u, 0u, 0u};
}
__global__ void __launch_bounds__(NTHREADS, 2) hy_fwd(Args args) {
    extern __shared__ __attribute__((aligned(16))) unsigned char lds[];
    LAS unsigned char* lds3 = (LAS unsigned char*)lds;
    volatile LAS unsigned* MISC = (volatile LAS unsigned*)(lds3 + MISC_OFF);
    const int wave_s = __builtin_amdgcn_readfirstlane((int)threadIdx.x >> 6);
    if (threadIdx.x < 64) MISC[threadIdx.x] = 0u;
    __syncthreads();
    if (args.use_bar) (void)xcd_barrier_post((unsigned*)(args.ws + WS_CTL) + CW_BAR, MISC + 8);
    const int lo = args.ph_lo, hi = args.ph_hi, flags = args.flags;
#define IN(k) (lo <= (k) && (k) < hi)
#define SEAM(k) do { if (IN(k) && IN((k) + 1)) { GAS unsigned char* w_ = (GAS unsigned char*)args.ws; asm volatile("" : "+s"(w_)); XcdBarrier b_; b_.bar = (unsigned*)(w_ + WS_CTL) + CW_BAR; b_.x = xb_xcc_id(); b_.st = MISC + 8; xcd_barrier(b_); } } while (0)
#define PH_BEGIN(k) if (IN(k)) { asm volatile("; HYPH_BEGIN %0" :: "i"(__LINE__)); Frame F = fr_fresh(lds, wave_s); bf16* XN = (bf16*)(F.ws + WS_XN); bf16* R1 = (bf16*)(F.ws + WS_R1); \
        bf16* OA = (bf16*)(F.ws + WS_OA); bf16* OB = OA + 256; bf16* OC = OA + 768; bf16* MG = (bf16*)(F.ws + WS_MG); unsigned long long* SS = (unsigned long long*)(F.ws + WS_SS); (void)XN; (void)R1; (void)OA; (void)OB; (void)OC; (void)MG; (void)SS;
#ifdef HY_PROBE
#define STAMP(id) do { if (blockIdx.x == 0 && threadIdx.x == 0) ((GAS unsigned long long*)((GAS unsigned char*)args.ws + WS_CTL + 65536))[id] = __builtin_amdgcn_s_memrealtime(); } while (0)
#else
#define STAMP(id) do { } while (0)
#endif
#define PH_END(k) asm volatile("; HYPH_END %0" :: "i"(__LINE__)); } SEAM(k); STAMP((k) + 1);
#define PH_END_LOCAL(k) asm volatile("; HYPH_END %0" :: "i"(__LINE__)); } __syncthreads(); STAMP((k) + 1);

#ifdef HY_DUMP_PHASE
    if (lo == 999) {
        Frame F = fr_fresh(lds, wave_s); const bf16* src = (const bf16*)(F.ws + HY_DUMP_OFF); float* dst = (float*)F.out;
        for (size_t i = (size_t)F.bid * NTHREADS + F.tid; i < (size_t)M * DM; i += (size_t)F.G * NTHREADS) { const size_t m = i >> 10, c = i & 1023; dst[i] = (c < HY_DUMP_COLS && m < HY_DUMP_ROWS) ? bf2f(src[m * HY_DUMP_LD + c]) + bf2f(src[m * HY_DUMP_LD + c + HY_DUMP_C2]) + bf2f(src[m * HY_DUMP_LD + c + HY_DUMP_C3]) : 0.f; }
        return;
    }
#endif
    STAMP(0);
    PH_BEGIN(0) p0_prologue(F); PH_END(0)
    {
        constexpr int l = 0;
        const int pb = 1 + NPL * l;
        PH_BEGIN(pb + 0) { pg8::Gemm g{XN, wl_ptr(F, l, W_GU1), M, NGU, DM}; pg8::StaticOrder S; S.init(M, NGU, F.G, F.bid); pg8::EpiSwiGLU E{R1, FF, SS + (size_t)(3 * l + 0) * M};
            pg8::gemm_phase<pg8::EpiSwiGLU, pg8::StaticOrder, true, true>(lds3, g, S, E, F.tid);
#if defined(HY_XGEMM) && HY_XGEMM == 1
            { __syncthreads(); HY_XORDER S2; S2.init(M, NGU, F.G, F.bid); pg8::EpiNull EN; pg8::Gemm g2 = g; g2.ld = HY_XLD; pg8::gemm_phase<pg8::EpiNull, HY_XORDER, true, true>(lds3, g2, S2, EN, F.tid); }
#endif
            } PH_END(pb + 0)
        PH_BEGIN(pb + 1) { pg8::Gemm g{R1, wl_ptr(F, l, W_DN1), M, DM, FF}; pg8::StaticOrder S; S.init(M, DM, F.G, F.bid); pg8::EpiResid<true, false, (l == 0)> E{HY_IN(F, 0), ((float*)F.out), XN, SS + (size_t)(3 * l + 1) * M, DM, 0.5f};
            pg8::gemm_phase<pg8::EpiResid<true, false, (l == 0)>, pg8::StaticOrder, true, true>(lds3, g, S, E, F.tid);
#if defined(HY_XGEMM) && HY_XGEMM == 2
            { __syncthreads(); pg8::StaticOrder S2; S2.init(M, DM, F.G, F.bid); pg8::EpiNull EN; pg8::gemm_phase<pg8::EpiNull, pg8::StaticOrder, true, true>(lds3, g, S2, EN, F.tid); }
#endif
            } PH_END(pb + 1)
        if (flags != 0) {
        PH_BEGIN(pb + 2) { pg8::Gemm g{XN, wl_ptr(F, l, W_IN), M, DINP, DM}; pg8::StaticOrder S; S.init(M, DINP, F.G, F.bid); pg8::EpiScaled E{R1, DINP, SS + (size_t)(3 * l + 1) * M};
            pg8::gemm_phase<pg8::EpiScaled, pg8::StaticOrder, true, true>(lds3, g, S, E, F.tid); } PH_END(pb + 2)
        PH_BEGIN(pb + 3) { prep_phase(F, l); vt_build(F); } PH_END(pb + 3)
        PH_BEGIN(pb + 4) {
            if (flags & 2) cmp_phase(F, l);
            __syncthreads(); if (l == 0) STAMP(100);
            if (flags & 1) sb_phase(F);
            __syncthreads(); if (l == 0) STAMP(101);
            if (flags & 4) dsa1_phase(F, l);
        } PH_END(pb + 4)
        PH_BEGIN(pb + 5) {
            if (flags & 2) nsa1_phase(F, l);
            __syncthreads(); if (l == 0) STAMP(102);
            if (flags & 4) dsa2_phase(F);
        } PH_END_LOCAL(pb + 5)
        PH_BEGIN(pb + 6) { if (flags & 2) nsa2_phase(F, l);
#ifdef HY_XNSA2
            __syncthreads(); nsa2_phase_t<HY_XNSA2>(F, l);
#endif
 } PH_END(pb + 6)
        PH_BEGIN(pb + 7) { pg8::Gemm g{XN, wl_ptr(F, l, W_GATE), M, NGATE, DM}; pg8::StaticOrder S; S.init(M, NGATE, F.G, F.bid); pg8::EpiSigmoid E{R1, NGATE, SS + (size_t)(3 * l + 1) * M};
            pg8::gemm_phase<pg8::EpiSigmoid, pg8::StaticOrder, true, true>(lds3, g, S, E, F.tid); } PH_END(pb + 7)
        PH_BEGIN(pb + 8) { pg8::Gemm g{OA, wl_ptr(F, l, W_BRA), M, DM, 256, DM}; pg8::MergeOrder S; S.init(M, DM, F.G, F.bid); pg8::EpiMerge E{R1, MG, NGATE, DM};
            pg8::gemm_phase<pg8::EpiMerge, pg8::MergeOrder, true, true>(lds3, g, S, E, F.tid); } PH_END(pb + 8)
        PH_BEGIN(pb + 9) { pg8::Gemm g{MG, wl_ptr(F, l, W_OUT), M, DM, DM}; pg8::StaticOrder S; S.init(M, DM, F.G, F.bid); pg8::EpiResid<true, false, false> E{((float*)F.out), ((float*)F.out), XN, SS + (size_t)(3 * l + 2) * M, DM, 1.0f};
            pg8::gemm_phase<pg8::EpiResid<true, false, false>, pg8::StaticOrder, true, true>(lds3, g, S, E, F.tid); } PH_END(pb + 9)
        }
        PH_BEGIN(pb + 10) { pg8::Gemm g{XN, wl_ptr(F, l, W_GU2), M, NGU, DM}; pg8::StaticOrder S; S.init(M, NGU, F.G, F.bid); pg8::EpiSwiGLU E{R1, FF, SS + (size_t)(3 * l + 2) * M};
            pg8::gemm_phase<pg8::EpiSwiGLU, pg8::StaticOrder, true, true>(lds3, g, S, E, F.tid); } PH_END(pb + 10)
        PH_BEGIN(pb + 11) { pg8::Gemm g{R1, wl_ptr(F, l, W_DN2), M, DM, FF}; pg8::StaticOrder S; S.init(M, DM, F.G, F.bid); pg8::EpiResid<(l + 1 < DEPTH), (l + 1 == DEPTH), false> E{((float*)F.out), ((float*)F.out), XN, SS + (size_t)(3 * (l + 1 < DEPTH ? l + 1 : l)) * M, DM, 0.5f};
            pg8::gemm_phase<pg8::EpiResid<(l + 1 < DEPTH), (l + 1 == DEPTH), false>, pg8::StaticOrder, true, true>(lds3, g, S, E, F.tid); } PH_END(pb + 11)
        }
    {
        constexpr int l = 1;
        const int pb = 1 + NPL * l;
        PH_BEGIN(pb + 0) { pg8::Gemm g{XN, wl_ptr(F, l, W_GU1), M, NGU, DM}; pg8::StaticOrder S; S.init(M, NGU, F.G, F.bid); pg8::EpiSwiGLU E{R1, FF, SS + (size_t)(3 * l + 0) * M};
            pg8::gemm_phase<pg8::EpiSwiGLU, pg8::StaticOrder, true, true>(lds3, g, S, E, F.tid); } PH_END(pb + 0)
        PH_BEGIN(pb + 1) { pg8::Gemm g{R1, wl_ptr(F, l, W_DN1), M, DM, FF}; pg8::StaticOrder S; S.init(M, DM, F.G, F.bid); pg8::EpiResid<true, false, (l == 0)> E{HY_IN(F, 0), ((float*)F.out), XN, SS + (size_t)(3 * l + 1) * M, DM, 0.5f};
            pg8::gemm_phase<pg8::EpiResid<true, false, (l == 0)>, pg8::StaticOrder, true, true>(lds3, g, S, E, F.tid); } PH_END(pb + 1)
        if (flags != 0) {
        PH_BEGIN(pb + 2) { pg8::Gemm g{XN, wl_ptr(F, l, W_IN), M, DINP, DM}; pg8::StaticOrder S; S.init(M, DINP, F.G, F.bid); pg8::EpiScaled E{R1, DINP, SS + (size_t)(3 * l + 1) * M};
            pg8::gemm_phase<pg8::EpiScaled, pg8::StaticOrder, true, true>(lds3, g, S, E, F.tid); } PH_END(pb + 2)
        PH_BEGIN(pb + 3) { prep_phase(F, l); vt_build(F); } PH_END(pb + 3)
        PH_BEGIN(pb + 4) {
            if (flags & 2) cmp_phase(F, l);
            __syncthreads(); if (l == 0) STAMP(100);
            if (flags & 1) sb_phase(F);
            __syncthreads(); if (l == 0) STAMP(101);
            if (flags & 4) dsa1_phase(F, l);
        } PH_END(pb + 4)
        PH_BEGIN(pb + 5) {
            if (flags & 2) nsa1_phase(F, l);
            __syncthreads(); if (l == 0) STAMP(102);
            if (flags & 4) dsa2_phase(F);
        } PH_END_LOCAL(pb + 5)
        PH_BEGIN(pb + 6) { if (flags & 2) nsa2_phase(F, l); } PH_END(pb + 6)
        PH_BEGIN(pb + 7) { pg8::Gemm g{XN, wl_ptr(F, l, W_GATE), M, NGATE, DM}; pg8::StaticOrder S; S.init(M, NGATE, F.G, F.bid); pg8::EpiSigmoid E{R1, NGATE, SS + (size_t)(3 * l + 1) * M};
            pg8::gemm_phase<pg8::EpiSigmoid, pg8::StaticOrder, true, true>(lds3, g, S, E, F.tid); } PH_END(pb + 7)
        PH_BEGIN(pb + 8) { pg8::Gemm g{OA, wl_ptr(F, l, W_BRA), M, DM, 256, DM}; pg8::MergeOrder S; S.init(M, DM, F.G, F.bid); pg8::EpiMerge E{R1, MG, NGATE, DM};
            pg8::gemm_phase<pg8::EpiMerge, pg8::MergeOrder, true, true>(lds3, g, S, E, F.tid); } PH_END(pb + 8)
        PH_BEGIN(pb + 9) { pg8::Gemm g{MG, wl_ptr(F, l, W_OUT), M, DM, DM}; pg8::StaticOrder S; S.init(M, DM, F.G, F.bid); pg8::EpiResid<true, false, false> E{((float*)F.out), ((float*)F.out), XN, SS + (size_t)(3 * l + 2) * M, DM, 1.0f};
            pg8::gemm_phase<pg8::EpiResid<true, false, false>, pg8::StaticOrder, true, true>(lds3, g, S, E, F.tid); } PH_END(pb + 9)
        }
        PH_BEGIN(pb + 10) { pg8::Gemm g{XN, wl_ptr(F, l, W_GU2), M, NGU, DM}; pg8::StaticOrder S; S.init(M, NGU, F.G, F.bid); pg8::EpiSwiGLU E{R1, FF, SS + (size_t)(3 * l + 2) * M};
            pg8::gemm_phase<pg8::EpiSwiGLU, pg8::StaticOrder, true, true>(lds3, g, S, E, F.tid); } PH_END(pb + 10)
        PH_BEGIN(pb + 11) { pg8::Gemm g{R1, wl_ptr(F, l, W_DN2), M, DM, FF}; pg8::StaticOrder S; S.init(M, DM, F.G, F.bid); pg8::EpiResid<(l + 1 < DEPTH), (l + 1 == DEPTH), false> E{((float*)F.out), ((float*)F.out), XN, SS + (size_t)(3 * (l + 1 < DEPTH ? l + 1 : l)) * M, DM, 0.5f};
            pg8::gemm_phase<pg8::EpiResid<(l + 1 < DEPTH), (l + 1 == DEPTH), false>, pg8::StaticOrder, true, true>(lds3, g, S, E, F.tid); } PH_END(pb + 11)
        }
#ifdef HY_PROBE
    if (blockIdx.x == 0 && threadIdx.x == 0) {
        GAS unsigned long long* TS = (GAS unsigned long long*)((GAS unsigned char*)args.ws + WS_CTL + 65536);
        TS[NPHASES] = __builtin_amdgcn_s_memrealtime(); asm volatile("s_waitcnt vmcnt(0)" ::: "memory");
#define D(a, b) ((long long)(TS[b] - TS[a]))
        const long long d = HY_PROBE_A;
#undef D
        const unsigned long long t0 = __builtin_amdgcn_s_memrealtime();
        while ((long long)(__builtin_amdgcn_s_memrealtime() - t0) < d) __builtin_amdgcn_s_sleep(8);
    }
#endif
#undef IN
#undef SEAM
}

extern "C" void kernel_launch(void* const* d_in, const int* in_sizes, int n_in, void* d_out, int out_size, void* d_ws, size_t ws_size, hipStream_t stream) {
    static int grid = 0;
    if (grid == 0) {
        if (n_in != 21 || in_sizes[0] != M * DM || out_size != M * DM || ws_size < WS_END) { fprintf(stderr, "kernel_launch: unexpected shapes (n_in %d, x %d, out %d, ws %zu); nothing launched\n", n_in, n_in > 0 ? in_sizes[0] : -1, out_size, ws_size); grid = -1; return; }
        int dev = 0, cus = 0, per_cu = 0;
        if (hipGetDevice(&dev) != hipSuccess || hipDeviceGetAttribute(&cus, hipDeviceAttributeMultiprocessorCount, dev) != hipSuccess) { grid = -1; return; }
        if (hipFuncSetAttribute((const void*)hy_fwd, hipFuncAttributeMaxDynamicSharedMemorySize, LDS_BYTES) != hipSuccess) { fprintf(stderr, "kernel_launch: hipFuncSetAttribute failed\n"); grid = -1; return; }
        if (hipOccupancyMaxActiveBlocksPerMultiprocessor(&per_cu, (const void*)hy_fwd, NTHREADS, LDS_BYTES) != hipSuccess || per_cu < 1)
            fprintf(stderr, "kernel_launch: note: occupancy query reports %d workgroups per CU\n", per_cu);
        (void)hipGetLastError();
        grid = cus;
    }
    if (grid < 0) return;
    if (hipMemsetAsync((char*)d_ws + WS_CTL, 0, CTL_ZERO_BYTES, stream) != hipSuccess) return;
    Args a{};
    for (int i = 0; i < 21; ++i) a.in[i] = (const float*)d_in[i];
    a.out = (float*)d_out; a.ws = (unsigned char*)d_ws; a.flags = HY_FLAGS;
#if HY_N_LAUNCHES == 1
    a.ph_lo = 0; a.ph_hi = NPHASES; a.use_bar = 1;
    hipLaunchKernelGGL(hy_fwd, dim3(grid), dim3(NTHREADS), LDS_BYTES, stream, a);
#else
#ifdef HY_DUMP_PHASE
    for (int p = 0; p <= HY_DUMP_PHASE; ++p) { a.ph_lo = p; a.ph_hi = p + 1; a.use_bar = 0; hipLaunchKernelGGL(hy_fwd, dim3(grid), dim3(NTHREADS), LDS_BYTES, stream, a); }
    a.ph_lo = 999; a.ph_hi = 1000; a.use_bar = 0; hipLaunchKernelGGL(hy_fwd, dim3(grid), dim3(NTHREADS), LDS_BYTES, stream, a);
#else
    for (int p = 0; p < NPHASES; ++p) { a.ph_lo = p; a.ph_hi = p + 1; a.use_bar = 0; hipLaunchKernelGGL(hy_fwd, dim3(grid), dim3(NTHREADS), LDS_BYTES, stream, a); }
#endif
#endif
}
```
